# Optimizing an MI355X kernel written in HIP

```python
import math
import jax, jax.numpy as jnp
from jax import lax
import numpy as np

D_MODEL = 2048
BATCH = 4
SEQ = 2048
DEPTH = 1

CHUNK = 64
MEM_LEN = 256
SB_HEADS = 8
SB_HEAD_DIM = 128
SB_WIDTH = SB_HEADS * SB_HEAD_DIM
SB_BLOCK = 128
GLA_HEADS = 4
GLA_WIDTH = D_MODEL - SB_WIDTH
GLA_KEY_WIDTH = GLA_WIDTH // 2
GLA_DK = GLA_KEY_WIDTH // GLA_HEADS
GLA_DV = GLA_WIDTH // GLA_HEADS
GLA_GATE_RANK = 16
GLA_GATE_TEMP = 16.0
XATTN_HEADS = 4
XATTN_HEAD_DIM = D_MODEL // XATTN_HEADS
N_GROUPS = 8
EXPERTS_PER_GROUP = 8
N_EXPERTS = N_GROUPS * EXPERTS_PER_GROUP
TOP_K_IN_GROUP = 2
EXPERT_FF = D_MODEL // 4
MOE_BLOCK = 128
EPS = 1e-6
PROJ_SIZES = (SB_WIDTH, SB_WIDTH, SB_WIDTH, GLA_KEY_WIDTH, GLA_KEY_WIDTH, GLA_WIDTH, GLA_GATE_RANK, GLA_WIDTH)
PROJ_WIDTH = 6160

kernel_name = "hymba_stickbreak_gla_hmoe_layer"


def rmsnorm(x, gain):
    xf = x.astype(jnp.float32)
    y = xf * lax.rsqrt(jnp.mean(xf * xf, axis=-1, keepdims=True) + EPS)
    return (y * gain.astype(jnp.float32)).astype(x.dtype)


def head_rmsnorm(o, n_heads, gain):
    b, s, w = o.shape
    of = o.astype(jnp.float32).reshape(b, s, n_heads, w // n_heads)
    of = of * lax.rsqrt(jnp.mean(of * of, axis=-1, keepdims=True) + EPS)
    return (of.reshape(b, s, w) * gain.astype(jnp.float32)).astype(o.dtype)


def stick_breaking_attention(q, k, v):
    seq = q.shape[2]
    scale = 1.0 / math.sqrt(q.shape[-1])
    outs = []
    for start in range(0, seq, SB_BLOCK):
        end = start + SB_BLOCK
        qb, kb, vb = q[:, :, start:end], k[:, :, :end], v[:, :, :end]
        z = jnp.einsum('bhqd,bhkd->bhqk', qb, kb).astype(jnp.float32) * scale
        qpos = start + jnp.arange(SB_BLOCK)
        kpos = jnp.arange(end)
        strict = kpos[None, :] < qpos[:, None]
        log_keep = jnp.where(strict, -jax.nn.softplus(z), 0.0)
        cum = jnp.cumsum(log_keep, axis=-1)
        later = cum[..., -1:] - cum
        w = jnp.where(strict, jnp.exp(jax.nn.log_sigmoid(z) + later), 0.0)
        outs.append(jnp.einsum('bhqk,bhkd->bhqd', w, vb.astype(jnp.float32)))
    return jnp.concatenate(outs, axis=2).astype(v.dtype)


def gated_linear_attention(q, k, v, log_a):
    b, seq, h, dk = q.shape
    dv = v.shape[-1]
    nc = seq // CHUNK
    f32 = jnp.float32
    q = q.astype(f32).reshape(b, nc, CHUNK, h, dk) * (dk ** -0.5)
    k = k.astype(f32).reshape(b, nc, CHUNK, h, dk)
    vc = v.astype(f32).reshape(b, nc, CHUNK, h, dv)
    cum = jnp.cumsum(log_a.astype(f32).reshape(b, nc, CHUNK, h, dk), axis=2)
    last = cum[:, :, -1:]
    q_dec = q * jnp.exp(cum)
    k_inv = k * jnp.exp(-cum)
    k_to_end = k * jnp.exp(last - cum)
    scores = jnp.einsum('bcthk,bcshk->bchts', q_dec, k_inv)
    causal = jnp.arange(CHUNK)[:, None] >= jnp.arange(CHUNK)[None, :]
    scores = jnp.where(causal, scores, 0.0)
    o_intra = jnp.einsum('bchts,bcshv->bcthv', scores, vc)

    def step(state, inp):
        qd, kte, vv, dl = inp
        o = jnp.einsum('bthk,bhkv->bthv', qd, state)
        state = state * jnp.exp(dl)[..., None] + jnp.einsum('bshk,bshv->bhkv', kte, vv)
        return state, o

    xs = (jnp.moveaxis(q_dec, 1, 0), jnp.moveaxis(k_to_end, 1, 0),
          jnp.moveaxis(vc, 1, 0), jnp.moveaxis(last[:, :, 0], 1, 0))
    s0 = jnp.zeros((b, h, dk, dv), f32)
    _, o_inter = lax.scan(step, s0, xs)
    o = o_intra + jnp.moveaxis(o_inter, 0, 1)
    return o.reshape(b, seq, h * dv).astype(v.dtype)


def memory_cross_attention(hq, hm, w_xq, w_xkv, w_xo):
    b, s, d = hq.shape
    m = hm.shape[1]
    q = (hq @ w_xq).reshape(b, s, XATTN_HEADS, XATTN_HEAD_DIM)
    kv = hm @ w_xkv
    k, v = jnp.split(kv, 2, axis=-1)
    k = k.reshape(b, m, XATTN_HEADS, XATTN_HEAD_DIM)
    v = v.reshape(b, m, XATTN_HEADS, XATTN_HEAD_DIM)
    logits = jnp.einsum('bqhd,bkhd->bhqk', q, k).astype(jnp.float32) / math.sqrt(XATTN_HEAD_DIM)
    p = jax.nn.softmax(logits, axis=-1).astype(v.dtype)
    o = jnp.einsum('bhqk,bkhd->bqhd', p, v).reshape(b, s, d)
    return o @ w_xo


def hierarchical_moe(h, w_rg, b_rg, w_re, b_re, w_g, w_u, w_d):
    b, s, d = h.shape
    n = b * s
    hf = h.reshape(n, d)
    logits_g = (hf @ w_rg).astype(jnp.float32) + b_rg.astype(jnp.float32)
    p_g = jax.nn.softmax(logits_g, axis=-1)
    p_top, g_idx = lax.top_k(p_g, 1)
    logits_e = ((hf @ w_re).astype(jnp.float32) + b_re.astype(jnp.float32)).reshape(n, N_GROUPS, EXPERTS_PER_GROUP)
    logits_sel = jnp.take_along_axis(logits_e, g_idx[:, :, None], axis=1)[:, 0]
    p_e = jax.nn.softmax(logits_sel, axis=-1)
    v2, i2 = lax.top_k(p_e, TOP_K_IN_GROUP)
    v2 = v2 / jnp.sum(v2, axis=-1, keepdims=True)
    gate = p_top * v2
    expert_id = (g_idx * EXPERTS_PER_GROUP + i2).astype(jnp.int32)

    a = n * TOP_K_IN_GROUP
    flat_e = expert_id.reshape(a)
    flat_tok = jnp.repeat(jnp.arange(n, dtype=jnp.int32), TOP_K_IN_GROUP)
    flat_w = gate.reshape(a)
    order = jnp.argsort(flat_e)
    se = flat_e[order]
    counts = jnp.zeros((N_EXPERTS,), jnp.int32).at[flat_e].add(1)
    starts = jnp.cumsum(counts) - counts
    padded = (counts + MOE_BLOCK - 1) // MOE_BLOCK * MOE_BLOCK
    pad_end = jnp.cumsum(padded)
    pad_start = pad_end - padded
    dest = pad_start[se] + (jnp.arange(a, dtype=jnp.int32) - starts[se])
    n_blocks = -(-a // MOE_BLOCK) + N_EXPERTS
    p_rows = n_blocks * MOE_BLOCK
    buf_tok = jnp.zeros((p_rows,), jnp.int32).at[dest].set(flat_tok[order])
    buf_w = jnp.zeros((p_rows,), jnp.float32).at[dest].set(flat_w[order])
    block_start = jnp.arange(n_blocks, dtype=jnp.int32) * MOE_BLOCK
    block_exp = jnp.minimum(jnp.sum(pad_end[None, :] <= block_start[:, None], axis=1),
                            N_EXPERTS - 1).astype(jnp.int32)

    def run_block(args):
        e, tok = args
        xb = hf[tok]
        return (jax.nn.silu(xb @ w_g[e]) * (xb @ w_u[e])) @ w_d[e]

    ys = lax.map(run_block, (block_exp, buf_tok.reshape(n_blocks, MOE_BLOCK)))
    ys = ys.reshape(p_rows, d) * buf_w[:, None].astype(ys.dtype)
    out = jnp.zeros((n, d), ys.dtype).at[buf_tok].add(ys)
    return out.reshape(b, s, d).astype(h.dtype)


def setup_inputs(seed: int = 0) -> dict:
    key = jax.random.key(seed)
    ks = jax.random.split(key, 26)
    f32 = jnp.float32
    L = DEPTH

    def nrm(k, shape, fan_in):
        return jax.random.normal(k, shape, f32) * (fan_in ** -0.5)

    def gain(k, shape):
        return 1.0 + 0.02 * jax.random.normal(k, shape, f32)

    return {
        'x': jax.random.normal(ks[0], (BATCH, SEQ, D_MODEL), f32),
        'mem': jax.random.normal(ks[1], (BATCH, MEM_LEN, D_MODEL), f32),
        'norm_mix': gain(ks[2], (L, D_MODEL)),
        'w_in': nrm(ks[3], (L, D_MODEL, PROJ_WIDTH), D_MODEL),
        'w_gate_up': nrm(ks[4], (L, GLA_GATE_RANK, GLA_KEY_WIDTH), GLA_GATE_RANK),
        'b_gate': 0.1 * jax.random.normal(ks[5], (L, GLA_KEY_WIDTH), f32),
        'b_r': 0.02 * jax.random.normal(ks[6], (L, GLA_WIDTH), f32),
        'sb_out_norm': gain(ks[7], (L, SB_WIDTH)),
        'gla_out_norm': gain(ks[8], (L, GLA_WIDTH)),
        'w_out': nrm(ks[9], (L, D_MODEL, D_MODEL), D_MODEL),
        'norm_xattn': gain(ks[10], (L, D_MODEL)),
        'norm_mem': gain(ks[11], (L, D_MODEL)),
        'w_xq': nrm(ks[12], (L, D_MODEL, D_MODEL), D_MODEL),
        'w_xkv': nrm(ks[13], (L, D_MODEL, 2 * D_MODEL), D_MODEL),
        'w_xo': nrm(ks[14], (L, D_MODEL, D_MODEL), D_MODEL),
        'norm_moe': gain(ks[15], (L, D_MODEL)),
        'w_router_group': nrm(ks[16], (L, D_MODEL, N_GROUPS), D_MODEL),
        'b_router_group': 0.01 * jax.random.normal(ks[17], (L, N_GROUPS), f32),
        'w_router_expert': nrm(ks[18], (L, D_MODEL, N_EXPERTS), D_MODEL),
        'b_router_expert': 0.01 * jax.random.normal(ks[19], (L, N_EXPERTS), f32),
        'w_exp_gate': nrm(ks[20], (L, N_EXPERTS, D_MODEL, EXPERT_FF), D_MODEL),
        'w_exp_up': nrm(ks[21], (L, N_EXPERTS, D_MODEL, EXPERT_FF), D_MODEL),
        'w_exp_down': nrm(ks[22], (L, N_EXPERTS, EXPERT_FF, D_MODEL), EXPERT_FF),
        'norm_final': gain(ks[23], (D_MODEL,)),
    }


def reference(x, mem, norm_mix, w_in, w_gate_up, b_gate, b_r, sb_out_norm, gla_out_norm, w_out,
              norm_xattn, norm_mem, w_xq, w_xkv, w_xo, norm_moe, w_router_group, b_router_group,
              w_router_expert, b_router_expert, w_exp_gate, w_exp_up, w_exp_down, norm_final):
    b, s, d = x.shape
    split_idx = np.cumsum(PROJ_SIZES)[:-1].tolist()
    for l in range(DEPTH):
        h = rmsnorm(x, norm_mix[l])
        proj = h @ w_in[l]
        q_sb, k_sb, v_sb, q_g, k_g, v_g, a_lr, r_g = jnp.split(proj, split_idx, axis=-1)

        def to_heads(t):
            return t.reshape(b, s, SB_HEADS, SB_HEAD_DIM).transpose(0, 2, 1, 3)

        o_sb = stick_breaking_attention(to_heads(q_sb), to_heads(k_sb), to_heads(v_sb))
        o_sb = o_sb.transpose(0, 2, 1, 3).reshape(b, s, SB_WIDTH)
        o_sb = head_rmsnorm(o_sb, SB_HEADS, sb_out_norm[l])

        log_a = jax.nn.log_sigmoid((a_lr @ w_gate_up[l] + b_gate[l]).astype(jnp.float32)) / GLA_GATE_TEMP
        o_g = gated_linear_attention(q_g.reshape(b, s, GLA_HEADS, GLA_DK),
                                     k_g.reshape(b, s, GLA_HEADS, GLA_DK),
                                     v_g.reshape(b, s, GLA_HEADS, GLA_DV),
                                     log_a.reshape(b, s, GLA_HEADS, GLA_DK))
        o_g = head_rmsnorm(o_g, GLA_HEADS, gla_out_norm[l]) * jax.nn.silu(r_g + b_r[l])

        x = x + jnp.concatenate([o_sb, o_g], axis=-1) @ w_out[l]

        x = x + memory_cross_attention(rmsnorm(x, norm_xattn[l]), rmsnorm(mem, norm_mem[l]),
                                       w_xq[l], w_xkv[l], w_xo[l])

        x = x + hierarchical_moe(rmsnorm(x, norm_moe[l]), w_router_group[l], b_router_group[l],
                                 w_router_expert[l], b_router_expert[l],
                                 w_exp_gate[l], w_exp_up[l], w_exp_down[l])
    return rmsnorm(x, norm_final)
```

```cpp
#include <hip/hip_runtime.h>
#include <cstdio>
#include <cstdint>

constexpr int D = 2048, BATCH = 4, SEQ = 2048, NTOK = BATCH * SEQ;
constexpr int MEM = 256, NMEM = BATCH * MEM;
constexpr int PROJ = 6160;
constexpr int C_QSB = 0, C_KSB = 1024, C_VSB = 2048, C_QG = 3072, C_KG = 3584, C_VG = 4096, C_ALR = 5120, C_RG = 5136;
constexpr int SBH = 8, SBD = 128, GH = 4, GDK = 128, GDV = 256, GRANK = 16, CHUNK = 64;
constexpr int XH = 4, XD = 512;
constexpr int NG = 8, EPG = 8, NE = 64, FF = 512, NPAIR = NTOK * 2;
constexpr float EPS = 1e-6f;

typedef short bf16x8 __attribute__((ext_vector_type(8)));
typedef float f32x4 __attribute__((ext_vector_type(4)));

__device__ __forceinline__ unsigned short f2bf(float f) { unsigned u = __float_as_uint(f); u += 0x7fffu + ((u >> 16) & 1u); return (unsigned short)(u >> 16); }

namespace pg8 {
#define PG8_LAS __attribute__((address_space(3)))
typedef unsigned short bf16_t;
typedef unsigned u32x4 __attribute__((ext_vector_type(4)));
typedef unsigned u32x2 __attribute__((ext_vector_type(2)));
constexpr int BM = 256, BK = 64, HALF = 128, HTB = HALF * BK * 2, STAGE_BYTES = 8 * HTB, NXCD = 8, WGM = 8;
__host__ __device__ __forceinline__ int lds_byte(int r, int c) { const int st = (r >> 4) * 2 + (c >> 5), rr = r & 15, cc = c & 31, ob = rr * 64 + cc * 2; return st * 1024 + (ob ^ (((ob >> 9) & 1) << 5)); }
__host__ __device__ __forceinline__ void stage_rc(int b, int& R, int& C) { const int st = b / 1024, sb = b % 1024, swz = sb ^ (((sb >> 9) & 1) << 5); R = (st >> 1) * 16 + swz / 64; C = (st & 1) * 32 + (swz % 64) / 2; }
__host__ __device__ __forceinline__ int perm32(int rho) { const int n = rho >> 4, i = rho & 15; return 8 * (i >> 2) + 4 * n + (i & 3); }
__device__ __forceinline__ unsigned cvt_pk_bf16(float lo, float hi) { unsigned r; asm volatile("v_cvt_pk_bf16_f32 %0, %1, %2" : "=v"(r) : "v"(lo), "v"(hi)); return r; }

struct Unit { const char* A; const char* B; int pm, pn, z, mv; };

__device__ __forceinline__ void tile_order(int L, int nM, int nN, int& pm, int& pn) {
    const int nwg = nM * nN; int wgid = L;
    { const int q = nwg / NXCD, r = nwg % NXCD, xcd = wgid % NXCD, off = wgid / NXCD; wgid = (xcd < r ? xcd * (q + 1) : r * (q + 1) + (xcd - r) * q) + off; }
    const int nig = WGM * nN, gid = wgid / nig, fm = gid * WGM, gsz = (nM - fm) < WGM ? (nM - fm) : WGM;
    pm = fm + ((wgid % nig) % gsz); pn = (wgid % nig) / gsz;
}
struct DenseSched {
    const char* A; const char* Bt; unsigned lda, ldb; int K, nM, nN, G, c;
    __device__ __forceinline__ bool next(int i, Unit& u) const { const long L = (long)i * G + c; if (c < 0 || L >= (long)nM * nN) return false; int pm, pn; tile_order((int)L, nM, nN, pm, pn);
        u.pm = pm; u.pn = pn; u.z = 0; u.mv = 256; u.A = A + (size_t)pm * 256 * lda; u.B = Bt + (size_t)pn * 256 * ldb; return true; }
    __device__ __forceinline__ unsigned arow(const Unit&, int r) const { return (unsigned)r * lda; }
    __device__ __forceinline__ void a_ready(const Unit&) const {}
    __device__ __forceinline__ void done(const Unit&) const {}
};

struct ColTileSched {
    const char* A; const char* Bt; unsigned lda, ldb; int K, nM, pn, G, c;
    __device__ __forceinline__ bool next(int i, Unit& u) const { const long L = (long)i * G + c; if (c < 0 || L >= nM) return false;
        u.pm = (int)L; u.pn = pn; u.z = 0; u.mv = 256; u.A = A + (size_t)L * 256 * lda; u.B = Bt + (size_t)pn * 256 * ldb; return true; }
    __device__ __forceinline__ unsigned arow(const Unit&, int r) const { return (unsigned)r * lda; }
    __device__ __forceinline__ void a_ready(const Unit&) const {}
    __device__ __forceinline__ void done(const Unit&) const {}
};

template <class Epi, class Sched, bool ALIGN_EPI>
__device__ __forceinline__ void gemm_phase(PG8_LAS unsigned char* lds, const Sched& S, const Epi& E) {
    const int tid = threadIdx.x, wid = __builtin_amdgcn_readfirstlane(tid >> 6), lane = tid & 63, wr = wid >> 2, wc = wid & 3, fr = lane & 15, fq = lane >> 4;
    const int nt = S.K / BK;
    int R0, C0, R1, C1; stage_rc(tid * 16, R0, C0); stage_rc(tid * 16 + 8192, R1, C1);
    const int Rb0 = Epi::PERM ? ((R0 & ~31) + perm32(R0 & 31)) : R0, Rb1 = Epi::PERM ? ((R1 & ~31) + perm32(R1 & 31)) : R1;
    const unsigned ldb = S.ldb;
    const unsigned vB0 = (unsigned)Rb0 * ldb + (unsigned)C0 * 2u, vB1 = (unsigned)Rb1 * ldb + (unsigned)C1 * 2u;
    const size_t kstep = (size_t)(BK * 2);
    const size_t hstepB = (size_t)HALF * ldb;
    const unsigned ldsw = (unsigned)wid * 1024u;
    const int aoff = lds_byte(wr * 64 + fr, fq * 8), boff = lds_byte(wc * 32 + fr, fq * 8);
#define PG8_SA(b, h) (((b) * 2 + (h)) * HTB)
#define PG8_SB(b, h) ((4 + (b) * 2 + (h)) * HTB)
#define PG8_STG(bufoff, gbase, v0, v1) do { \
        __builtin_amdgcn_global_load_lds((const unsigned*)((const char*)(gbase) + (v0)), (PG8_LAS unsigned*)(lds + (bufoff) + ldsw), 16, 0, 0); \
        __builtin_amdgcn_global_load_lds((const unsigned*)((const char*)(gbase) + (v1)), (PG8_LAS unsigned*)(lds + (bufoff) + ldsw + 8192), 16, 0, 0); } while (0)
#define PG8_STGB(bufoff, gbase) PG8_STG(bufoff, gbase, vB0, vB1)
#define PG8_LDA(dst, b, h) do { _Pragma("unroll") for (int m = 0; m < 4; ++m) _Pragma("unroll") for (int k = 0; k < 2; ++k) dst[m][k] = *(const PG8_LAS bf16x8*)(lds + PG8_SA(b, h) + aoff + m * 2048 + k * 1024); } while (0)
#define PG8_LDB(dst, b, h) do { _Pragma("unroll") for (int n = 0; n < 2; ++n) _Pragma("unroll") for (int k = 0; k < 2; ++k) dst[n][k] = *(const PG8_LAS bf16x8*)(lds + PG8_SB(b, h) + boff + n * 2048 + k * 1024); } while (0)
#define PG8_MMA(ai, bj, At, Bt) do { __builtin_amdgcn_s_setprio(1); _Pragma("unroll") for (int m = 0; m < 4; ++m) _Pragma("unroll") for (int n = 0; n < 2; ++n) _Pragma("unroll") for (int k = 0; k < 2; ++k) \
        acc[ai][bj][m][n] = __builtin_amdgcn_mfma_f32_16x16x32_bf16(Bt[n][k], At[m][k], acc[ai][bj][m][n], 0, 0, 0); __builtin_amdgcn_s_setprio(0); } while (0)
#define PG8_WAIT_V(n) asm volatile("s_waitcnt vmcnt(" #n ")" ::: "memory")
#define PG8_WAIT_L(n) asm volatile("s_waitcnt lgkmcnt(" #n ")" ::: "memory")
#define PG8_BAR __builtin_amdgcn_s_barrier()
#define PG8_SCHED __builtin_amdgcn_sched_barrier(0)
#define PG8_OFFS(u, o00, o01, o10, o11) do { o00 = S.arow(u, R0) + (unsigned)C0 * 2u; o01 = S.arow(u, R1) + (unsigned)C1 * 2u; o10 = S.arow(u, HALF + R0) + (unsigned)C0 * 2u; o11 = S.arow(u, HALF + R1) + (unsigned)C1 * 2u; } while (0)
    Unit cur, nxt; int ui = 0;
    if (!S.next(0, cur)) return;
    f32x4 acc[2][2][4][2];
#pragma unroll
    for (int a = 0; a < 2; ++a)
#pragma unroll
        for (int b = 0; b < 2; ++b)
#pragma unroll
            for (int m = 0; m < 4; ++m)
#pragma unroll
                for (int n = 0; n < 2; ++n) acc[a][b][m][n] = (f32x4){0.f, 0.f, 0.f, 0.f};
    bf16x8 At[4][2], B0[2][2], B1[2][2];
    const char* cA = cur.A; const char* cB = cur.B;
    unsigned c00, c01, c10, c11; PG8_OFFS(cur, c00, c01, c10, c11);
    S.a_ready(cur);
    PG8_STGB(PG8_SB(0, 0), cB); PG8_STGB(PG8_SB(0, 1), cB + hstepB); PG8_STG(PG8_SA(0, 0), cA, c00, c01); PG8_STG(PG8_SA(0, 1), cA, c10, c11);
    if (wr == 1) PG8_BAR;
    PG8_WAIT_V(2); PG8_BAR;
    PG8_STGB(PG8_SB(1, 0), cB + kstep); PG8_STG(PG8_SA(1, 0), cA + kstep, c00, c01); PG8_STGB(PG8_SB(1, 1), cB + hstepB + kstep);
    PG8_WAIT_V(6); PG8_BAR;
    for (;;) {
        const bool has_next = S.next(ui + 1, nxt);
        const char* nA = has_next ? nxt.A : cA; const char* nB = has_next ? nxt.B : cB;
        unsigned n00 = c00, n01 = c01, n10 = c10, n11 = c11;
        if (has_next) PG8_OFFS(nxt, n00, n01, n10, n11);
        for (int t = 0; t < nt; t += 2) {
            const bool last = (t == nt - 2);
            const char* a1 = cA + (size_t)(t + 1) * kstep;
            const char* a2 = last ? nA : cA + (size_t)(t + 2) * kstep; const char* b2 = last ? nB : cB + (size_t)(t + 2) * kstep;
            const char* a3 = a2 + kstep; const char* b3 = b2 + kstep;
            const unsigned x00 = last ? n00 : c00, x01 = last ? n01 : c01, x10 = last ? n10 : c10, x11 = last ? n11 : c11;
            if (last && has_next) S.a_ready(nxt);
            PG8_LDB(B0, 0, 0); PG8_LDB(B1, 0, 1); PG8_SCHED; PG8_LDA(At, 0, 0); PG8_STG(PG8_SA(1, 1), a1, c10, c11);
            PG8_WAIT_V(8); PG8_WAIT_L(0); PG8_BAR; PG8_MMA(0, 0, At, B0); PG8_MMA(0, 1, At, B1); PG8_BAR; PG8_SCHED;
            PG8_LDA(At, 0, 1); PG8_STGB(PG8_SB(0, 0), b2); PG8_STGB(PG8_SB(0, 1), b2 + hstepB); PG8_STG(PG8_SA(0, 0), a2, x00, x01);
            PG8_WAIT_V(8); PG8_WAIT_L(0); PG8_BAR; PG8_MMA(1, 0, At, B0); PG8_MMA(1, 1, At, B1); PG8_BAR; PG8_SCHED;
            PG8_LDB(B0, 1, 0); PG8_LDB(B1, 1, 1); PG8_SCHED; PG8_LDA(At, 1, 0); PG8_STG(PG8_SA(0, 1), a2, x10, x11);
            PG8_WAIT_V(8); PG8_WAIT_L(0); PG8_BAR; PG8_MMA(0, 0, At, B0); PG8_MMA(0, 1, At, B1); PG8_BAR; PG8_SCHED;
            PG8_LDA(At, 1, 1); PG8_STGB(PG8_SB(1, 0), b3); PG8_STGB(PG8_SB(1, 1), b3 + hstepB); PG8_STG(PG8_SA(1, 0), a3, x00, x01);
            PG8_WAIT_V(8); PG8_WAIT_L(0); PG8_BAR; PG8_MMA(1, 0, At, B0); PG8_MMA(1, 1, At, B1); PG8_BAR; PG8_SCHED;
        }
        if constexpr (ALIGN_EPI) { if (wr == 0) PG8_BAR; }
        if constexpr (!Epi::AFTER_DRAIN) { E(acc, cur, wr, wc, fr, fq); S.done(cur); }
        if (!has_next) break;
#pragma unroll
        for (int a = 0; a < 2; ++a)
#pragma unroll
            for (int b = 0; b < 2; ++b)
#pragma unroll
                for (int m = 0; m < 4; ++m)
#pragma unroll
                    for (int n = 0; n < 2; ++n) acc[a][b][m][n] = (f32x4){0.f, 0.f, 0.f, 0.f};
        cur = nxt; cA = nA; cB = nB; c00 = n00; c01 = n01; c10 = n10; c11 = n11; ++ui;
        if constexpr (ALIGN_EPI) { if (wr == 1) PG8_BAR; }
    }
    PG8_WAIT_V(0);
    if constexpr (!ALIGN_EPI) { if (wr == 0) PG8_BAR; }
    PG8_BAR;
    if constexpr (Epi::AFTER_DRAIN) { E.fused(acc, cur, wr, wc, fr, fq, lds, wid, lane); S.done(cur); }
#undef PG8_SA
#undef PG8_SB
#undef PG8_STG
#undef PG8_STGB
#undef PG8_LDA
#undef PG8_LDB
#undef PG8_MMA
#undef PG8_WAIT_V
#undef PG8_WAIT_L
#undef PG8_BAR
#undef PG8_SCHED
#undef PG8_OFFS
}

template <class Epi>
__device__ __forceinline__ void gemm128_unit(PG8_LAS unsigned char* lds, const char* A, unsigned lda, const char* B, unsigned ldb, int K, const Epi& E, const Unit& u) {
    const int tid = threadIdx.x, wid = __builtin_amdgcn_readfirstlane(tid >> 6), lane = tid & 63, wr = wid >> 2, wc = wid & 3, fr = lane & 15, fq = lane >> 4;
    const int nt = K / BK;
    int R0, C0, R1, C1; stage_rc(tid * 16, R0, C0); stage_rc(tid * 16 + 8192, R1, C1);
    const int Rb0 = (R0 & ~31) + perm32(R0 & 31), Rb1 = (R1 & ~31) + perm32(R1 & 31);
    const unsigned vB0 = (unsigned)Rb0 * ldb + (unsigned)C0 * 2u, vB1 = (unsigned)Rb1 * ldb + (unsigned)C1 * 2u, vA0 = (unsigned)R0 * lda + (unsigned)C0 * 2u, vA1 = (unsigned)R1 * lda + (unsigned)C1 * 2u;
    const size_t hstepB = (size_t)HALF * ldb;
    const unsigned ldsw = (unsigned)wid * 1024u;
    const int aoff = lds_byte(wr * 64 + fr, fq * 8), boff = lds_byte(wc * 32 + fr, fq * 8);
    constexpr int STG3 = 3 * HTB;
#define G8_STG(off, gbase, v0, v1) do { \
        __builtin_amdgcn_global_load_lds((const unsigned*)((const char*)(gbase) + (v0)), (PG8_LAS unsigned*)(lds + (off) + ldsw), 16, 0, 0); \
        __builtin_amdgcn_global_load_lds((const unsigned*)((const char*)(gbase) + (v1)), (PG8_LAS unsigned*)(lds + (off) + ldsw + 8192), 16, 0, 0); } while (0)
#define G8_TILE(so, kt) do { const char* bb_ = B + (size_t)(kt) * (BK * 2); const char* aa_ = A + (size_t)(kt) * (BK * 2); \
        G8_STG((so), bb_, vB0, vB1); G8_STG((so) + HTB, bb_ + hstepB, vB0, vB1); G8_STG((so) + 2 * HTB, aa_, vA0, vA1); } while (0)
#define G8_MMA(bj, Bt) do { __builtin_amdgcn_s_setprio(1); _Pragma("unroll") for (int m = 0; m < 4; ++m) _Pragma("unroll") for (int n = 0; n < 2; ++n) _Pragma("unroll") for (int k = 0; k < 2; ++k) \
        acc[bj][m][n] = __builtin_amdgcn_mfma_f32_16x16x32_bf16(Bt[n][k], At[m][k], acc[bj][m][n], 0, 0, 0); __builtin_amdgcn_s_setprio(0); } while (0)
    f32x4 acc[2][4][2];
#pragma unroll
    for (int b = 0; b < 2; ++b)
#pragma unroll
        for (int m = 0; m < 4; ++m)
#pragma unroll
            for (int n = 0; n < 2; ++n) acc[b][m][n] = (f32x4){0.f, 0.f, 0.f, 0.f};
    bf16x8 At[4][2], B0[2][2], B1[2][2];
    G8_TILE(0, 0); G8_TILE(STG3, 1);
    asm volatile("s_waitcnt vmcnt(6)" ::: "memory"); __builtin_amdgcn_s_barrier();
    if (wr == 1) __builtin_amdgcn_s_barrier();
    int so = 0;
    for (int t = 0; t < nt; ++t) {
        const int s2 = (so >= STG3) ? so - STG3 : so + 2 * STG3;
        const int kt2 = (t + 2 < nt) ? t + 2 : 0;
        G8_TILE(s2, kt2);
#pragma unroll
        for (int n = 0; n < 2; ++n)
#pragma unroll
            for (int k = 0; k < 2; ++k) { B0[n][k] = *(const PG8_LAS bf16x8*)(lds + so + boff + n * 2048 + k * 1024); B1[n][k] = *(const PG8_LAS bf16x8*)(lds + so + HTB + boff + n * 2048 + k * 1024); }
#pragma unroll
        for (int m = 0; m < 4; ++m)
#pragma unroll
            for (int k = 0; k < 2; ++k) At[m][k] = *(const PG8_LAS bf16x8*)(lds + so + 2 * HTB + aoff + m * 2048 + k * 1024);
        asm volatile("s_waitcnt vmcnt(6)" ::: "memory"); asm volatile("s_waitcnt lgkmcnt(0)" ::: "memory"); __builtin_amdgcn_s_barrier();
        G8_MMA(0, B0); G8_MMA(1, B1);
        __builtin_amdgcn_s_barrier(); __builtin_amdgcn_sched_barrier(0);
        so = (so == 2 * STG3) ? 0 : so + STG3;
    }
    if (wr == 0) __builtin_amdgcn_s_barrier();
    E(acc, u, wr, wc, fr, fq);
    asm volatile("s_waitcnt vmcnt(0)" ::: "memory"); __builtin_amdgcn_s_barrier();
#undef G8_STG
#undef G8_TILE
#undef G8_MMA
}
}

#define LAS __attribute__((address_space(3)))
typedef unsigned short bf16;
typedef unsigned v4u __attribute__((ext_vector_type(4)));
typedef unsigned v2u __attribute__((ext_vector_type(2)));
#define RLX_AGENT __ATOMIC_RELAXED, __HIP_MEMORY_SCOPE_AGENT
#define LDS_WAIT() asm volatile("s_waitcnt lgkmcnt(0)" ::: "memory")
#define VM_WAIT() asm volatile("s_waitcnt vmcnt(0)" ::: "memory")
__device__ __forceinline__ unsigned pk2(float lo, float hi) { return (unsigned)f2bf(lo) | ((unsigned)f2bf(hi) << 16); }
__device__ __forceinline__ float bf2f(unsigned short b) { return __uint_as_float(((unsigned)b) << 16); }

#define XB_TMO      128
#define XB_XCNT(j)  (256  + 64 * (j))
#define XB_XSUB(j)  (1280 + 64 * (j))
#define XB_XGEN(j)  (2304 + 64 * (j))
#define XB_TOP      3328
#define XB_TOPGEN   3392
#define XCD_BAR_WORDS 3456
#define XB_SPIN_CAP (1u << 18)
__device__ __forceinline__ unsigned xb_ld(unsigned* p)              { return __hip_atomic_load(p, __ATOMIC_RELAXED, __HIP_MEMORY_SCOPE_AGENT); }
__device__ __forceinline__ unsigned xb_add(unsigned* p, unsigned v) { return __hip_atomic_fetch_add(p, v, __ATOMIC_RELAXED, __HIP_MEMORY_SCOPE_AGENT); }
__device__ __forceinline__ unsigned xb_xcc_id() { return (unsigned)__builtin_amdgcn_s_getreg((3 << 11) | 20) & 0xFu; }
#define XB_SPIN(cond, bar) do { unsigned _sp = 0; while (cond) { __builtin_amdgcn_s_sleep(1); \
    if ((++_sp & 255u) == 0u) { if (xb_ld(&(bar)[XB_TMO])) break; if (_sp > XB_SPIN_CAP) { atomicAdd(&(bar)[XB_TMO], 1u); break; } } } } while (0)
struct XcdBarrier { unsigned* bar; unsigned x; volatile LAS unsigned* st; };
__device__ __forceinline__ XcdBarrier xcd_barrier_post(unsigned* bar, volatile LAS unsigned* st) {
    XcdBarrier b; b.bar = bar; b.x = xb_xcc_id(); b.st = st;
    if (threadIdx.x == 0) (void)xb_add(&bar[XB_XCNT(b.x)], 1u);
    return b;
}
__device__ __forceinline__ void xcd_barrier_complete(unsigned* bar, unsigned x, unsigned& nloc, unsigned& nx) {
    const unsigned G = gridDim.x * gridDim.y * gridDim.z;
    unsigned sum, cnt, mine, sp = 0u;
    for (;;) {
        sum = 0u; cnt = 0u; mine = 0u;
#pragma unroll
        for (unsigned j = 0; j < 16; ++j) { const unsigned c = xb_ld(&bar[XB_XCNT(j)]); sum += c; cnt += (c > 0u) ? 1u : 0u; mine = (j == x) ? c : mine; }
        if (sum == G) break;
        __builtin_amdgcn_s_sleep(1);
        if ((++sp & 255u) == 0u) { if (xb_ld(&bar[XB_TMO])) break; if (sp > XB_SPIN_CAP) { atomicAdd(&bar[XB_TMO], 1u); break; } }
    }
    nloc = mine > 0u ? mine : 1u; nx = cnt > 0u ? cnt : 1u;
}
__device__ __forceinline__ void xcd_barrier(const XcdBarrier& b) {
    asm volatile("s_waitcnt vmcnt(0)" ::: "memory");
    __syncthreads();
    if (threadIdx.x == 0) {
        unsigned* bar = b.bar;
        __builtin_amdgcn_s_waitcnt(0);
        unsigned nloc = b.st[0], nx = b.st[1];
        if (nloc == 0u) { xcd_barrier_complete(bar, b.x, nloc, nx); b.st[0] = nloc; b.st[1] = nx; }
        const unsigned old = xb_add(&bar[XB_XSUB(b.x)], 1u);
        const unsigned gen = old / nloc;
        if (old + 1u == (gen + 1u) * nloc) {
            __builtin_amdgcn_fence(__ATOMIC_RELEASE, "agent");
            asm volatile("s_waitcnt vmcnt(0)" ::: "memory");
            const unsigned og = xb_add(&bar[XB_TOP], 1u);
            const unsigned tg = og / nx;
            if (og + 1u == (tg + 1u) * nx) xb_add(&bar[XB_TOPGEN], 1u);
            else XB_SPIN(xb_ld(&bar[XB_TOPGEN]) == tg, bar);
            __builtin_amdgcn_fence(__ATOMIC_ACQUIRE, "agent");
            xb_add(&bar[XB_XGEN(b.x)], 1u);
            asm volatile("s_waitcnt vmcnt(0)" ::: "memory");
        } else {
            XB_SPIN(xb_ld(&bar[XB_XGEN(b.x)]) == gen, bar);
            __builtin_amdgcn_fence(__ATOMIC_ACQUIRE, "agent");
            asm volatile("s_waitcnt vmcnt(0)" ::: "memory");
        }
    }
    __syncthreads();
}

template <class PF>
__device__ __forceinline__ void xcd_barrier_pf(const XcdBarrier& b, const PF& pf) {
    asm volatile("s_waitcnt vmcnt(0)" ::: "memory");
    __syncthreads();
    if (threadIdx.x >= 64) pf();
    if (threadIdx.x == 0) {
        unsigned* bar = b.bar;
        __builtin_amdgcn_s_waitcnt(0);
        unsigned nloc = b.st[0], nx = b.st[1];
        if (nloc == 0u) { xcd_barrier_complete(bar, b.x, nloc, nx); b.st[0] = nloc; b.st[1] = nx; }
        const unsigned old = xb_add(&bar[XB_XSUB(b.x)], 1u);
        const unsigned gen = old / nloc;
        if (old + 1u == (gen + 1u) * nloc) {
            __builtin_amdgcn_fence(__ATOMIC_RELEASE, "agent");
            asm volatile("s_waitcnt vmcnt(0)" ::: "memory");
            const unsigned og = xb_add(&bar[XB_TOP], 1u);
            const unsigned tg = og / nx;
            if (og + 1u == (tg + 1u) * nx) xb_add(&bar[XB_TOPGEN], 1u);
            else XB_SPIN(xb_ld(&bar[XB_TOPGEN]) == tg, bar);
            __builtin_amdgcn_fence(__ATOMIC_ACQUIRE, "agent");
            xb_add(&bar[XB_XGEN(b.x)], 1u);
            asm volatile("s_waitcnt vmcnt(0)" ::: "memory");
        } else {
            XB_SPIN(xb_ld(&bar[XB_XGEN(b.x)]) == gen, bar);
            __builtin_amdgcn_fence(__ATOMIC_ACQUIRE, "agent");
            asm volatile("s_waitcnt vmcnt(0)" ::: "memory");
        }
    }
    if (threadIdx.x < 64) pf();
    __syncthreads();
}

constexpr size_t MiB = 1u << 20;
constexpr int PROJP = 6400;
constexpr size_t WS_CTL = 0, CTL_ZERO_BYTES = 1 * MiB;
constexpr int CW_BAR = 4096;
constexpr int CW_CNT = 16384;
constexpr int CW_Q = 24576;
constexpr int CW_ROWSQ1 = 32768, CW_ROWSQ2 = 32768 + 8192;
constexpr size_t WS_WIN = 2 * MiB;
constexpr size_t WS_WOUT = 28 * MiB;
constexpr size_t WS_WXQ = 36 * MiB;
constexpr size_t WS_WXKV = 44 * MiB;
constexpr size_t WS_WXO = 60 * MiB;
constexpr size_t WS_H0 = 68 * MiB;
constexpr size_t WS_HM = 100 * MiB;
constexpr size_t WS_PROJ = 104 * MiB;
constexpr size_t WS_ALR = 204 * MiB;
constexpr size_t WS_KV = 205 * MiB;
constexpr size_t WS_CAT = 214 * MiB;
constexpr size_t WS_X1 = 246 * MiB;
constexpr size_t WS_X1B = 310 * MiB;
constexpr size_t WS_QX = 342 * MiB;
constexpr size_t WS_OX = 374 * MiB;
constexpr size_t WS_X2 = 406 * MiB;
constexpr size_t WS_GU = WS_X1;
constexpr size_t WS_GS = WS_X1B;
constexpr size_t WS_GQD = WS_QX;
constexpr size_t WS_GKI = WS_QX + 8 * MiB;
constexpr size_t WS_GEL = WS_QX + 16 * MiB;
constexpr size_t WS_PB = WS_H0;
constexpr size_t WS_HF = 854 * MiB;
constexpr size_t WS_HB = 886 * MiB;
constexpr size_t WS_YB = 902 * MiB;
constexpr size_t WS_WR = 966 * MiB;
constexpr size_t WS_LIST = 967 * MiB;
constexpr size_t WS_GATE = 969 * MiB;
constexpr size_t WS_MKT = WS_OX;
constexpr size_t WS_NVT = WS_OX + 16 * MiB;
constexpr size_t WS_NEW_END = 970 * MiB;

constexpr int RING_OFF = 0, RING_BYTES = 147456;
constexpr int LDSCTL_OFF = RING_BYTES, MISC_OFF = LDSCTL_OFF + 320;
constexpr int LDS_BYTES = 163840;
constexpr int NWAVES = 8;

struct Frame {
    LAS unsigned char* lds; volatile LAS unsigned* MISC; unsigned* ctl;
    int tid, lane, wave, G, vcu;
    unsigned char* ws;
};

__device__ __forceinline__ void p0_transpose_item(const float* W, int K, int ldw, int ncols, const float* gain, bf16* WT, int row_off, LAS float* scr, int item, int lane) {
    const int nblk = (ncols + 63) / 64, kb = item / nblk, nb = item % nblk, k0 = 64 * kb, n0 = 64 * nb;
    const int lk = lane >> 4, ln = (lane & 15) * 4; const bool ok = (n0 + ln) < ncols;
    f32x4 v[16];
#pragma unroll
    for (int i = 0; i < 16; ++i) v[i] = ok ? __builtin_nontemporal_load((const f32x4*)(W + (size_t)(k0 + 4 * i + lk) * ldw + n0 + ln)) : (f32x4){0.f, 0.f, 0.f, 0.f};
#pragma unroll
    for (int i = 0; i < 16; ++i) { const int kk = 4 * i + lk; const float g = gain ? gain[k0 + kk] : 1.0f; LAS float* d = scr + kk * 65 + ln; d[0] = v[i][0] * g; d[1] = v[i][1] * g; d[2] = v[i][2] * g; d[3] = v[i][3] * g; }
    LDS_WAIT(); asm volatile("" ::: "memory");
    const int c = lane & 7;
#pragma unroll
    for (int j = 0; j < 8; ++j) { const int n = (lane >> 3) + 8 * j; const LAS float* sp = scr + (8 * c) * 65 + n;
        v4u o; o.x = pk2(sp[0 * 65], sp[1 * 65]); o.y = pk2(sp[2 * 65], sp[3 * 65]); o.z = pk2(sp[4 * 65], sp[5 * 65]); o.w = pk2(sp[6 * 65], sp[7 * 65]);
        *(v4u*)(WT + (size_t)(row_off + n0 + n) * K + k0 + 8 * c) = o; }
    LDS_WAIT(); asm volatile("" ::: "memory");
}
__device__ __forceinline__ float wave_sum(float v) {
#pragma unroll
    for (int o = 1; o < 64; o <<= 1) v += __shfl_xor(v, o);
    return v;
}
__device__ __forceinline__ void rms_row_to_bf16(const float* xrow, const float* gain, bf16* orow, int lane) {
    const f32x4* xr = (const f32x4*)xrow + lane; const f32x4* gr = (const f32x4*)gain + lane;
    f32x4 v[8]; float s = 0.f;
#pragma unroll
    for (int j = 0; j < 8; ++j) { v[j] = __builtin_nontemporal_load(xr + 64 * j); s += (v[j].x * v[j].x + v[j].y * v[j].y) + (v[j].z * v[j].z + v[j].w * v[j].w); }
    const float rstd = rsqrtf(wave_sum(s) * (1.f / D) + EPS);
    unsigned long long* o8 = (unsigned long long*)orow + lane;
#pragma unroll
    for (int j = 0; j < 8; ++j) { const f32x4 g = gr[64 * j]; o8[64 * j] = (unsigned long long)pk2(v[j].x * rstd * g.x, v[j].y * rstd * g.y) | ((unsigned long long)pk2(v[j].z * rstd * g.z, v[j].w * rstd * g.w) << 32); }
}

struct EpiBf16 {
    static constexpr bool PERM = true, AFTER_DRAIN = false;
    bf16* O; int ldc;
    __device__ __forceinline__ void operator()(const f32x4 (&acc)[2][2][4][2], const pg8::Unit& u, int wr, int wc, int fr, int fq) const {
        const int row0 = u.pm * 256 + wr * 64 + fr, col0 = u.pn * 256 + wc * 32 + 8 * fq;
#pragma unroll
        for (int ai = 0; ai < 2; ++ai)
#pragma unroll
            for (int m = 0; m < 4; ++m) { bf16* rowp = O + (size_t)(row0 + ai * 128 + m * 16) * ldc + col0;
#pragma unroll
                for (int bj = 0; bj < 2; ++bj) { const f32x4 v0 = acc[ai][bj][m][0], v1 = acc[ai][bj][m][1];
                    v4u w; w.x = pg8::cvt_pk_bf16(v0[0], v0[1]); w.y = pg8::cvt_pk_bf16(v0[2], v0[3]); w.z = pg8::cvt_pk_bf16(v1[0], v1[1]); w.w = pg8::cvt_pk_bf16(v1[2], v1[3]);
                    *(v4u*)(rowp + bj * 128) = w; } }
    }
};
struct EpiProj {
    static constexpr bool PERM = true, AFTER_DRAIN = false;
    bf16* O; float* alr;
    __device__ __forceinline__ void operator()(const f32x4 (&acc)[2][2][4][2], const pg8::Unit& u, int wr, int wc, int fr, int fq) const {
        const int row0 = u.pm * 256 + wr * 64 + fr, col0 = u.pn * 256 + wc * 32 + 8 * fq;
#pragma unroll
        for (int ai = 0; ai < 2; ++ai)
#pragma unroll
            for (int m = 0; m < 4; ++m) { const int row = row0 + ai * 128 + m * 16; bf16* rowp = O + (size_t)row * PROJP + col0;
#pragma unroll
                for (int bj = 0; bj < 2; ++bj) { const f32x4 v0 = acc[ai][bj][m][0], v1 = acc[ai][bj][m][1];
                    v4u w; w.x = pg8::cvt_pk_bf16(v0[0], v0[1]); w.y = pg8::cvt_pk_bf16(v0[2], v0[3]); w.z = pg8::cvt_pk_bf16(v1[0], v1[1]); w.w = pg8::cvt_pk_bf16(v1[2], v1[3]);
                    *(v4u*)(rowp + bj * 128) = w; }
                if (u.pn == C_ALR / 256 && wc == 0 && fq < 2) { float* ap = alr + (size_t)row * GRANK + 8 * fq; *(f32x4*)ap = acc[ai][0][m][0]; *(f32x4*)(ap + 4) = acc[ai][0][m][1]; } }
    }
};

struct EpiResid {
    static constexpr bool PERM = true, AFTER_DRAIN = false;
    const float* R; const bf16* Rb; float* O; bf16* Ob; float* rowsq;
    __device__ __forceinline__ void operator()(const f32x4 (&acc)[2][2][4][2], const pg8::Unit& u, int wr, int wc, int fr, int fq) const {
        const int row0 = u.pm * 256 + wr * 64 + fr, col0 = u.pn * 256 + wc * 32 + 8 * fq;
#pragma unroll
        for (int ai = 0; ai < 2; ++ai) {
            f32x4 rr[4][2][2];
#pragma unroll
            for (int m = 0; m < 4; ++m) { const size_t off = (size_t)(row0 + ai * 128 + m * 16) * D + col0;
#pragma unroll
                for (int bj = 0; bj < 2; ++bj) {
                    if (R) { rr[m][bj][0] = __builtin_nontemporal_load((const f32x4*)(R + off + bj * 128)); rr[m][bj][1] = __builtin_nontemporal_load((const f32x4*)(R + off + bj * 128 + 4)); }
                    else { const v4u rb = *(const v4u*)(Rb + off + bj * 128); rr[m][bj][0] = (f32x4){__uint_as_float(rb.x << 16), __uint_as_float(rb.x & 0xffff0000u), __uint_as_float(rb.y << 16), __uint_as_float(rb.y & 0xffff0000u)};
                        rr[m][bj][1] = (f32x4){__uint_as_float(rb.z << 16), __uint_as_float(rb.z & 0xffff0000u), __uint_as_float(rb.w << 16), __uint_as_float(rb.w & 0xffff0000u)}; } } }
#pragma unroll
            for (int m = 0; m < 4; ++m) { const int row = row0 + ai * 128 + m * 16; const size_t off = (size_t)row * D + col0; float ss = 0.f;
#pragma unroll
                for (int bj = 0; bj < 2; ++bj) { const f32x4 v0 = acc[ai][bj][m][0] + rr[m][bj][0], v1 = acc[ai][bj][m][1] + rr[m][bj][1];
                    if (O) { *(f32x4*)(O + off + bj * 128) = v0; *(f32x4*)(O + off + bj * 128 + 4) = v1; }
                    ss += (v0[0] * v0[0] + v0[1] * v0[1]) + (v0[2] * v0[2] + v0[3] * v0[3]) + (v1[0] * v1[0] + v1[1] * v1[1]) + (v1[2] * v1[2] + v1[3] * v1[3]);
                    if (Ob) { v4u w; w.x = pg8::cvt_pk_bf16(v0[0], v0[1]); w.y = pg8::cvt_pk_bf16(v0[2], v0[3]); w.z = pg8::cvt_pk_bf16(v1[0], v1[1]); w.w = pg8::cvt_pk_bf16(v1[2], v1[3]);
                        *(v4u*)(Ob + off + bj * 128) = w; } }
                ss += __shfl_xor(ss, 16); ss += __shfl_xor(ss, 32);
                if (fq == 0) atomicAdd(rowsq + row, ss); }
            asm volatile("" ::: "memory"); }
    }
};
struct EpiRowScaleBf16 {
    static constexpr bool PERM = true, AFTER_DRAIN = false;
    bf16* O; const float* rowsq;
    __device__ __forceinline__ void operator()(const f32x4 (&acc)[2][2][4][2], const pg8::Unit& u, int wr, int wc, int fr, int fq) const {
        const int row0 = u.pm * 256 + wr * 64 + fr, col0 = u.pn * 256 + wc * 32 + 8 * fq;
#pragma unroll
        for (int ai = 0; ai < 2; ++ai)
#pragma unroll
            for (int m = 0; m < 4; ++m) { const int row = row0 + ai * 128 + m * 16; const float rs = rsqrtf(rowsq[row] * (1.0f / D) + EPS); bf16* rowp = O + (size_t)row * D + col0;
#pragma unroll
                for (int bj = 0; bj < 2; ++bj) { const f32x4 v0 = acc[ai][bj][m][0] * rs, v1 = acc[ai][bj][m][1] * rs;
                    v4u w; w.x = pg8::cvt_pk_bf16(v0[0], v0[1]); w.y = pg8::cvt_pk_bf16(v0[2], v0[3]); w.z = pg8::cvt_pk_bf16(v1[0], v1[1]); w.w = pg8::cvt_pk_bf16(v1[2], v1[3]);
                    *(v4u*)(rowp + bj * 128) = w; } }
    }
};

typedef __bf16 bf16x2_t __attribute__((ext_vector_type(2)));
typedef float f32x2_t __attribute__((ext_vector_type(2)));
typedef float f32x16 __attribute__((ext_vector_type(16)));
typedef short s16x4 __attribute__((ext_vector_type(4)));
__device__ __forceinline__ unsigned pkbf(float a, float b) { f32x2_t f = {a, b}; bf16x2_t h = __builtin_convertvector(f, bf16x2_t); return __builtin_bit_cast(unsigned, h); }
__device__ __forceinline__ unsigned offb(unsigned row, unsigned ch) { return 256u * row + 16u * (ch ^ (((row & 3u) << 2) | ((row >> 2) & 3u))); }
__device__ __forceinline__ void tr_read8(unsigned a0, unsigned a1, unsigned a2, unsigned a3, unsigned a4, unsigned a5, unsigned a6, unsigned a7,
                                         s16x4& r0, s16x4& r1, s16x4& r2, s16x4& r3, s16x4& r4, s16x4& r5, s16x4& r6, s16x4& r7) {
    asm volatile("ds_read_b64_tr_b16 %0, %8\n\tds_read_b64_tr_b16 %1, %9\n\tds_read_b64_tr_b16 %2, %10\n\tds_read_b64_tr_b16 %3, %11\n\t"
                 "ds_read_b64_tr_b16 %4, %12\n\tds_read_b64_tr_b16 %5, %13\n\tds_read_b64_tr_b16 %6, %14\n\tds_read_b64_tr_b16 %7, %15\n\ts_waitcnt lgkmcnt(0)"
                 : "=&v"(r0), "=&v"(r1), "=&v"(r2), "=&v"(r3), "=&v"(r4), "=&v"(r5), "=&v"(r6), "=&v"(r7)
                 : "v"(a0), "v"(a1), "v"(a2), "v"(a3), "v"(a4), "v"(a5), "v"(a6), "v"(a7) : "memory");
}
__device__ __forceinline__ void sb_wave_unit(LAS unsigned char* wl, const bf16* __restrict__ proj, const float* __restrict__ gain, bf16* __restrict__ cat, int b, int hd, int qi, int lane) {
    const int r = lane & 31, h = lane >> 5, t = 32 * qi + r;
    const size_t rowq = (size_t)(b * SEQ + t) * PROJP;
    bf16x8 Bq[8];
#pragma unroll
    for (int ks = 0; ks < 8; ++ks) Bq[ks] = *(const bf16x8*)(proj + rowq + C_QSB + hd * SBD + 16 * ks + 8 * h);
    f32x16 O[4];
#pragma unroll
    for (int db = 0; db < 4; ++db)
#pragma unroll
        for (int i = 0; i < 16; ++i) O[db][i] = 0.f;
    float R = 1.0f;
    const unsigned lbase = (unsigned)(size_t)wl;
    const int srow = lane >> 4, sch = lane & 15;
    v4u sreg[8];
    { const bf16* src = proj + (size_t)(b * SEQ + 32 * qi + srow) * PROJP + hd * SBD + sch * 8 + C_KSB;
#pragma unroll
      for (int i = 0; i < 8; ++i) sreg[i] = *(const v4u*)(src + (size_t)(4 * i) * PROJP); }
    const unsigned blk = (lane >> 4) & 1, q4 = (lane & 15) >> 2, p4 = lane & 3;
    const float cexp = 0.08838834764831845f * 1.4426950408889634f;
    for (int kt = qi; kt >= 0; --kt) {
#pragma unroll
        for (int i = 0; i < 8; ++i) *(LAS v4u*)(wl + offb(4 * i + srow, sch)) = sreg[i];
        { const bf16* src = proj + (size_t)(b * SEQ + 32 * kt + srow) * PROJP + hd * SBD + sch * 8 + C_VSB;
#pragma unroll
          for (int i = 0; i < 8; ++i) sreg[i] = *(const v4u*)(src + (size_t)(4 * i) * PROJP); }
        asm volatile("s_waitcnt lgkmcnt(0)" ::: "memory");
        f32x16 S;
#pragma unroll
        for (int i = 0; i < 16; ++i) S[i] = 0.f;
#pragma unroll
        for (int ks = 0; ks < 8; ++ks) { const bf16x8 Kf = *(const LAS bf16x8*)(wl + offb(r, 2 * ks + h)); S = __builtin_amdgcn_mfma_f32_32x32x16_bf16(Kf, Bq[ks], S, 0, 0, 0); }
        float w[16], keep[16];
        const bool diag = (kt == qi);
#pragma unroll
        for (int i = 0; i < 16; ++i) { const int key = (i & 3) + 8 * (i >> 2) + 4 * h;
            const float e = __builtin_amdgcn_exp2f(fminf(S[i] * cexp, 115.f)); const float kp = __builtin_amdgcn_rcpf(1.f + e);
            const bool ok = !diag || key < r;
            keep[i] = ok ? kp : 1.f; w[i] = ok ? e * kp : 0.f; }
        float tot[4], oth[4], sf[16];
#pragma unroll
        for (int g = 0; g < 4; ++g) { sf[4 * g + 3] = 1.f; sf[4 * g + 2] = keep[4 * g + 3]; sf[4 * g + 1] = sf[4 * g + 2] * keep[4 * g + 2]; sf[4 * g] = sf[4 * g + 1] * keep[4 * g + 1]; tot[g] = sf[4 * g] * keep[4 * g]; }
#pragma unroll
        for (int g = 0; g < 4; ++g) oth[g] = __shfl_xor(tot[g], 32);
        float Cg[4]; Cg[3] = R; Cg[2] = Cg[3] * (tot[3] * oth[3]); Cg[1] = Cg[2] * (tot[2] * oth[2]); Cg[0] = Cg[1] * (tot[1] * oth[1]);
        R = Cg[0] * (tot[0] * oth[0]);
#pragma unroll
        for (int g = 0; g < 4; ++g) { const float E = h ? Cg[g] : Cg[g] * oth[g];
#pragma unroll
            for (int p = 0; p < 4; ++p) w[4 * g + p] = w[4 * g + p] * (sf[4 * g + p] * E); }
#pragma unroll
        for (int i = 0; i < 8; ++i) *(LAS v4u*)(wl + 8192 + offb(4 * i + srow, sch)) = sreg[i];
        if (kt > 0) { const bf16* src = proj + (size_t)(b * SEQ + 32 * (kt - 1) + srow) * PROJP + hd * SBD + sch * 8 + C_KSB;
#pragma unroll
            for (int i = 0; i < 8; ++i) sreg[i] = *(const v4u*)(src + (size_t)(4 * i) * PROJP); }
        asm volatile("s_waitcnt lgkmcnt(0)" ::: "memory");
#pragma unroll
        for (int s2 = 0; s2 < 2; ++s2) {
            v4u wp; wp.x = pkbf(w[8 * s2], w[8 * s2 + 1]); wp.y = pkbf(w[8 * s2 + 2], w[8 * s2 + 3]); wp.z = pkbf(w[8 * s2 + 4], w[8 * s2 + 5]); wp.w = pkbf(w[8 * s2 + 6], w[8 * s2 + 7]);
            const bf16x8 Wf = __builtin_bit_cast(bf16x8, wp);
            s16x4 v0a, v0b, v1a, v1b, v2a, v2b, v3a, v3b;
            const unsigned rb0 = 16 * s2 + 4 * h + q4, rb1 = rb0 + 8, cb = 2 * blk + (p4 >> 1), bo = lbase + 8192 + 8 * (p4 & 1);
            tr_read8(bo + offb(rb0, cb), bo + offb(rb1, cb), bo + offb(rb0, 4 + cb), bo + offb(rb1, 4 + cb), bo + offb(rb0, 8 + cb), bo + offb(rb1, 8 + cb), bo + offb(rb0, 12 + cb), bo + offb(rb1, 12 + cb),
                     v0a, v0b, v1a, v1b, v2a, v2b, v3a, v3b);
            O[0] = __builtin_amdgcn_mfma_f32_32x32x16_bf16(__builtin_shufflevector(v0a, v0b, 0, 1, 2, 3, 4, 5, 6, 7), Wf, O[0], 0, 0, 0);
            O[1] = __builtin_amdgcn_mfma_f32_32x32x16_bf16(__builtin_shufflevector(v1a, v1b, 0, 1, 2, 3, 4, 5, 6, 7), Wf, O[1], 0, 0, 0);
            O[2] = __builtin_amdgcn_mfma_f32_32x32x16_bf16(__builtin_shufflevector(v2a, v2b, 0, 1, 2, 3, 4, 5, 6, 7), Wf, O[2], 0, 0, 0);
            O[3] = __builtin_amdgcn_mfma_f32_32x32x16_bf16(__builtin_shufflevector(v3a, v3b, 0, 1, 2, 3, 4, 5, 6, 7), Wf, O[3], 0, 0, 0);
        }
        if (__all(R == 0.f)) break;
    }
    float ss = 0.f;
#pragma unroll
    for (int db = 0; db < 4; ++db)
#pragma unroll
        for (int i = 0; i < 16; ++i) ss += O[db][i] * O[db][i];
    ss += __shfl_xor(ss, 32);
    const float rs = rsqrtf(ss * (1.0f / SBD) + EPS);
    bf16* orow = cat + (size_t)(b * SEQ + t) * D + hd * SBD;
#pragma unroll
    for (int db = 0; db < 4; ++db)
#pragma unroll
        for (int g = 0; g < 4; ++g) { const int d = 32 * db + 8 * g + 4 * h; const f32x4 gv = *(const f32x4*)(gain + hd * SBD + d);
            v2u o; o.x = pkbf(O[db][4 * g] * rs * gv[0], O[db][4 * g + 1] * rs * gv[1]); o.y = pkbf(O[db][4 * g + 2] * rs * gv[2], O[db][4 * g + 3] * rs * gv[3]);
            *(v2u*)(orow + d) = o; }
}

__device__ __forceinline__ void sb_wg_unit(LAS unsigned char* sm0, const bf16* __restrict__ proj, const float* __restrict__ gain, bf16* __restrict__ cat, int item, int wave, int lane) {
    const int qg = (SEQ / 256 - 1) - item / (BATCH * SBH), bh = item % (BATCH * SBH), b = bh / SBH, hd = bh % SBH;
    LAS unsigned char* sm = sm0;
    LAS int* doneAt = (LAS int*)(sm0 + RING_BYTES + 8192);
    const int qi = 8 * qg + wave, r = lane & 31, h = lane >> 5, t = 32 * qi + r;
    const size_t rowq = (size_t)(b * SEQ + t) * PROJP;
    bf16x8 Bq[8];
#pragma unroll
    for (int ks = 0; ks < 8; ++ks) Bq[ks] = *(const bf16x8*)(proj + rowq + C_QSB + hd * SBD + 16 * ks + 8 * h);
    f32x16 O[4];
#pragma unroll
    for (int db = 0; db < 4; ++db)
#pragma unroll
        for (int i = 0; i < 16; ++i) O[db][i] = 0.f;
    float R = 1.0f; bool done = false;
    const int prow0 = 4 * wave + (lane >> 4); const unsigned sw0 = (unsigned)((((lane >> 4) & 3) << 2) | (wave & 3));
    const unsigned pch0 = (unsigned)(lane & 15) ^ sw0;
    const bf16* kv0 = proj + (size_t)(b * SEQ + prow0) * PROJP + hd * SBD;
    __syncthreads();
    if (lane == 0) doneAt[wave] = -1;
#define SBW_DMA(kt_) do { int kq_ = (kt_); asm volatile("" : "+s"(kq_)); const unsigned st_ = (unsigned)(kq_ % 9) * 16384u + (unsigned)wave * 1024u; const size_t ro_ = (size_t)(32 * kq_) * PROJP; \
        __builtin_amdgcn_global_load_lds((const unsigned*)(kv0 + ro_ + C_KSB + pch0 * 8), (LAS unsigned*)(sm + st_), 16, 0, 0); \
        __builtin_amdgcn_global_load_lds((const unsigned*)(kv0 + ro_ + C_VSB + pch0 * 8), (LAS unsigned*)(sm + st_ + 8192), 16, 0, 0); } while (0)
    const int ktop = 8 * qg + 7;
#pragma unroll
    for (int i = 0; i < 8; ++i) SBW_DMA(ktop - i);
    const unsigned blk = (lane >> 4) & 1, q4 = (lane & 15) >> 2, p4 = lane & 3;
    const float cexp = 0.08838834764831845f * 1.4426950408889634f;
    for (int s = 0; ; ++s) {
        asm volatile("s_waitcnt vmcnt(0) lgkmcnt(0)" ::: "memory");
        __builtin_amdgcn_s_barrier(); asm volatile("" ::: "memory");
        { int nd = 0;
#pragma unroll
          for (int w8 = 0; w8 < 8; ++w8) { const int da = doneAt[w8]; nd += (da >= 0 && da < s) ? 1 : 0; }
          if (nd == 8) break; }
        { const int knew = ktop - 8 - s; if (knew >= 0) SBW_DMA(knew); }
        const int kt = qi - s;
        if (!done) {
            int kq = kt; asm volatile("" : "+s"(kq));
            LAS unsigned char* Kt = sm + (kq % 9) * 16384; const unsigned vb = (unsigned)(size_t)Kt + 8192u;
            f32x16 S;
#pragma unroll
            for (int i = 0; i < 16; ++i) S[i] = 0.f;
#pragma unroll
            for (int ks = 0; ks < 8; ++ks) { const bf16x8 Kf = *(const LAS bf16x8*)(Kt + offb(r, 2 * ks + h)); S = __builtin_amdgcn_mfma_f32_32x32x16_bf16(Kf, Bq[ks], S, 0, 0, 0); }
            float w[16], keep[16];
            const bool diag = (s == 0);
#pragma unroll
            for (int i = 0; i < 16; ++i) { const int key = (i & 3) + 8 * (i >> 2) + 4 * h;
                const float e = __builtin_amdgcn_exp2f(fminf(S[i] * cexp, 115.f)); const float kp = __builtin_amdgcn_rcpf(1.f + e);
                const bool ok = !diag || key < r;
                keep[i] = ok ? kp : 1.f; w[i] = ok ? e * kp : 0.f; }
            float tot[4], oth[4], sf[16];
#pragma unroll
            for (int g = 0; g < 4; ++g) { sf[4 * g + 3] = 1.f; sf[4 * g + 2] = keep[4 * g + 3]; sf[4 * g + 1] = sf[4 * g + 2] * keep[4 * g + 2]; sf[4 * g] = sf[4 * g + 1] * keep[4 * g + 1]; tot[g] = sf[4 * g] * keep[4 * g]; }
#pragma unroll
            for (int g = 0; g < 4; ++g) oth[g] = __shfl_xor(tot[g], 32);
            float Cg[4]; Cg[3] = R; Cg[2] = Cg[3] * (tot[3] * oth[3]); Cg[1] = Cg[2] * (tot[2] * oth[2]); Cg[0] = Cg[1] * (tot[1] * oth[1]);
            R = Cg[0] * (tot[0] * oth[0]);
#pragma unroll
            for (int g = 0; g < 4; ++g) { const float E = h ? Cg[g] : Cg[g] * oth[g];
#pragma unroll
                for (int p = 0; p < 4; ++p) w[4 * g + p] = w[4 * g + p] * (sf[4 * g + p] * E); }
#pragma unroll
            for (int s2 = 0; s2 < 2; ++s2) {
                v4u wp; wp.x = pkbf(w[8 * s2], w[8 * s2 + 1]); wp.y = pkbf(w[8 * s2 + 2], w[8 * s2 + 3]); wp.z = pkbf(w[8 * s2 + 4], w[8 * s2 + 5]); wp.w = pkbf(w[8 * s2 + 6], w[8 * s2 + 7]);
                const bf16x8 Wf = __builtin_bit_cast(bf16x8, wp);
                s16x4 v0a, v0b, v1a, v1b, v2a, v2b, v3a, v3b;
                const unsigned rb0 = 16 * s2 + 4 * h + q4, rb1 = rb0 + 8, cb = 2 * blk + (p4 >> 1), bo = vb + 8 * (p4 & 1);
                tr_read8(bo + offb(rb0, cb), bo + offb(rb1, cb), bo + offb(rb0, 4 + cb), bo + offb(rb1, 4 + cb), bo + offb(rb0, 8 + cb), bo + offb(rb1, 8 + cb), bo + offb(rb0, 12 + cb), bo + offb(rb1, 12 + cb),
                         v0a, v0b, v1a, v1b, v2a, v2b, v3a, v3b);
                O[0] = __builtin_amdgcn_mfma_f32_32x32x16_bf16(__builtin_shufflevector(v0a, v0b, 0, 1, 2, 3, 4, 5, 6, 7), Wf, O[0], 0, 0, 0);
                O[1] = __builtin_amdgcn_mfma_f32_32x32x16_bf16(__builtin_shufflevector(v1a, v1b, 0, 1, 2, 3, 4, 5, 6, 7), Wf, O[1], 0, 0, 0);
                O[2] = __builtin_amdgcn_mfma_f32_32x32x16_bf16(__builtin_shufflevector(v2a, v2b, 0, 1, 2, 3, 4, 5, 6, 7), Wf, O[2], 0, 0, 0);
                O[3] = __builtin_amdgcn_mfma_f32_32x32x16_bf16(__builtin_shufflevector(v3a, v3b, 0, 1, 2, 3, 4, 5, 6, 7), Wf, O[3], 0, 0, 0);
            }
            if (__all(R < 5.0e-20f) || kt == 0) { done = true; if (lane == 0) doneAt[wave] = s; }
        }
    }
#undef SBW_DMA
    asm volatile("s_waitcnt vmcnt(0)" ::: "memory");
    float ss = 0.f;
#pragma unroll
    for (int db = 0; db < 4; ++db)
#pragma unroll
        for (int i = 0; i < 16; ++i) ss += O[db][i] * O[db][i];
    ss += __shfl_xor(ss, 32);
    const float rs = rsqrtf(ss * (1.0f / SBD) + EPS);
    bf16* orow = cat + (size_t)(b * SEQ + t) * D + hd * SBD;
#pragma unroll
    for (int db = 0; db < 4; ++db) { unsigned w[4][2];
#pragma unroll
        for (int g = 0; g < 4; ++g) { const int d = 32 * db + 8 * g + 4 * h; const f32x4 gv = *(const f32x4*)(gain + hd * SBD + d);
            w[g][0] = pkbf(O[db][4 * g] * rs * gv[0], O[db][4 * g + 1] * rs * gv[1]); w[g][1] = pkbf(O[db][4 * g + 2] * rs * gv[2], O[db][4 * g + 3] * rs * gv[3]); }
        const v2u s0 = __builtin_amdgcn_permlane32_swap(w[0][0], w[1][0], false, false), s1 = __builtin_amdgcn_permlane32_swap(w[0][1], w[1][1], false, false);
        const v2u s2 = __builtin_amdgcn_permlane32_swap(w[2][0], w[3][0], false, false), s3 = __builtin_amdgcn_permlane32_swap(w[2][1], w[3][1], false, false);
        *(v4u*)(orow + 32 * db + 8 * h) = (v4u){s0.x, s1.x, s0.y, s1.y}; *(v4u*)(orow + 32 * db + 16 + 8 * h) = (v4u){s2.x, s3.x, s2.y, s3.y}; }
}

struct MktSched { const char* KV; const char* WqN; unsigned ldb; int K, G, c;
    __device__ __forceinline__ bool next(int i, pg8::Unit& u) const { const int L = i * G + c; if (L >= 128) return false; const int b = L >> 5, h = (L >> 3) & 3, kt = L & 7;
        u.pm = b * 4 + h; u.pn = kt; u.z = L; u.mv = 256; u.A = KV + ((size_t)(b * MEM) * 2 * D + h * XD) * 2; u.B = WqN + ((size_t)(kt * 256) * D + h * XD) * 2; return true; }
    __device__ __forceinline__ unsigned arow(const pg8::Unit&, int r) const { return (unsigned)r * (2 * D * 2); }
    __device__ __forceinline__ void a_ready(const pg8::Unit&) const {}
    __device__ __forceinline__ void done(const pg8::Unit&) const {} };
struct NvtSched { const char* WoT; const char* KV; unsigned ldb; int K, G, c;
    __device__ __forceinline__ bool next(int i, pg8::Unit& u) const { const int L = i * G + c; if (L >= 128) return false; const int b = L >> 5, h = (L >> 3) & 3, nt = L & 7;
        u.pm = b * 8 + nt; u.pn = h; u.z = L; u.mv = 256; u.A = WoT + ((size_t)(nt * 256) * D + h * XD) * 2; u.B = KV + ((size_t)(b * MEM) * 2 * D + D + h * XD) * 2; return true; }
    __device__ __forceinline__ unsigned arow(const pg8::Unit&, int r) const { return (unsigned)r * (D * 2); }
    __device__ __forceinline__ void a_ready(const pg8::Unit&) const {}
    __device__ __forceinline__ void done(const pg8::Unit&) const {} };
struct XLogitSched { const char* X1; const char* MKT; unsigned ldb; int K, G, c;
    __device__ __forceinline__ bool next(int i, pg8::Unit& u) const { const int Lr = i * G + c; if (Lr >= 128) return false; const int rp = 4 * (Lr & 7) + (Lr >> 5), h = (Lr >> 3) & 3, L = rp * 4 + h, b = rp >> 3, qt = rp & 7;
        u.pm = b * 8 + qt; u.pn = h; u.z = L; u.mv = 256; u.A = X1 + (size_t)(b * SEQ + qt * 256) * D * 2; u.B = MKT + (size_t)(b * 1024 + h * 256) * D * 2; return true; }
    __device__ __forceinline__ unsigned arow(const pg8::Unit&, int r) const { return (unsigned)r * (D * 2); }
    __device__ __forceinline__ void a_ready(const pg8::Unit&) const {}
    __device__ __forceinline__ void done(const pg8::Unit&) const {} };
struct EpiSoftmaxP {
    static constexpr bool PERM = true, AFTER_DRAIN = false;
    bf16* P; LAS float* tab; const float* rowsq;
    __device__ __forceinline__ void operator()(const f32x4 (&acc)[2][2][4][2], const pg8::Unit& u, int wr, int wc, int fr, int fq) const {
        const float sc = 0.044194173824159216f * 1.4426950408889634f;
        LAS float* Tm = tab; LAS float* Ts = tab + 1024;
        float rsc[2][4];
#pragma unroll
        for (int ai = 0; ai < 2; ++ai)
#pragma unroll
            for (int m = 0; m < 4; ++m) { rsc[ai][m] = sc * rsqrtf(rowsq[u.pm * 256 + ai * 128 + wr * 64 + m * 16 + fr] * (1.0f / D) + EPS); float v = -3.0e38f;
#pragma unroll
                for (int bj = 0; bj < 2; ++bj)
#pragma unroll
                    for (int n = 0; n < 2; ++n) { const f32x4 a = acc[ai][bj][m][n]; v = fmaxf(v, fmaxf(fmaxf(a[0], a[1]), fmaxf(a[2], a[3]))); }
                v = fmaxf(v, __shfl_xor(v, 16)); v = fmaxf(v, __shfl_xor(v, 32));
                if (fq == 0) Tm[(ai * 128 + wr * 64 + m * 16 + fr) * 4 + wc] = v; }
        asm volatile("s_waitcnt lgkmcnt(0)" ::: "memory"); __builtin_amdgcn_s_barrier(); asm volatile("" ::: "memory");
        float e[2][2][4][2][4];
#pragma unroll
        for (int ai = 0; ai < 2; ++ai)
#pragma unroll
            for (int m = 0; m < 4; ++m) { const f32x4 t4 = *(const LAS f32x4*)(Tm + (ai * 128 + wr * 64 + m * 16 + fr) * 4); const float k2 = rsc[ai][m], mr = fmaxf(fmaxf(t4[0], t4[1]), fmaxf(t4[2], t4[3])) * k2; float sacc = 0.f;
#pragma unroll
                for (int bj = 0; bj < 2; ++bj)
#pragma unroll
                    for (int n = 0; n < 2; ++n)
#pragma unroll
                        for (int j = 0; j < 4; ++j) { const float x = __builtin_amdgcn_exp2f(acc[ai][bj][m][n][j] * k2 - mr); e[ai][bj][m][n][j] = x; sacc += x; }
                sacc += __shfl_xor(sacc, 16); sacc += __shfl_xor(sacc, 32);
                if (fq == 0) Ts[(ai * 128 + wr * 64 + m * 16 + fr) * 4 + wc] = sacc; }
        asm volatile("s_waitcnt lgkmcnt(0)" ::: "memory"); __builtin_amdgcn_s_barrier(); asm volatile("" ::: "memory");
        const int col0 = u.pn * 256 + wc * 32 + 8 * fq;
#pragma unroll
        for (int ai = 0; ai < 2; ++ai)
#pragma unroll
            for (int m = 0; m < 4; ++m) { const int rl = ai * 128 + wr * 64 + m * 16 + fr; const f32x4 t4 = *(const LAS f32x4*)(Ts + rl * 4); const float inv = 1.0f / ((t4[0] + t4[1]) + (t4[2] + t4[3]));
                bf16* rowp = P + (size_t)(u.pm * 256 + rl) * 1024 + col0;
#pragma unroll
                for (int bj = 0; bj < 2; ++bj) { v4u w; w.x = pkbf(e[ai][bj][m][0][0] * inv, e[ai][bj][m][0][1] * inv); w.y = pkbf(e[ai][bj][m][0][2] * inv, e[ai][bj][m][0][3] * inv);
                    w.z = pkbf(e[ai][bj][m][1][0] * inv, e[ai][bj][m][1][1] * inv); w.w = pkbf(e[ai][bj][m][1][2] * inv, e[ai][bj][m][1][3] * inv); *(v4u*)(rowp + bj * 128) = w; } }
    }
};
struct EpiSoftmax128 {
    bf16* P; LAS float* tab; const float* rowsq;
    __device__ __forceinline__ void operator()(const f32x4 (&acc)[2][4][2], const pg8::Unit& u, int wr, int wc, int fr, int fq) const {
        const float sc = 0.044194173824159216f * 1.4426950408889634f;
        LAS float* Tm = tab; LAS float* Ts = tab + 512;
        float rsc[4];
#pragma unroll
        for (int m = 0; m < 4; ++m) { rsc[m] = sc * rsqrtf(rowsq[u.pm * 128 + wr * 64 + m * 16 + fr] * (1.0f / D) + EPS); float v = -3.0e38f;
#pragma unroll
            for (int bj = 0; bj < 2; ++bj)
#pragma unroll
                for (int n = 0; n < 2; ++n) { const f32x4 a = acc[bj][m][n]; v = fmaxf(v, fmaxf(fmaxf(a[0], a[1]), fmaxf(a[2], a[3]))); }
            v = fmaxf(v, __shfl_xor(v, 16)); v = fmaxf(v, __shfl_xor(v, 32));
            if (fq == 0) Tm[(wr * 64 + m * 16 + fr) * 4 + wc] = v; }
        asm volatile("s_waitcnt lgkmcnt(0)" ::: "memory"); __builtin_amdgcn_s_barrier(); asm volatile("" ::: "memory");
        float e[2][4][2][4];
#pragma unroll
        for (int m = 0; m < 4; ++m) { const f32x4 t4 = *(const LAS f32x4*)(Tm + (wr * 64 + m * 16 + fr) * 4); const float k2 = rsc[m], mr = fmaxf(fmaxf(t4[0], t4[1]), fmaxf(t4[2], t4[3])) * k2; float sacc = 0.f;
#pragma unroll
            for (int bj = 0; bj < 2; ++bj)
#pragma unroll
                for (int n = 0; n < 2; ++n)
#pragma unroll
                    for (int j = 0; j < 4; ++j) { const float x = __builtin_amdgcn_exp2f(acc[bj][m][n][j] * k2 - mr); e[bj][m][n][j] = x; sacc += x; }
            sacc += __shfl_xor(sacc, 16); sacc += __shfl_xor(sacc, 32);
            if (fq == 0) Ts[(wr * 64 + m * 16 + fr) * 4 + wc] = sacc; }
        asm volatile("s_waitcnt lgkmcnt(0)" ::: "memory"); __builtin_amdgcn_s_barrier(); asm volatile("" ::: "memory");
        const int col0 = u.pn * 256 + wc * 32 + 8 * fq;
#pragma unroll
        for (int m = 0; m < 4; ++m) { const int rl = wr * 64 + m * 16 + fr; const f32x4 t4 = *(const LAS f32x4*)(Ts + rl * 4); const float inv = 1.0f / ((t4[0] + t4[1]) + (t4[2] + t4[3]));
            bf16* rowp = P + (size_t)(u.pm * 128 + rl) * 1024 + col0;
#pragma unroll
            for (int bj = 0; bj < 2; ++bj) { v4u w; w.x = pkbf(e[bj][m][0][0] * inv, e[bj][m][0][1] * inv); w.y = pkbf(e[bj][m][0][2] * inv, e[bj][m][0][3] * inv);
                w.z = pkbf(e[bj][m][1][0] * inv, e[bj][m][1][1] * inv); w.w = pkbf(e[bj][m][1][2] * inv, e[bj][m][1][3] * inv); *(v4u*)(rowp + bj * 128) = w; } }
    }
};
struct XOutSched { const char* P; const char* NVT; unsigned ldb; int K, G, c;
    __device__ __forceinline__ bool next(int i, pg8::Unit& u) const { const int Lr = i * G + c; if (Lr >= 256) return false; const int rp = 4 * (Lr & 7) + (Lr >> 6), nt = (Lr >> 3) & 7, L = rp * 8 + nt, b = rp >> 3, qt = rp & 7;
        u.pm = b * 8 + qt; u.pn = nt; u.z = L; u.mv = 256; u.A = P + (size_t)(b * SEQ + qt * 256) * 1024 * 2; u.B = NVT + (size_t)(b * D + nt * 256) * 1024 * 2; return true; }
    __device__ __forceinline__ unsigned arow(const pg8::Unit&, int r) const { return (unsigned)r * (1024 * 2); }
    __device__ __forceinline__ void a_ready(const pg8::Unit&) const {}
    __device__ __forceinline__ void done(const pg8::Unit&) const {} };

template <int MODE>
__device__ __forceinline__ void moe_stream_unit(LAS unsigned char* lds, const char* __restrict__ Ab, unsigned lda, int ashift, const float* __restrict__ W0, const float* __restrict__ W1, int ldw, int K, int colbase,
                                                const int* __restrict__ list, int n_e, bf16* __restrict__ Out, const float* __restrict__ gate, int tid, int wave, int lane) {
    const int wr = wave >> 2, wc = wave & 3, r = lane & 31, h = lane >> 5;
    const int nt = K / 32;
    const unsigned blane = (unsigned)(((lane >> 5) * ldw + 4 * (lane & 31)) * 4);
    const char* Wg0 = (const char*)(W0 + colbase); const char* Wg1 = (MODE == 0) ? (const char*)(W1 + colbase) : (const char*)(W0 + colbase + 128);
    const unsigned a_base = (unsigned)(wr * 2048 + r * 64), a_sw0 = (unsigned)(((h ^ ((r >> 2) & 3)) & 3) << 4), a_sw1 = (unsigned)((((2 + h) ^ ((r >> 2) & 3)) & 3) << 4);
    const unsigned b_base = (unsigned)((h * 8 * 128 + 32 * wc + r) * 4);
    for (int base = 0; base < n_e; base += 320) {
        const int nrows = (n_e - base) < 320 ? (n_e - base) : 320, nblk = (nrows + 31) >> 5;
        __syncthreads();
        unsigned aoff[3];
#pragma unroll
        for (int i = 0; i < 3; ++i) { const int pc = (i < 2) ? (wave + 8 * i) : (16 + (wave & 3)); const int m = 16 * pc + (lane >> 2), mm = m < nrows ? m : nrows - 1; const int id = list[base + mm];
            aoff[i] = (unsigned)(id >> ashift) * lda + (unsigned)(((lane & 3) ^ ((m >> 2) & 3)) * 16); }
        f32x16 acc[5][2];
#pragma unroll
        for (int j = 0; j < 5; ++j)
#pragma unroll
            for (int nb = 0; nb < 2; ++nb)
#pragma unroll
                for (int i = 0; i < 16; ++i) acc[j][nb][i] = 0.f;
#define MS_DMAB(t) do { int tq_ = (t); asm volatile("" : "+s"(tq_)); const unsigned st_ = 40960u + (unsigned)(tq_ % 3) * 32768u + (unsigned)wave * 1024u; const size_t kro_ = ((size_t)tq_ * 32 + 2 * wave) * (size_t)ldw * 4; \
            __builtin_amdgcn_global_load_lds((const unsigned*)(Wg0 + kro_ + blane), (LAS unsigned*)(lds + st_), 16, 0, 2); \
            __builtin_amdgcn_global_load_lds((const unsigned*)(Wg0 + kro_ + (size_t)ldw * 64 + blane), (LAS unsigned*)(lds + st_ + 8192), 16, 0, 2); \
            __builtin_amdgcn_global_load_lds((const unsigned*)(Wg1 + kro_ + blane), (LAS unsigned*)(lds + st_ + 16384), 16, 0, 2); \
            __builtin_amdgcn_global_load_lds((const unsigned*)(Wg1 + kro_ + (size_t)ldw * 64 + blane), (LAS unsigned*)(lds + st_ + 24576), 16, 0, 2); } while (0)
#define MS_DMAA(t) do { int tq_ = (t); asm volatile("" : "+s"(tq_)); const unsigned st_ = (unsigned)(tq_ & 1) * 20480u; const char* ap_ = Ab + (size_t)tq_ * 64; \
            __builtin_amdgcn_global_load_lds((const unsigned*)(ap_ + aoff[0]), (LAS unsigned*)(lds + st_ + wave * 1024), 16, 0, 0); \
            __builtin_amdgcn_global_load_lds((const unsigned*)(ap_ + aoff[1]), (LAS unsigned*)(lds + st_ + (wave + 8) * 1024), 16, 0, 0); \
            __builtin_amdgcn_global_load_lds((const unsigned*)(ap_ + aoff[2]), (LAS unsigned*)(lds + st_ + (16 + (wave & 3)) * 1024), 16, 0, 0); } while (0)
        MS_DMAB(0); MS_DMAA(0); if (nt > 1) MS_DMAB(1);
        for (int t = 0; t < nt; ++t) {
            int tq = t; asm volatile("" : "+s"(tq));
            LAS unsigned char* Bs = lds + 40960 + (tq % 3) * 32768; LAS unsigned char* As = lds + (tq & 1) * 20480;
            if (t + 1 < nt) asm volatile("s_waitcnt vmcnt(4)" ::: "memory"); else asm volatile("s_waitcnt vmcnt(0)" ::: "memory");
            __builtin_amdgcn_s_barrier(); asm volatile("" ::: "memory");
            if (t + 1 < nt) MS_DMAA(t + 1);
            if (t + 2 < nt) MS_DMAB(t + 2);
            const LAS unsigned char* Ar = As + a_base; const LAS float* Br = (const LAS float*)(Bs + b_base);
#pragma unroll
            for (int ks = 0; ks < 2; ++ks) {
                bf16x8 Bf[2];
#pragma unroll
                for (int nb = 0; nb < 2; ++nb) { const LAS float* bp = Br + nb * 4096 + ks * 2048;
                    v4u w; w.x = pkbf(bp[0], bp[128]); w.y = pkbf(bp[256], bp[384]); w.z = pkbf(bp[512], bp[640]); w.w = pkbf(bp[768], bp[896]); Bf[nb] = __builtin_bit_cast(bf16x8, w); }
#pragma unroll
                for (int j = 0; j < 5; ++j) { const int mb = wr + 2 * j;
                    if (mb < nblk) { const bf16x8 Af = *(const LAS bf16x8*)(Ar + (ks ? a_sw1 : a_sw0) + j * 4096);
                        acc[j][0] = __builtin_amdgcn_mfma_f32_32x32x16_bf16(Bf[0], Af, acc[j][0], 0, 0, 0); acc[j][1] = __builtin_amdgcn_mfma_f32_32x32x16_bf16(Bf[1], Af, acc[j][1], 0, 0, 0); } }
            }
        }
#undef MS_DMAB
#undef MS_DMAA
#pragma unroll
        for (int j = 0; j < 5; ++j) { const int mb = wr + 2 * j, m = 32 * mb + r;
            if (mb < nblk && m < nrows) { const int pair = list[base + m];
                if (MODE == 0) {
#pragma unroll
                    for (int g = 0; g < 4; ++g) { float hv[4];
#pragma unroll
                        for (int p2 = 0; p2 < 4; ++p2) { const float gv = acc[j][0][4 * g + p2], uv = acc[j][1][4 * g + p2]; hv[p2] = gv / (1.f + __expf(-gv)) * uv; }
                        v2u w; w.x = pkbf(hv[0], hv[1]); w.y = pkbf(hv[2], hv[3]); *(v2u*)(Out + (size_t)pair * FF + colbase + 32 * wc + 8 * g + 4 * h) = w; }
                } else { const float gt = gate[pair];
#pragma unroll
                    for (int nb = 0; nb < 2; ++nb)
#pragma unroll
                        for (int g = 0; g < 4; ++g) { v2u w; w.x = pkbf(acc[j][nb][4 * g] * gt, acc[j][nb][4 * g + 1] * gt); w.y = pkbf(acc[j][nb][4 * g + 2] * gt, acc[j][nb][4 * g + 3] * gt);
                            *(v2u*)(Out + (size_t)pair * D + colbase + 128 * nb + 32 * wc + 8 * g + 4 * h) = w; } } } }
    }
}

template <int MODE> __device__ __forceinline__ int moe_expert(int u) { const int x8 = u & 7, y = u >> 3; return x8 * 8 + (MODE == 0 ? (y >> 2) : (y >> 3)); }
template <int MODE> __device__ __forceinline__ int moe_colbase(int u) { const int y = u >> 3; return MODE == 0 ? 128 * (y & 3) : 256 * (y & 7); }
__device__ __forceinline__ void moe_dma_b(LAS unsigned char* lds, const char* Wg0, const char* Wg1, int ldw, int tile, int stage, int wave, int lane) {
    int tq = tile; asm volatile("" : "+s"(tq));
    const unsigned blane = (unsigned)(((lane >> 5) * ldw + 4 * (lane & 31)) * 4);
    const unsigned st = 40960u + (unsigned)stage * 32768u + (unsigned)wave * 1024u; const size_t kro = ((size_t)tq * 32 + 2 * wave) * (size_t)ldw * 4;
    __builtin_amdgcn_global_load_lds((const unsigned*)(Wg0 + kro + blane), (LAS unsigned*)(lds + st), 16, 0, 2);
    __builtin_amdgcn_global_load_lds((const unsigned*)(Wg0 + kro + (size_t)ldw * 64 + blane), (LAS unsigned*)(lds + st + 8192), 16, 0, 2);
    __builtin_amdgcn_global_load_lds((const unsigned*)(Wg1 + kro + blane), (LAS unsigned*)(lds + st + 16384), 16, 0, 2);
    __builtin_amdgcn_global_load_lds((const unsigned*)(Wg1 + kro + (size_t)ldw * 64 + blane), (LAS unsigned*)(lds + st + 24576), 16, 0, 2);
}
template <int MODE> __device__ __forceinline__ void moe_wptr(const float* Wa, const float* Wb, int u, const char*& Wg0, const char*& Wg1) {
    const int e = moe_expert<MODE>(u), cb = moe_colbase<MODE>(u);
    if (MODE == 0) { Wg0 = (const char*)(Wa + (size_t)e * D * FF + cb); Wg1 = (const char*)(Wb + (size_t)e * D * FF + cb); }
    else { Wg0 = (const char*)(Wa + (size_t)e * FF * D + cb); Wg1 = Wg0 + 128 * 4; }
}
template <int MODE> __device__ __forceinline__ void moe_prefetch(LAS unsigned char* lds, const float* Wa, const float* Wb, int wave, int lane) {
    constexpr int NU = (MODE == 0) ? NE * 4 : NE * 8, ldw = (MODE == 0) ? FF : D;
    if ((int)blockIdx.x < NU) { const char* w0; const char* w1; moe_wptr<MODE>(Wa, Wb, (int)blockIdx.x, w0, w1); moe_dma_b(lds, w0, w1, ldw, 0, 0, wave, lane); moe_dma_b(lds, w0, w1, ldw, 1, 1, wave, lane); }
}
template <int MODE>
__device__ __forceinline__ void moe_stream_wg(LAS unsigned char* lds, const char* __restrict__ Ab, unsigned lda, int ashift, const float* __restrict__ Wa, const float* __restrict__ Wb,
                                              const int* __restrict__ elist, const int* __restrict__ ecnt, bf16* __restrict__ Out, const float* __restrict__ gate, int G, bool pre, int tid, int wave, int lane) {
    constexpr int NU = (MODE == 0) ? NE * 4 : NE * 8, K = (MODE == 0) ? D : FF, ldw = (MODE == 0) ? FF : D, nt = K / 32;
    const int wr = wave >> 2, wc = wave & 3, r = lane & 31, h = lane >> 5;
    const unsigned a_base = (unsigned)(wr * 2048 + r * 64), a_sw0 = (unsigned)(((h ^ ((r >> 2) & 3)) & 3) << 4), a_sw1 = (unsigned)((((2 + h) ^ ((r >> 2) & 3)) & 3) << 4);
    const unsigned b_base = (unsigned)((h * 8 * 128 + 32 * wc + r) * 4);
    int u = (int)blockIdx.x, base = 0, ne = 0; bool have = false;
    for (; u < NU; u += G) { ne = ecnt[moe_expert<MODE>(u) * 64]; if (ne > 0) { have = true; break; } }
    if (pre && !(have && u == (int)blockIdx.x)) { asm volatile("s_waitcnt vmcnt(0)" ::: "memory"); pre = false; }
    if (!pre) __syncthreads();
    if (!have) return;
    const char* Wg0; const char* Wg1; moe_wptr<MODE>(Wa, Wb, u, Wg0, Wg1);
    if (!pre) { moe_dma_b(lds, Wg0, Wg1, ldw, 0, 0, wave, lane); moe_dma_b(lds, Wg0, Wg1, ldw, 1, 1, wave, lane); }
    int ph = 0;
    unsigned aoff[3], naoff[3];
#define MW_AOFF(dst, lst, bs, nr) do { _Pragma("unroll") for (int i = 0; i < 3; ++i) { const int pc = (i < 2) ? (wave + 8 * i) : (16 + (wave & 3)); const int m = 16 * pc + (lane >> 2), mm = m < (nr) ? m : (nr) - 1; const int id = (lst)[(bs) + mm]; \
            dst[i] = (unsigned)(id >> ashift) * lda + (unsigned)(((lane & 3) ^ ((m >> 2) & 3)) * 16); } } while (0)
#define MW_DMAA(t, ao) do { int tq_ = (t); asm volatile("" : "+s"(tq_)); const unsigned st_ = (unsigned)(tq_ & 1) * 20480u; const char* ap_ = Ab + (size_t)tq_ * 64; \
            __builtin_amdgcn_global_load_lds((const unsigned*)(ap_ + ao[0]), (LAS unsigned*)(lds + st_ + wave * 1024), 16, 0, 0); \
            __builtin_amdgcn_global_load_lds((const unsigned*)(ap_ + ao[1]), (LAS unsigned*)(lds + st_ + (wave + 8) * 1024), 16, 0, 0); \
            __builtin_amdgcn_global_load_lds((const unsigned*)(ap_ + ao[2]), (LAS unsigned*)(lds + st_ + (16 + (wave & 3)) * 1024), 16, 0, 0); } while (0)
    { const int nr0 = ne < 320 ? ne : 320; const int* l0 = elist + (size_t)moe_expert<MODE>(u) * NTOK; MW_AOFF(aoff, l0, 0, nr0); }
    MW_DMAA(0, aoff);
    for (;;) {
        const int* list = elist + (size_t)moe_expert<MODE>(u) * NTOK; const int colbase = moe_colbase<MODE>(u);
        const int nrows = (ne - base) < 320 ? (ne - base) : 320, nblk = (nrows + 31) >> 5;
        int nu = u, nbase = base + 320, nne = ne; bool hn = true;
        if (nbase >= ne) { hn = false; for (nu = u + G; nu < NU; nu += G) { nne = ecnt[moe_expert<MODE>(nu) * 64]; if (nne > 0) { hn = true; nbase = 0; break; } } }
        const char* nW0 = Wg0; const char* nW1 = Wg1;
        if (hn) { moe_wptr<MODE>(Wa, Wb, nu, nW0, nW1); const int nnr = (nne - nbase) < 320 ? (nne - nbase) : 320; const int* nl = elist + (size_t)moe_expert<MODE>(nu) * NTOK; MW_AOFF(naoff, nl, nbase, nnr); }
        f32x16 acc[5][2];
#pragma unroll
        for (int j = 0; j < 5; ++j)
#pragma unroll
            for (int nb = 0; nb < 2; ++nb)
#pragma unroll
                for (int i = 0; i < 16; ++i) acc[j][nb][i] = 0.f;
        for (int t = 0; t < nt; ++t) {
            int tq = t; asm volatile("" : "+s"(tq));
            const int sb = (ph + tq) % 3;
            LAS unsigned char* Bs = lds + 40960 + sb * 32768; LAS unsigned char* As = lds + (tq & 1) * 20480;
            if (t > 0 && (t + 1 < nt || hn)) asm volatile("s_waitcnt vmcnt(4)" ::: "memory"); else asm volatile("s_waitcnt vmcnt(0)" ::: "memory");
            __builtin_amdgcn_s_barrier(); asm volatile("" ::: "memory");
            if (t + 1 < nt) MW_DMAA(t + 1, aoff); else if (hn) MW_DMAA(0, naoff);
            if (t + 2 < nt) moe_dma_b(lds, Wg0, Wg1, ldw, t + 2, (ph + t + 2) % 3, wave, lane); else if (hn) moe_dma_b(lds, nW0, nW1, ldw, t + 2 - nt, (ph + t + 2) % 3, wave, lane);
            const LAS unsigned char* Ar = As + a_base; const LAS float* Br = (const LAS float*)(Bs + b_base);
#pragma unroll
            for (int ks = 0; ks < 2; ++ks) {
                bf16x8 Bf[2];
#pragma unroll
                for (int nb = 0; nb < 2; ++nb) { const LAS float* bp = Br + nb * 4096 + ks * 2048;
                    v4u w; w.x = pkbf(bp[0], bp[128]); w.y = pkbf(bp[256], bp[384]); w.z = pkbf(bp[512], bp[640]); w.w = pkbf(bp[768], bp[896]); Bf[nb] = __builtin_bit_cast(bf16x8, w); }
#pragma unroll
                for (int j = 0; j < 5; ++j) { const int mb = wr + 2 * j;
                    if (mb < nblk) { const bf16x8 Af = *(const LAS bf16x8*)(Ar + (ks ? a_sw1 : a_sw0) + j * 4096);
                        acc[j][0] = __builtin_amdgcn_mfma_f32_32x32x16_bf16(Bf[0], Af, acc[j][0], 0, 0, 0); acc[j][1] = __builtin_amdgcn_mfma_f32_32x32x16_bf16(Bf[1], Af, acc[j][1], 0, 0, 0); } }
            }
        }
#pragma unroll
        for (int j = 0; j < 5; ++j) { const int mb = wr + 2 * j, m = 32 * mb + r;
            if (mb < nblk) { const bool live = m < nrows; const int pair = list[base + (live ? m : nrows - 1)];
                if (MODE == 0) { unsigned w[4][2];
#pragma unroll
                    for (int g = 0; g < 4; ++g) { float hv[4];
#pragma unroll
                        for (int p2 = 0; p2 < 4; ++p2) { const float gv = acc[j][0][4 * g + p2], uv = acc[j][1][4 * g + p2]; hv[p2] = gv / (1.f + __expf(-gv)) * uv; }
                        w[g][0] = pkbf(hv[0], hv[1]); w[g][1] = pkbf(hv[2], hv[3]); }
                    const v2u s0 = __builtin_amdgcn_permlane32_swap(w[0][0], w[1][0], false, false), s1 = __builtin_amdgcn_permlane32_swap(w[0][1], w[1][1], false, false);
                    const v2u s2 = __builtin_amdgcn_permlane32_swap(w[2][0], w[3][0], false, false), s3 = __builtin_amdgcn_permlane32_swap(w[2][1], w[3][1], false, false);
                    if (live) { bf16* op = Out + (size_t)pair * FF + colbase + 32 * wc + 8 * h; *(v4u*)op = (v4u){s0.x, s1.x, s0.y, s1.y}; *(v4u*)(op + 16) = (v4u){s2.x, s3.x, s2.y, s3.y}; }
                } else { const float gt = gate[pair];
#pragma unroll
                    for (int nb = 0; nb < 2; ++nb) { unsigned w[4][2];
#pragma unroll
                        for (int g = 0; g < 4; ++g) { w[g][0] = pkbf(acc[j][nb][4 * g] * gt, acc[j][nb][4 * g + 1] * gt); w[g][1] = pkbf(acc[j][nb][4 * g + 2] * gt, acc[j][nb][4 * g + 3] * gt); }
                        const v2u s0 = __builtin_amdgcn_permlane32_swap(w[0][0], w[1][0], false, false), s1 = __builtin_amdgcn_permlane32_swap(w[0][1], w[1][1], false, false);
                        const v2u s2 = __builtin_amdgcn_permlane32_swap(w[2][0], w[3][0], false, false), s3 = __builtin_amdgcn_permlane32_swap(w[2][1], w[3][1], false, false);
                        if (live) { bf16* op = Out + (size_t)pair * D + colbase + 128 * nb + 32 * wc + 8 * h; *(v4u*)op = (v4u){s0.x, s1.x, s0.y, s1.y}; *(v4u*)(op + 16) = (v4u){s2.x, s3.x, s2.y, s3.y}; } } } } }
        if (!hn) break;
        u = nu; base = nbase; ne = nne; Wg0 = nW0; Wg1 = nW1; ph = (ph + nt) % 3;
#pragma unroll
        for (int i = 0; i < 3; ++i) aoff[i] = naoff[i];
    }
#undef MW_AOFF
#undef MW_DMAA
}

__device__ __forceinline__ float softplus_f(float z) { return fmaxf(z, 0.f) + log1pf(__expf(-fabsf(z))); }
__device__ __forceinline__ void tr_read2(unsigned a0, unsigned a1, s16x4& r0, s16x4& r1) {
    asm volatile("ds_read_b64_tr_b16 %0, %2\n\tds_read_b64_tr_b16 %1, %3\n\ts_waitcnt lgkmcnt(0)" : "=&v"(r0), "=&v"(r1) : "v"(a0), "v"(a1) : "memory");
}
__device__ __forceinline__ void gla_stage_v(LAS unsigned char* vt, const bf16* __restrict__ proj, size_t row0, int hd, int tid) {
#pragma unroll
    for (int i = 0; i < 4; ++i) { const int id = i * 512 + tid, row = id >> 5, ch = id & 31;
        const v4u x = *(const v4u*)(proj + (row0 + row) * PROJP + C_VG + hd * GDV + ch * 8);
        *(LAS v4u*)(vt + (ch >> 4) * 16384 + offb(row, ch & 15)) = x; }
}
__device__ __forceinline__ void gla_pass1_unit(LAS unsigned char* sm, const bf16* __restrict__ proj, const float* __restrict__ alr, const float* __restrict__ wg, const float* __restrict__ bg,
                                               bf16* __restrict__ qdg, bf16* __restrict__ kig, float* __restrict__ elg, bf16* __restrict__ Ug, int unit, int tid, int wave, int lane) {
    LAS unsigned char* vt = sm; LAS unsigned char* kit = sm + 32768; LAS float* ptot = (LAS float*)(sm + 49152);
    const int c = unit & 31, hd = (unit >> 5) & 3, b = unit >> 7;
    const size_t row0 = (size_t)b * SEQ + c * CHUNK;
    const int j = tid & 127, part = tid >> 7;
    __syncthreads();
    gla_stage_v(vt, proj, row0, hd, tid);
    LAS float* alds = ptot + 512;
    if (tid < 256) *(LAS f32x4*)(alds + tid * 4) = *(const f32x4*)(alr + row0 * GRANK + tid * 4);
    float wgr[GRANK];
#pragma unroll
    for (int r = 0; r < GRANK; ++r) wgr[r] = wg[r * 512 + hd * GDK + j];
    const float bj = bg[hd * GDK + j];
    __syncthreads();
    float cl[16]; float run = 0.f;
#pragma unroll
    for (int tt = 0; tt < 16; ++tt) { const LAS f32x4* ap = (const LAS f32x4*)(alds + (part * 16 + tt) * GRANK); const f32x4 a0 = ap[0], a1 = ap[1], a2 = ap[2], a3 = ap[3];
        float sacc = bj + ((a0[0] * wgr[0] + a0[1] * wgr[1]) + (a0[2] * wgr[2] + a0[3] * wgr[3])) + ((a1[0] * wgr[4] + a1[1] * wgr[5]) + (a1[2] * wgr[6] + a1[3] * wgr[7]))
                   + ((a2[0] * wgr[8] + a2[1] * wgr[9]) + (a2[2] * wgr[10] + a2[3] * wgr[11])) + ((a3[0] * wgr[12] + a3[1] * wgr[13]) + (a3[2] * wgr[14] + a3[3] * wgr[15]));
        run -= (fmaxf(-sacc, 0.f) + __logf(1.0f + __expf(-fabsf(sacc)))) * (1.0f / 16.0f); cl[tt] = run; }
    ptot[part * 128 + j] = run;
    __syncthreads();
    const float prefix = (part > 0 ? ptot[j] : 0.f) + (part > 1 ? ptot[128 + j] : 0.f) + (part > 2 ? ptot[256 + j] : 0.f);
    LAS float* cumt = alds + 1024;
#pragma unroll
    for (int tt = 0; tt < 16; ++tt) cumt[(part * 16 + tt) * 128 + j] = prefix + cl[tt];
    if (part == 3) elg[(size_t)unit * 128 + j] = __expf(prefix + run);
    __syncthreads();
#pragma unroll
    for (int i = 0; i < 2; ++i) { const int id = i * 512 + tid, t = id >> 4, cch = id & 15;
        const v4u q8 = *(const v4u*)(proj + (row0 + t) * PROJP + C_QG + hd * GDK + cch * 8), k8 = *(const v4u*)(proj + (row0 + t) * PROJP + C_KG + hd * GDK + cch * 8);
        const f32x4 c0 = *(const LAS f32x4*)(cumt + t * 128 + cch * 8), c1 = *(const LAS f32x4*)(cumt + t * 128 + cch * 8 + 4);
        v4u qo, ko;
#pragma unroll
        for (int e2 = 0; e2 < 4; ++e2) { const float ca = e2 < 2 ? c0[2 * e2] : c1[2 * e2 - 4], cb = e2 < 2 ? c0[2 * e2 + 1] : c1[2 * e2 - 3];
            const float ea = __expf(ca), eb = __expf(cb), ia = __builtin_amdgcn_rcpf(ea), ib = __builtin_amdgcn_rcpf(eb);
            const float qa = __uint_as_float(q8[e2] << 16), qb = __uint_as_float(q8[e2] & 0xffff0000u), ka = __uint_as_float(k8[e2] << 16), kb2 = __uint_as_float(k8[e2] & 0xffff0000u);
            qo[e2] = pkbf(qa * 0.08838834764831845f * ea, qb * 0.08838834764831845f * eb); ko[e2] = pkbf(ka * ia, kb2 * ib); }
        const size_t gi = (row0 + t) * 512 + hd * GDK + cch * 8;
        *(v4u*)(qdg + gi) = qo; *(v4u*)(kig + gi) = ko;
        *(LAS v4u*)(kit + offb(t, cch)) = ko; }
    __syncthreads();
    const unsigned vbase = (unsigned)(size_t)vt + (wave >> 2) * 16384, kbase = (unsigned)(size_t)kit;
    const unsigned h = lane >> 5, blk = (lane >> 4) & 1, q4 = (lane & 15) >> 2, p4 = lane & 3;
    f32x16 U[4];
#pragma unroll
    for (int db = 0; db < 4; ++db)
#pragma unroll
        for (int i = 0; i < 16; ++i) U[db][i] = 0.f;
#pragma unroll
    for (int ks = 0; ks < 4; ++ks) {
        const unsigned r0 = 16 * ks + 8 * h + q4, r1 = r0 + 4, cc = 2 * blk + (p4 >> 1), bo = 8 * (p4 & 1);
        s16x4 a0, a1; tr_read2(vbase + offb(r0, 4 * (wave & 3) + cc) + bo, vbase + offb(r1, 4 * (wave & 3) + cc) + bo, a0, a1);
        const bf16x8 Af = __builtin_shufflevector(a0, a1, 0, 1, 2, 3, 4, 5, 6, 7);
#pragma unroll
        for (int db = 0; db < 4; ++db) { s16x4 b0, b1; tr_read2(kbase + offb(r0, 4 * db + cc) + bo, kbase + offb(r1, 4 * db + cc) + bo, b0, b1);
            U[db] = __builtin_amdgcn_mfma_f32_32x32x16_bf16(Af, __builtin_shufflevector(b0, b1, 0, 1, 2, 3, 4, 5, 6, 7), U[db], 0, 0, 0); }
    }
    bf16* up = Ug + (size_t)unit * 32768;
#pragma unroll
    for (int db = 0; db < 4; ++db)
#pragma unroll
        for (int i = 0; i < 16; ++i) up[(size_t)(32 * wave + (i & 3) + 8 * (i >> 2) + 4 * h) * 128 + 32 * db + (lane & 31)] = f2bf(U[db][i]);
}
__device__ __forceinline__ void gla_pass3_pair(LAS unsigned char* sm, const bf16* __restrict__ proj, const bf16* __restrict__ qdg, const bf16* __restrict__ kig, const bf16* __restrict__ Sg,
                                               const float* __restrict__ gain, const float* __restrict__ br, bf16* __restrict__ cat, int unit0, int unit1, int tid, int wave, int lane) {
    LAS float* nt = (LAS float*)(sm + 65536);
    const int ug = wave >> 2, gwv = wave & 3, unit = ug ? unit1 : unit0;
    const int c = unit & 31, hd = (unit >> 5) & 3, b = unit >> 7;
    const size_t row0 = (size_t)b * SEQ + c * CHUNK;
    __syncthreads();
#pragma unroll
    for (int i = 0; i < 8; ++i) { const int id = i * 512 + tid, tl = id >> 11, rem = id & 2047, row = rem >> 5, ch = rem & 31; const int us = tl ? unit1 : unit0;
        const size_t r0s = (size_t)(us >> 7) * SEQ + (us & 31) * CHUNK; const int hs = (us >> 5) & 3;
        const v4u x = *(const v4u*)(proj + (r0s + row) * PROJP + C_VG + hs * GDV + ch * 8);
        *(LAS v4u*)(sm + tl * 32768 + (ch >> 4) * 16384 + offb(row, ch & 15)) = x; }
    LAS unsigned char* vt = sm + ug * 32768;
    const int tb = gwv & 1, dq2 = gwv >> 1, r = lane & 31, h = lane >> 5, t = 32 * tb + r;
    bf16x8 Bq[8];
#pragma unroll
    for (int ks = 0; ks < 8; ++ks) Bq[ks] = *(const bf16x8*)(qdg + (row0 + t) * 512 + hd * GDK + 16 * ks + 8 * h);
    f32x16 O[4];
#pragma unroll
    for (int dvb = 0; dvb < 4; ++dvb)
#pragma unroll
        for (int i = 0; i < 16; ++i) O[dvb][i] = 0.f;
    const bf16* Sp = Sg + (size_t)unit * 32768;
    bf16x8 Kf0[8];
#pragma unroll
    for (int ks = 0; ks < 8; ++ks) Kf0[ks] = *(const bf16x8*)(kig + (row0 + r) * 512 + hd * GDK + 16 * ks + 8 * h);
#pragma unroll
    for (int dvb = 0; dvb < 4; ++dvb)
#pragma unroll
        for (int ks = 0; ks < 8; ++ks) { const bf16x8 Sf = *(const bf16x8*)(Sp + (size_t)(32 * (4 * dq2 + dvb) + r) * 128 + 16 * ks + 8 * h);
            O[dvb] = __builtin_amdgcn_mfma_f32_32x32x16_bf16(Sf, Bq[ks], O[dvb], 0, 0, 0); }
    __syncthreads();
    const unsigned blk = (lane >> 4) & 1, q4 = (lane & 15) >> 2, p4 = lane & 3;
    for (int sb = 0; sb <= tb; ++sb) {
        f32x16 ST;
#pragma unroll
        for (int i = 0; i < 16; ++i) ST[i] = 0.f;
#pragma unroll
        for (int ks = 0; ks < 8; ++ks) { const bf16x8 Kf = (sb == 0) ? Kf0[ks] : *(const bf16x8*)(kig + (row0 + 32 * sb + r) * 512 + hd * GDK + 16 * ks + 8 * h);
            ST = __builtin_amdgcn_mfma_f32_32x32x16_bf16(Kf, Bq[ks], ST, 0, 0, 0); }
        const bool diag = (sb == tb);
        float w[16];
#pragma unroll
        for (int i = 0; i < 16; ++i) { const int sl = (i & 3) + 8 * (i >> 2) + 4 * h; w[i] = (!diag || sl <= r) ? ST[i] : 0.f; }
#pragma unroll
        for (int s2 = 0; s2 < 2; ++s2) {
            v4u wp; wp.x = pkbf(w[8 * s2], w[8 * s2 + 1]); wp.y = pkbf(w[8 * s2 + 2], w[8 * s2 + 3]); wp.z = pkbf(w[8 * s2 + 4], w[8 * s2 + 5]); wp.w = pkbf(w[8 * s2 + 6], w[8 * s2 + 7]);
            const bf16x8 Wf = __builtin_bit_cast(bf16x8, wp);
            const unsigned rb0 = 32 * sb + 16 * s2 + 4 * h + q4, rb1 = rb0 + 8, cb = 2 * blk + (p4 >> 1), bo = 8 * (p4 & 1);
            const unsigned base = (unsigned)(size_t)vt + dq2 * 16384 + bo;
            s16x4 v0a, v0b, v1a, v1b, v2a, v2b, v3a, v3b;
            tr_read8(base + offb(rb0, cb), base + offb(rb1, cb), base + offb(rb0, 4 + cb), base + offb(rb1, 4 + cb), base + offb(rb0, 8 + cb), base + offb(rb1, 8 + cb), base + offb(rb0, 12 + cb), base + offb(rb1, 12 + cb),
                     v0a, v0b, v1a, v1b, v2a, v2b, v3a, v3b);
            O[0] = __builtin_amdgcn_mfma_f32_32x32x16_bf16(__builtin_shufflevector(v0a, v0b, 0, 1, 2, 3, 4, 5, 6, 7), Wf, O[0], 0, 0, 0);
            O[1] = __builtin_amdgcn_mfma_f32_32x32x16_bf16(__builtin_shufflevector(v1a, v1b, 0, 1, 2, 3, 4, 5, 6, 7), Wf, O[1], 0, 0, 0);
            O[2] = __builtin_amdgcn_mfma_f32_32x32x16_bf16(__builtin_shufflevector(v2a, v2b, 0, 1, 2, 3, 4, 5, 6, 7), Wf, O[2], 0, 0, 0);
            O[3] = __builtin_amdgcn_mfma_f32_32x32x16_bf16(__builtin_shufflevector(v3a, v3b, 0, 1, 2, 3, 4, 5, 6, 7), Wf, O[3], 0, 0, 0);
        }
    }
    float ss = 0.f;
#pragma unroll
    for (int dvb = 0; dvb < 4; ++dvb)
#pragma unroll
        for (int i = 0; i < 16; ++i) ss += O[dvb][i] * O[dvb][i];
    ss += __shfl_xor(ss, 32);
    if (h == 0) nt[(ug * 64 + t) * 2 + dq2] = ss;
    __syncthreads();
    const float rs = rsqrtf((nt[(ug * 64 + t) * 2] + nt[(ug * 64 + t) * 2 + 1]) * (1.0f / GDV) + EPS);
#pragma unroll
    for (int dvb = 0; dvb < 4; ++dvb) { unsigned w[4][2];
#pragma unroll
        for (int g = 0; g < 4; ++g) { const int cidx = hd * GDV + 32 * (4 * dq2 + dvb) + 8 * g + 4 * h;
            const v2u rg = *(const v2u*)(proj + (row0 + t) * PROJP + C_RG + cidx); const f32x4 gv = *(const f32x4*)(gain + cidx), bv = *(const f32x4*)(br + cidx);
            const float rr[4] = {__uint_as_float(rg.x << 16) + bv[0], __uint_as_float(rg.x & 0xffff0000u) + bv[1], __uint_as_float(rg.y << 16) + bv[2], __uint_as_float(rg.y & 0xffff0000u) + bv[3]};
            float y[4];
#pragma unroll
            for (int i = 0; i < 4; ++i) y[i] = O[dvb][4 * g + i] * rs * gv[i] * (rr[i] / (1.f + __expf(-rr[i])));
            w[g][0] = pkbf(y[0], y[1]); w[g][1] = pkbf(y[2], y[3]); }
        const v2u s0 = __builtin_amdgcn_permlane32_swap(w[0][0], w[1][0], false, false), s1 = __builtin_amdgcn_permlane32_swap(w[0][1], w[1][1], false, false);
        const v2u s2 = __builtin_amdgcn_permlane32_swap(w[2][0], w[3][0], false, false), s3 = __builtin_amdgcn_permlane32_swap(w[2][1], w[3][1], false, false);
        bf16* op = cat + (row0 + t) * D + 1024 + hd * GDV + 32 * (4 * dq2 + dvb) + 8 * h;
        *(v4u*)op = (v4u){s0.x, s1.x, s0.y, s1.y}; *(v4u*)(op + 16) = (v4u){s2.x, s3.x, s2.y, s3.y}; }
}

__device__ __forceinline__ void proj_tail_item(LAS unsigned char* sm, const bf16* __restrict__ h0, const bf16* __restrict__ WinT, bf16* __restrict__ proj, int item, int tid, int wave, int lane) {
    LAS float* red = (LAS float*)sm;
    const int fr = lane & 15, kg = lane >> 4; const size_t row0 = (size_t)item * 64;
    f32x4 acc[4];
#pragma unroll
    for (int mt = 0; mt < 4; ++mt) acc[mt] = (f32x4){0.f, 0.f, 0.f, 0.f};
    __syncthreads();
#pragma unroll
    for (int ks = 0; ks < 8; ++ks) { const int k0 = 256 * wave + 32 * ks + 8 * kg;
        const bf16x8 Bf = *(const bf16x8*)(WinT + (size_t)(6144 + fr) * D + k0);
#pragma unroll
        for (int mt = 0; mt < 4; ++mt) { const bf16x8 Af = *(const bf16x8*)(h0 + (row0 + 16 * mt + fr) * D + k0); acc[mt] = __builtin_amdgcn_mfma_f32_16x16x32_bf16(Af, Bf, acc[mt], 0, 0, 0); } }
#pragma unroll
    for (int mt = 0; mt < 4; ++mt)
#pragma unroll
        for (int jj = 0; jj < 4; ++jj) red[(wave * 64 + 16 * mt + 4 * kg + jj) * 16 + fr] = acc[mt][jj];
    __syncthreads();
#pragma unroll
    for (int i = 0; i < 2; ++i) { const int o = i * 512 + tid; float a = 0.f;
#pragma unroll
        for (int w8 = 0; w8 < 8; ++w8) a += red[w8 * 1024 + o];
        proj[(row0 + (o >> 4)) * PROJP + 6144 + (o & 15)] = f2bf(a); }
}

struct Args { const float* in[24]; float* out; unsigned char* ws; int ph_lo, ph_hi; };
__global__ void __launch_bounds__(NWAVES * 64, 2) mk_fwd(Args args) {
    extern __shared__ __attribute__((aligned(16))) unsigned char lds[];
    Frame F;
    F.lds = (LAS unsigned char*)lds; F.MISC = (volatile LAS unsigned*)(F.lds + MISC_OFF);
    F.tid = threadIdx.x; F.lane = F.tid & 63; F.wave = __builtin_amdgcn_readfirstlane(F.tid >> 6);
    F.G = gridDim.x; { const int bx = blockIdx.x; F.vcu = (F.G % 8 == 0) ? (bx % 8) * (F.G / 8) + bx / 8 : bx; }
    F.ws = args.ws; F.ctl = (unsigned*)(args.ws + WS_CTL);
    for (int u = F.tid; u < (LDS_BYTES - LDSCTL_OFF) / 4; u += NWAVES * 64) ((LAS unsigned*)(F.lds + LDSCTL_OFF))[u] = 0u;
    __syncthreads();
    const int lo = args.ph_lo, hi = args.ph_hi;
    const bool multi = (hi - lo) > 1;
    XcdBarrier bar; bar.bar = F.ctl + CW_BAR; bar.x = 0; bar.st = nullptr;
    if (multi) bar = xcd_barrier_post(F.ctl + CW_BAR, F.MISC + 8);
#ifndef DUP_PHASE
#define DUP_PHASE -1
#endif
#define IN(k) (lo <= (k) && (k) < hi)
#define REP(k) for (int rep_ = 0; rep_ < ((DUP_PHASE) == (k) ? 2 : 1); ++rep_)
#define SEAM(k) do { if (IN(k) && IN((k) + 1)) xcd_barrier(bar); } while (0)
    const float* const* in = args.in;
    unsigned char* ws = args.ws;
    bf16* WinT = (bf16*)(ws + WS_WIN); bf16* WoutT = (bf16*)(ws + WS_WOUT); bf16* WxqT = (bf16*)(ws + WS_WXQ); bf16* WxkvT = (bf16*)(ws + WS_WXKV); bf16* WxoT = (bf16*)(ws + WS_WXO);
    bf16* h0 = (bf16*)(ws + WS_H0); bf16* hm = (bf16*)(ws + WS_HM); bf16* projb = (bf16*)(ws + WS_PROJ); float* alr = (float*)(ws + WS_ALR);
    bf16* KVb = (bf16*)(ws + WS_KV); bf16* MKT = (bf16*)(ws + WS_MKT); bf16* NVT = (bf16*)(ws + WS_NVT);
    bf16* catb = (bf16*)(ws + WS_CAT); float* x1 = (float*)(ws + WS_X1); bf16* x1b = (bf16*)(ws + WS_X1B); bf16* qx = (bf16*)(ws + WS_QX); bf16* oxb = (bf16*)(ws + WS_OX); bf16* x2b = (bf16*)(ws + WS_X2);
    bf16* Pb = (bf16*)(ws + WS_PB);
    bf16* hf = (bf16*)(ws + WS_HF); bf16* Hb = (bf16*)(ws + WS_HB); bf16* Yb = (bf16*)(ws + WS_YB);
    bf16* WrHi = (bf16*)(ws + WS_WR); bf16* WrLo = (bf16*)(ws + WS_WR + 512 * 1024); int* elist = (int*)(ws + WS_LIST); float* gatev = (float*)(ws + WS_GATE); int* ecnt = (int*)(F.ctl + CW_CNT);
    float* rowsq1 = (float*)(F.ctl + CW_ROWSQ1); float* rowsq2 = (float*)(F.ctl + CW_ROWSQ2);

    if (IN(0)) REP(0) {
        LAS float* scr = (LAS float*)(F.lds + RING_OFF + F.wave * 18432);
        const int gw = F.vcu * NWAVES + F.wave, NGW = F.G * NWAVES;
        constexpr int KB = D / 64;
        constexpr int I_IN = KB * ((PROJ + 63) / 64), I_KV = KB * (2 * D / 64);
        constexpr int NITEMS = I_IN + I_KV;
        for (int it = gw; it < NITEMS; it += NGW) {
            if (it < I_IN) p0_transpose_item(in[3], D, PROJ, PROJ, nullptr, WinT, 0, scr, it, F.lane);
            else p0_transpose_item(in[13], D, 2 * D, 2 * D, nullptr, WxkvT, 0, scr, it - I_IN, F.lane);
        }
        { const size_t z0 = (size_t)(((PROJ + 63) / 64) * 64) * D, z1 = (size_t)PROJP * D; v4u zz = {0u, 0u, 0u, 0u};
          for (size_t i = z0 / 8 + (size_t)blockIdx.x * 512 + F.tid; i < z1 / 8; i += (size_t)F.G * 512) ((v4u*)WinT)[i] = zz; }
        for (int i = blockIdx.x * 512 + F.tid; i < 80 * D; i += F.G * 512) { const int n = i / D, k = i % D; const float v = n < 8 ? in[16][k * 8 + n] : (n < 72 ? in[18][k * 64 + n - 8] : 0.f);
            const int j = ((((k >> 5) * 5 + (n >> 4)) * 64) + ((k & 31) >> 3) * 16 + (n & 15)) * 8 + (k & 7);
            const unsigned short hi = f2bf(v); WrHi[j] = hi; WrLo[j] = f2bf(v - bf2f(hi)); }
        for (int m = gw; m < NTOK; m += NGW) rms_row_to_bf16(in[0] + (size_t)m * D, in[2], h0 + (size_t)m * D, F.lane);
        for (int m = gw; m < NMEM; m += NGW) rms_row_to_bf16(in[1] + (size_t)m * D, in[11], hm + (size_t)m * D, F.lane);
    }
    SEAM(0);
    if (IN(1)) REP(1) {
        pg8::DenseSched S{(const char*)h0, (const char*)WinT, D * 2, D * 2, D, NTOK / 256, 24, F.G, (int)blockIdx.x};
        EpiProj E{projb, alr};
        pg8::gemm_phase<EpiProj, pg8::DenseSched, true>(F.lds + RING_OFF, S, E);
    }
    SEAM(1);
    if (IN(2)) REP(2) {
        { pg8::DenseSched S{(const char*)hm, (const char*)WxkvT, D * 2, D * 2, D, NMEM / 256, 2 * D / 256, F.G, (int)blockIdx.x};
          EpiBf16 E{KVb, 2 * D};
          pg8::gemm_phase<EpiBf16, pg8::DenseSched, true>(F.lds + RING_OFF, S, E); }
        { const int first = (F.G > 64 + 32) ? 64 : 0, nl = F.G - first, li = (int)blockIdx.x - first;
          if (li >= 0) { LAS float* scr = (LAS float*)(F.lds + RING_OFF + F.wave * 18432);
              constexpr int I_SQ = (D / 64) * (D / 64);
              for (int it = li * NWAVES + F.wave; it < 2 * I_SQ; it += nl * NWAVES) {
                  if (it < I_SQ) p0_transpose_item(in[9], D, D, D, nullptr, WoutT, 0, scr, it, F.lane);
                  else p0_transpose_item(in[14], D, D, D, nullptr, WxoT, 0, scr, it - I_SQ, F.lane); }
              for (int i = li * 512 + F.tid; i < D * D / 4; i += nl * 512) { const f32x4 v = ((const f32x4*)in[12])[i]; const float g = in[10][i / (D / 4)]; v2u o; o.x = pkbf(v[0] * g, v[1] * g); o.y = pkbf(v[2] * g, v[3] * g); ((v2u*)WxqT)[i] = o; } } }
        for (;;) {
            if (F.tid == 0) F.MISC[20] = (unsigned)__hip_atomic_fetch_add(F.ctl + CW_Q + 128, 1u, __ATOMIC_RELAXED, __HIP_MEMORY_SCOPE_AGENT);
            __syncthreads();
            const int item = (int)F.MISC[20];
            __syncthreads();
            if (item >= NTOK / 64) break;
            proj_tail_item(F.lds + RING_OFF, h0, WinT, projb, item, F.tid, F.wave, F.lane);
        }
        for (;;) {
            if (F.tid == 0) F.MISC[20] = (unsigned)__hip_atomic_fetch_add(F.ctl + CW_Q, 1u, __ATOMIC_RELAXED, __HIP_MEMORY_SCOPE_AGENT);
            __syncthreads();
            const int item = (int)F.MISC[20];
            __syncthreads();
            if (item >= 512) break;
            gla_pass1_unit(F.lds + RING_OFF, projb, alr, in[4], in[5], (bf16*)(ws + WS_GQD), (bf16*)(ws + WS_GKI), (float*)(ws + WS_GEL), (bf16*)(ws + WS_GU), item, F.tid, F.wave, F.lane);
        }
        for (;;) {
            if (F.tid == 0) F.MISC[20] = (unsigned)__hip_atomic_fetch_add(F.ctl + CW_Q + 64, 1u, __ATOMIC_RELAXED, __HIP_MEMORY_SCOPE_AGENT);
            __syncthreads();
            const int item = (int)F.MISC[20];
            __syncthreads();
            if (item >= BATCH * SBH * (SEQ / 32) / NWAVES) break;
            sb_wg_unit(F.lds + RING_OFF, projb, in[7], catb, item, F.wave, F.lane);
        }
    }
    SEAM(2);
    if (IN(3)) REP(3) {
        { MktSched S{(const char*)KVb, (const char*)WxqT, D * 2, XD, F.G, (int)blockIdx.x}; EpiBf16 E{MKT, D};
          pg8::gemm_phase<EpiBf16, MktSched, true>(F.lds + RING_OFF, S, E); }
        { NvtSched S{(const char*)WxoT, (const char*)KVb, 2 * D * 2, XD, F.G, ((int)blockIdx.x + F.G - 128) % F.G}; EpiBf16 E{NVT, 1024};
          pg8::gemm_phase<EpiBf16, NvtSched, true>(F.lds + RING_OFF, S, E); }
        const bf16* Ug = (const bf16*)(ws + WS_GU); const float* elg = (const float*)(ws + WS_GEL); bf16* Sg = (bf16*)(ws + WS_GS);
        for (int g = blockIdx.x * 512 + F.tid; g < BATCH * GH * 8192; g += F.G * 512) { const int bh = g >> 13, idx = g & 8191, dk = (idx & 31) * 4;
            f32x4 S4 = {0.f, 0.f, 0.f, 0.f};
#pragma unroll 8
            for (int c = 0; c < 32; ++c) { const size_t u = (size_t)bh * 32 + c; const v2u ub = __builtin_nontemporal_load((const v2u*)(Ug + u * 32768 + (size_t)idx * 4)); const f32x4 u4 = {__uint_as_float(ub.x << 16), __uint_as_float(ub.x & 0xffff0000u), __uint_as_float(ub.y << 16), __uint_as_float(ub.y & 0xffff0000u)}, e4 = *(const f32x4*)(elg + u * 128 + dk);
                v2u o; o.x = pkbf(S4[0], S4[1]); o.y = pkbf(S4[2], S4[3]); *(v2u*)(Sg + u * 32768 + (size_t)idx * 4) = o;
                S4 = (S4 + u4) * e4; } }
    }
    SEAM(3);
    if (IN(4)) REP(4) {
        for (int unit = blockIdx.x; unit < 512; unit += 2 * F.G)
            gla_pass3_pair(F.lds + RING_OFF, projb, (const bf16*)(ws + WS_GQD), (const bf16*)(ws + WS_GKI), (const bf16*)(ws + WS_GS), in[8], in[6], catb, unit, (unit + F.G < 512) ? unit + F.G : unit, F.tid, F.wave, F.lane);
    }
    SEAM(4);
    if (IN(5)) REP(5) {
        pg8::DenseSched S{(const char*)catb, (const char*)WoutT, D * 2, D * 2, D, NTOK / 256, D / 256, F.G, (int)blockIdx.x};
        EpiResid E{in[0], nullptr, nullptr, x1b, rowsq1};
        pg8::gemm_phase<EpiResid, pg8::DenseSched, false>(F.lds + RING_OFF, S, E);
    }
    SEAM(5);
    if (IN(6)) REP(6) {
        EpiSoftmax128 E{Pb, (LAS float*)(F.lds + LDSCTL_OFF + 1024), rowsq1};
        for (int c = blockIdx.x; c < 256; c += F.G) { const int hp = 8 * (c & 7) + (c >> 5), h = (c >> 3) & 3, b = hp >> 4;
            pg8::Unit u; u.pm = hp; u.pn = h; u.z = c; u.mv = 128; u.A = (const char*)x1b + (size_t)hp * 128 * D * 2; u.B = (const char*)MKT + (size_t)(b * 1024 + h * 256) * D * 2;
            pg8::gemm128_unit<EpiSoftmax128>(F.lds + RING_OFF, u.A, D * 2, u.B, D * 2, D, E, u); }
    }
    SEAM(6);
    if (IN(7)) REP(7) {
        XOutSched S{(const char*)Pb, (const char*)NVT, 1024 * 2, 1024, F.G, (int)blockIdx.x};
        EpiResid E{nullptr, x1b, nullptr, x2b, rowsq2};
        pg8::gemm_phase<EpiResid, XOutSched, false>(F.lds + RING_OFF, S, E);
    }
    SEAM(7);
    if (IN(8)) REP(8) {
        LAS float* red = (LAS float*)(F.lds + RING_OFF);
        LAS float* lg = (LAS float*)(F.lds + RING_OFF + 81920);
        const int kg = F.lane >> 4, fr = F.lane & 15;
        for (int tile = blockIdx.x; tile < NTOK / 32; tile += F.G) {
            const int row0 = tile * 32;
            f32x4 racc[2][5];
#pragma unroll
            for (int rt = 0; rt < 2; ++rt)
#pragma unroll
                for (int nt = 0; nt < 5; ++nt) racc[rt][nt] = (f32x4){0.f, 0.f, 0.f, 0.f};
            float rs[2];
#pragma unroll
            for (int rt = 0; rt < 2; ++rt) rs[rt] = rsqrtf(rowsq2[row0 + 16 * rt + fr] * (1.0f / D) + EPS);
            for (int kh = 0; kh < 4; ++kh) {
                v4u xa[2][2];
#pragma unroll
                for (int k4 = 0; k4 < 2; ++k4)
#pragma unroll
                    for (int rt = 0; rt < 2; ++rt) { const size_t ro = (size_t)(row0 + 16 * rt + fr) * D + 256 * F.wave + 32 * (2 * kh + k4) + 8 * kg; xa[k4][rt] = __builtin_nontemporal_load((const v4u*)(x2b + ro)); }
#pragma unroll
                for (int k4 = 0; k4 < 2; ++k4) {
                    const int k0 = 256 * F.wave + 32 * (2 * kh + k4) + 8 * kg;
                    const f32x4 g0 = *(const f32x4*)(in[15] + k0), g1 = *(const f32x4*)(in[15] + k0 + 4);
                    bf16x8 Ahi[2], Alo[2];
#pragma unroll
                    for (int rt = 0; rt < 2; ++rt) { const size_t ro = (size_t)(row0 + 16 * rt + fr) * D + k0; const v4u xb = xa[k4][rt]; const f32x4 a0 = {__uint_as_float(xb.x << 16), __uint_as_float(xb.x & 0xffff0000u), __uint_as_float(xb.y << 16), __uint_as_float(xb.y & 0xffff0000u)}, a1 = {__uint_as_float(xb.z << 16), __uint_as_float(xb.z & 0xffff0000u), __uint_as_float(xb.w << 16), __uint_as_float(xb.w & 0xffff0000u)};
                        float v[8]; v[0] = a0[0] * rs[rt] * g0[0]; v[1] = a0[1] * rs[rt] * g0[1]; v[2] = a0[2] * rs[rt] * g0[2]; v[3] = a0[3] * rs[rt] * g0[3];
                        v[4] = a1[0] * rs[rt] * g1[0]; v[5] = a1[1] * rs[rt] * g1[1]; v[6] = a1[2] * rs[rt] * g1[2]; v[7] = a1[3] * rs[rt] * g1[3];
                        v4u hp, lp;
#pragma unroll
                        for (int j = 0; j < 4; ++j) { const unsigned hpk = pkbf(v[2 * j], v[2 * j + 1]); hp[j] = hpk; lp[j] = pkbf(v[2 * j] - __uint_as_float(hpk << 16), v[2 * j + 1] - __uint_as_float(hpk & 0xffff0000u)); }
                        *(v4u*)(hf + ro) = hp; Ahi[rt] = __builtin_bit_cast(bf16x8, hp); Alo[rt] = __builtin_bit_cast(bf16x8, lp); }
#pragma unroll
                    for (int nt = 0; nt < 5; ++nt) { const size_t bo = (size_t)((((8 * F.wave + 2 * kh + k4) * 5 + nt) * 64 + F.lane) * 8); const bf16x8 Bh = *(const bf16x8*)(WrHi + bo), Bl = *(const bf16x8*)(WrLo + bo);
#pragma unroll
                        for (int rt = 0; rt < 2; ++rt) { racc[rt][nt] = __builtin_amdgcn_mfma_f32_16x16x32_bf16(Ahi[rt], Bh, racc[rt][nt], 0, 0, 0);
                            racc[rt][nt] = __builtin_amdgcn_mfma_f32_16x16x32_bf16(Alo[rt], Bh, racc[rt][nt], 0, 0, 0); racc[rt][nt] = __builtin_amdgcn_mfma_f32_16x16x32_bf16(Ahi[rt], Bl, racc[rt][nt], 0, 0, 0); } }
                }
            }
#pragma unroll
            for (int rt = 0; rt < 2; ++rt)
#pragma unroll
                for (int nt = 0; nt < 5; ++nt)
#pragma unroll
                    for (int j = 0; j < 4; ++j) red[(F.wave * 32 + 16 * rt + 4 * kg + j) * 80 + 16 * nt + fr] = racc[rt][nt][j];
            __syncthreads();
            for (int o = F.tid; o < 32 * 80; o += 512) { float a = 0.f;
#pragma unroll
                for (int w8 = 0; w8 < 8; ++w8) a += red[w8 * 2560 + o]; lg[o] = a; }
            __syncthreads();
            if (F.tid < 32) { const int tkn = row0 + F.tid; const LAS float* l = lg + F.tid * 80;
                int g = 0; float mg = l[0] + in[17][0];
                for (int i = 1; i < 8; ++i) { const float v = l[i] + in[17][i]; if (v > mg) { mg = v; g = i; } }
                float sg = 0.f; for (int i = 0; i < 8; ++i) sg += __expf(l[i] + in[17][i] - mg);
                const float ptop = 1.f / sg;
                int i1 = 0; float m1 = l[8 + g * 8] + in[19][g * 8];
                for (int i = 1; i < 8; ++i) { const float v = l[8 + g * 8 + i] + in[19][g * 8 + i]; if (v > m1) { m1 = v; i1 = i; } }
                int i2 = 0; float m2 = -3.4e38f;
                for (int i = 0; i < 8; ++i) { const float v = l[8 + g * 8 + i] + in[19][g * 8 + i]; if (i != i1 && v > m2) { m2 = v; i2 = i; } }
                const float rr = __expf(m2 - m1), w1 = 1.f / (1.f + rr), w2 = rr / (1.f + rr);
                const int e1 = g * 8 + i1, e2 = g * 8 + i2;
                const int s1 = atomicAdd(&ecnt[e1 * 64], 1), s2 = atomicAdd(&ecnt[e2 * 64], 1);
                elist[(size_t)e1 * NTOK + s1] = tkn * 2; gatev[tkn * 2] = ptop * w1;
                elist[(size_t)e2 * NTOK + s2] = tkn * 2 + 1; gatev[tkn * 2 + 1] = ptop * w2; }
            __syncthreads();
        }
    }
    const bool pre9 = IN(8) && IN(9), pre10 = IN(9) && IN(10);
    if (pre9) xcd_barrier_pf(bar, [&]() { moe_prefetch<0>(F.lds + RING_OFF, in[20], in[21], F.wave, F.lane); });
    if (IN(9)) REP(9) {
        moe_stream_wg<0>(F.lds + RING_OFF, (const char*)hf, D * 2, 1, in[20], in[21], elist, ecnt, Hb, nullptr, F.G, pre9 && rep_ == 0, F.tid, F.wave, F.lane);
    }
    if (pre10) xcd_barrier_pf(bar, [&]() { moe_prefetch<1>(F.lds + RING_OFF, in[22], nullptr, F.wave, F.lane); });
    if (IN(10)) REP(10) {
        moe_stream_wg<1>(F.lds + RING_OFF, (const char*)Hb, FF * 2, 0, in[22], nullptr, elist, ecnt, Yb, gatev, F.G, pre10 && rep_ == 0, F.tid, F.wave, F.lane);
    }
    SEAM(10);
    if (IN(11)) REP(11) {
        const int gw = F.vcu * NWAVES + F.wave, NGW = F.G * NWAVES;
        for (int m = gw; m < NTOK; m += NGW) {
            const v2u* xr = (const v2u*)(x2b + (size_t)m * D) + F.lane; const v2u* y0 = (const v2u*)(Yb + (size_t)(2 * m) * D) + F.lane; const v2u* y1 = (const v2u*)(Yb + (size_t)(2 * m + 1) * D) + F.lane;
            f32x4 v[8]; float ssq = 0.f;
#pragma unroll
            for (int j = 0; j < 8; ++j) { const v2u a = __builtin_nontemporal_load(y0 + 64 * j), b2 = __builtin_nontemporal_load(y1 + 64 * j), xx = __builtin_nontemporal_load(xr + 64 * j); f32x4 t4;
                t4[0] = __uint_as_float(xx.x << 16) + __uint_as_float(a.x << 16) + __uint_as_float(b2.x << 16); t4[1] = __uint_as_float(xx.x & 0xffff0000u) + __uint_as_float(a.x & 0xffff0000u) + __uint_as_float(b2.x & 0xffff0000u);
                t4[2] = __uint_as_float(xx.y << 16) + __uint_as_float(a.y << 16) + __uint_as_float(b2.y << 16); t4[3] = __uint_as_float(xx.y & 0xffff0000u) + __uint_as_float(a.y & 0xffff0000u) + __uint_as_float(b2.y & 0xffff0000u);
                v[j] = t4; ssq += (t4[0] * t4[0] + t4[1] * t4[1]) + (t4[2] * t4[2] + t4[3] * t4[3]); }
            const float rstd = rsqrtf(wave_sum(ssq) * (1.f / D) + EPS);
            f32x4* o4 = (f32x4*)(args.out + (size_t)m * D) + F.lane;
#pragma unroll
            for (int j = 0; j < 8; ++j) { const f32x4 g = ((const f32x4*)in[23])[64 * j + F.lane]; __builtin_nontemporal_store(v[j] * rstd * g, o4 + 64 * j); }
        }
    }
#undef IN
#undef SEAM
}


extern "C" void kernel_launch(void* const* d_in, const int* in_sizes, int n_in, void* d_out, int out_size, void* d_ws, size_t ws_size, hipStream_t stream) {
    static int grid = 0;
    if (!grid) {
        if (WS_NEW_END > ws_size || n_in != 24) { fprintf(stderr, "kernel_launch: workspace too small (%zu < %zu) or n_in %d != 24\n", ws_size, (size_t)WS_NEW_END, n_in); grid = -1; return; }
        (void)hipFuncSetAttribute((const void*)mk_fwd, hipFuncAttributeMaxDynamicSharedMemorySize, LDS_BYTES);
        int dev = 0, cus = 0, per_cu = 0; (void)hipGetDevice(&dev); (void)hipDeviceGetAttribute(&cus, hipDeviceAttributeMultiprocessorCount, dev);
        (void)hipOccupancyMaxActiveBlocksPerMultiprocessor(&per_cu, (const void*)mk_fwd, NWAVES * 64, LDS_BYTES);
        (void)hipGetLastError();
        grid = cus > 0 ? cus : 256;
        if (per_cu < 1) fprintf(stderr, "kernel_launch: occupancy query reports %d workgroups per CU\n", per_cu);
    }
    if (grid < 0) return;
    (void)hipMemsetAsync((char*)d_ws + WS_CTL, 0, CTL_ZERO_BYTES, stream);
    Args a{};
    for (int i = 0; i < 24; ++i) a.in[i] = (const float*)d_in[i];
    a.out = (float*)d_out; a.ws = (unsigned char*)d_ws; a.ph_lo = 0; a.ph_hi = 12;
#if defined(EXP_LO)
    a.ph_hi = EXP_HI + 1;
    hipLaunchKernelGGL(mk_fwd, dim3(grid), dim3(NWAVES * 64), LDS_BYTES, stream, a);
    (void)hipMemsetAsync((char*)d_ws + WS_CTL + CW_BAR * 4, 0, XCD_BAR_WORDS * 4, stream);
    if (EXP_LO <= 2 && 2 <= EXP_HI) (void)hipMemsetAsync((char*)d_ws + WS_CTL + CW_Q * 4, 0, 1024, stream);
    if (EXP_LO <= 5 && 5 <= EXP_HI) (void)hipMemsetAsync((char*)d_ws + WS_CTL + CW_ROWSQ1 * 4, 0, NTOK * 4, stream);
    if (EXP_LO <= 7 && 7 <= EXP_HI) (void)hipMemsetAsync((char*)d_ws + WS_CTL + CW_ROWSQ2 * 4, 0, NTOK * 4, stream);
    if (EXP_LO <= 8 && 8 <= EXP_HI) (void)hipMemsetAsync((char*)d_ws + WS_CTL + CW_CNT * 4, 0, NE * 256, stream);
    a.ph_lo = EXP_LO; a.ph_hi = 12;
#endif
    hipLaunchKernelGGL(mk_fwd, dim3(grid), dim3(NWAVES * 64), LDS_BYTES, stream, a);
}
```

```cpp
#include <hip/hip_runtime.h>
#include <cstdio>
#include <cstdint>

constexpr int D = 2048, BATCH = 4, SEQ = 2048, NTOK = BATCH * SEQ;
constexpr int MEM = 256, NMEM = BATCH * MEM;
constexpr int PROJ = 6160;
constexpr int C_QSB = 0, C_KSB = 1024, C_VSB = 2048, C_QG = 3072, C_KG = 3584, C_VG = 4096, C_ALR = 5120, C_RG = 5136;
constexpr int SBH = 8, SBD = 128, GH = 4, GDK = 128, GDV = 256, GRANK = 16, CHUNK = 64;
constexpr int XH = 4, XD = 512;
constexpr int NG = 8, EPG = 8, NE = 64, FF = 512, NPAIR = NTOK * 2;
constexpr float EPS = 1e-6f;

typedef short bf16x8 __attribute__((ext_vector_type(8)));
typedef float f32x4 __attribute__((ext_vector_type(4)));

__device__ __forceinline__ unsigned short f2bf(float f) { unsigned u = __float_as_uint(f); u += 0x7fffu + ((u >> 16) & 1u); return (unsigned short)(u >> 16); }

namespace pg8 {
#define PG8_LAS __attribute__((address_space(3)))
typedef unsigned short bf16_t;
typedef unsigned u32x4 __attribute__((ext_vector_type(4)));
typedef unsigned u32x2 __attribute__((ext_vector_type(2)));
constexpr int BM = 256, BK = 64, HALF = 128, HTB = HALF * BK * 2, STAGE_BYTES = 8 * HTB, NXCD = 8, WGM = 8;
__host__ __device__ __forceinline__ int lds_byte(int r, int c) { const int st = (r >> 4) * 2 + (c >> 5), rr = r & 15, cc = c & 31, ob = rr * 64 + cc * 2; return st * 1024 + (ob ^ (((ob >> 9) & 1) << 5)); }
__host__ __device__ __forceinline__ void stage_rc(int b, int& R, int& C) { const int st = b / 1024, sb = b % 1024, swz = sb ^ (((sb >> 9) & 1) << 5); R = (st >> 1) * 16 + swz / 64; C = (st & 1) * 32 + (swz % 64) / 2; }
__host__ __device__ __forceinline__ int perm32(int rho) { const int n = rho >> 4, i = rho & 15; return 8 * (i >> 2) + 4 * n + (i & 3); }
__device__ __forceinline__ unsigned cvt_pk_bf16(float lo, float hi) { unsigned r; asm volatile("v_cvt_pk_bf16_f32 %0, %1, %2" : "=v"(r) : "v"(lo), "v"(hi)); return r; }

struct Unit { const char* A; const char* B; int pm, pn, z, mv; };

__device__ __forceinline__ void tile_order(int L, int nM, int nN, int& pm, int& pn) {
    const int nwg = nM * nN; int wgid = L;
    { const int q = nwg / NXCD, r = nwg % NXCD, xcd = wgid % NXCD, off = wgid / NXCD; wgid = (xcd < r ? xcd * (q + 1) : r * (q + 1) + (xcd - r) * q) + off; }
    const int nig = WGM * nN, gid = wgid / nig, fm = gid * WGM, gsz = (nM - fm) < WGM ? (nM - fm) : WGM;
    pm = fm + ((wgid % nig) % gsz); pn = (wgid % nig) / gsz;
}
struct DenseSched {
    const char* A; const char* Bt; unsigned lda, ldb; int K, nM, nN, G, c;
    __device__ __forceinline__ bool next(int i, Unit& u) const { const long L = (long)i * G + c; if (c < 0 || L >= (long)nM * nN) return false; int pm, pn; tile_order((int)L, nM, nN, pm, pn);
        u.pm = pm; u.pn = pn; u.z = 0; u.mv = 256; u.A = A + (size_t)pm * 256 * lda; u.B = Bt + (size_t)pn * 256 * ldb; return true; }
    __device__ __forceinline__ unsigned arow(const Unit&, int r) const { return (unsigned)r * lda; }
    __device__ __forceinline__ void a_ready(const Unit&) const {}
    __device__ __forceinline__ void done(const Unit&) const {}
};

struct ColTileSched {
    const char* A; const char* Bt; unsigned lda, ldb; int K, nM, pn, G, c;
    __device__ __forceinline__ bool next(int i, Unit& u) const { const long L = (long)i * G + c; if (c < 0 || L >= nM) return false;
        u.pm = (int)L; u.pn = pn; u.z = 0; u.mv = 256; u.A = A + (size_t)L * 256 * lda; u.B = Bt + (size_t)pn * 256 * ldb; return true; }
    __device__ __forceinline__ unsigned arow(const Unit&, int r) const { return (unsigned)r * lda; }
    __device__ __forceinline__ void a_ready(const Unit&) const {}
    __device__ __forceinline__ void done(const Unit&) const {}
};

template <class Epi, class Sched, bool ALIGN_EPI>
__device__ __forceinline__ void gemm_phase(PG8_LAS unsigned char* lds, const Sched& S, const Epi& E) {
    const int tid = threadIdx.x, wid = __builtin_amdgcn_readfirstlane(tid >> 6), lane = tid & 63, wr = wid >> 2, wc = wid & 3, fr = lane & 15, fq = lane >> 4;
    const int nt = S.K / BK;
    int R0, C0, R1, C1; stage_rc(tid * 16, R0, C0); stage_rc(tid * 16 + 8192, R1, C1);
    const int Rb0 = Epi::PERM ? ((R0 & ~31) + perm32(R0 & 31)) : R0, Rb1 = Epi::PERM ? ((R1 & ~31) + perm32(R1 & 31)) : R1;
    const unsigned ldb = S.ldb;
    const unsigned vB0 = (unsigned)Rb0 * ldb + (unsigned)C0 * 2u, vB1 = (unsigned)Rb1 * ldb + (unsigned)C1 * 2u;
    const size_t kstep = (size_t)(BK * 2);
    const size_t hstepB = (size_t)HALF * ldb;
    const unsigned ldsw = (unsigned)wid * 1024u;
    const int aoff = lds_byte(wr * 64 + fr, fq * 8), boff = lds_byte(wc * 32 + fr, fq * 8);
#define PG8_SA(b, h) (((b) * 2 + (h)) * HTB)
#define PG8_SB(b, h) ((4 + (b) * 2 + (h)) * HTB)
#define PG8_STG(bufoff, gbase, v0, v1) do { \
        __builtin_amdgcn_global_load_lds((const unsigned*)((const char*)(gbase) + (v0)), (PG8_LAS unsigned*)(lds + (bufoff) + ldsw), 16, 0, 0); \
        __builtin_amdgcn_global_load_lds((const unsigned*)((const char*)(gbase) + (v1)), (PG8_LAS unsigned*)(lds + (bufoff) + ldsw + 8192), 16, 0, 0); } while (0)
#define PG8_STGB(bufoff, gbase) PG8_STG(bufoff, gbase, vB0, vB1)
#define PG8_LDA(dst, b, h) do { _Pragma("unroll") for (int m = 0; m < 4; ++m) _Pragma("unroll") for (int k = 0; k < 2; ++k) dst[m][k] = *(const PG8_LAS bf16x8*)(lds + PG8_SA(b, h) + aoff + m * 2048 + k * 1024); } while (0)
#define PG8_LDB(dst, b, h) do { _Pragma("unroll") for (int n = 0; n < 2; ++n) _Pragma("unroll") for (int k = 0; k < 2; ++k) dst[n][k] = *(const PG8_LAS bf16x8*)(lds + PG8_SB(b, h) + boff + n * 2048 + k * 1024); } while (0)
#define PG8_MMA(ai, bj, At, Bt) do { __builtin_amdgcn_s_setprio(1); _Pragma("unroll") for (int m = 0; m < 4; ++m) _Pragma("unroll") for (int n = 0; n < 2; ++n) _Pragma("unroll") for (int k = 0; k < 2; ++k) \
        acc[ai][bj][m][n] = __builtin_amdgcn_mfma_f32_16x16x32_bf16(Bt[n][k], At[m][k], acc[ai][bj][m][n], 0, 0, 0); __builtin_amdgcn_s_setprio(0); } while (0)
#define PG8_WAIT_V(n) asm volatile("s_waitcnt vmcnt(" #n ")" ::: "memory")
#define PG8_WAIT_L(n) asm volatile("s_waitcnt lgkmcnt(" #n ")" ::: "memory")
#define PG8_BAR __builtin_amdgcn_s_barrier()
#define PG8_SCHED __builtin_amdgcn_sched_barrier(0)
#define PG8_OFFS(u, o00, o01, o10, o11) do { o00 = S.arow(u, R0) + (unsigned)C0 * 2u; o01 = S.arow(u, R1) + (unsigned)C1 * 2u; o10 = S.arow(u, HALF + R0) + (unsigned)C0 * 2u; o11 = S.arow(u, HALF + R1) + (unsigned)C1 * 2u; } while (0)
    Unit cur, nxt; int ui = 0;
    if (!S.next(0, cur)) return;
    f32x4 acc[2][2][4][2];
#pragma unroll
    for (int a = 0; a < 2; ++a)
#pragma unroll
        for (int b = 0; b < 2; ++b)
#pragma unroll
            for (int m = 0; m < 4; ++m)
#pragma unroll
                for (int n = 0; n < 2; ++n) acc[a][b][m][n] = (f32x4){0.f, 0.f, 0.f, 0.f};
    bf16x8 At[4][2], B0[2][2], B1[2][2];
    const char* cA = cur.A; const char* cB = cur.B;
    unsigned c00, c01, c10, c11; PG8_OFFS(cur, c00, c01, c10, c11);
    S.a_ready(cur);
    PG8_STGB(PG8_SB(0, 0), cB); PG8_STGB(PG8_SB(0, 1), cB + hstepB); PG8_STG(PG8_SA(0, 0), cA, c00, c01); PG8_STG(PG8_SA(0, 1), cA, c10, c11);
    if (wr == 1) PG8_BAR;
    PG8_WAIT_V(2); PG8_BAR;
    PG8_STGB(PG8_SB(1, 0), cB + kstep); PG8_STG(PG8_SA(1, 0), cA + kstep, c00, c01); PG8_STGB(PG8_SB(1, 1), cB + hstepB + kstep);
    PG8_WAIT_V(6); PG8_BAR;
    for (;;) {
        const bool has_next = S.next(ui + 1, nxt);
        const char* nA = has_next ? nxt.A : cA; const char* nB = has_next ? nxt.B : cB;
        unsigned n00 = c00, n01 = c01, n10 = c10, n11 = c11;
        if (has_next) PG8_OFFS(nxt, n00, n01, n10, n11);
        for (int t = 0; t < nt; t += 2) {
            const bool last = (t == nt - 2);
            const char* a1 = cA + (size_t)(t + 1) * kstep;
            const char* a2 = last ? nA : cA + (size_t)(t + 2) * kstep; const char* b2 = last ? nB : cB + (size_t)(t + 2) * kstep;
            const char* a3 = a2 + kstep; const char* b3 = b2 + kstep;
            const unsigned x00 = last ? n00 : c00, x01 = last ? n01 : c01, x10 = last ? n10 : c10, x11 = last ? n11 : c11;
            if (last && has_next) S.a_ready(nxt);
            PG8_LDB(B0, 0, 0); PG8_LDB(B1, 0, 1); PG8_SCHED; PG8_LDA(At, 0, 0); PG8_STG(PG8_SA(1, 1), a1, c10, c11);
            PG8_WAIT_V(8); PG8_WAIT_L(0); PG8_BAR; PG8_MMA(0, 0, At, B0); PG8_MMA(0, 1, At, B1); PG8_BAR; PG8_SCHED;
            PG8_LDA(At, 0, 1); PG8_STGB(PG8_SB(0, 0), b2); PG8_STGB(PG8_SB(0, 1), b2 + hstepB); PG8_STG(PG8_SA(0, 0), a2, x00, x01);
            PG8_WAIT_V(8); PG8_WAIT_L(0); PG8_BAR; PG8_MMA(1, 0, At, B0); PG8_MMA(1, 1, At, B1); PG8_BAR; PG8_SCHED;
            PG8_LDB(B0, 1, 0); PG8_LDB(B1, 1, 1); PG8_SCHED; PG8_LDA(At, 1, 0); PG8_STG(PG8_SA(0, 1), a2, x10, x11);
            PG8_WAIT_V(8); PG8_WAIT_L(0); PG8_BAR; PG8_MMA(0, 0, At, B0); PG8_MMA(0, 1, At, B1); PG8_BAR; PG8_SCHED;
            PG8_LDA(At, 1, 1); PG8_STGB(PG8_SB(1, 0), b3); PG8_STGB(PG8_SB(1, 1), b3 + hstepB); PG8_STG(PG8_SA(1, 0), a3, x00, x01);
            PG8_WAIT_V(8); PG8_WAIT_L(0); PG8_BAR; PG8_MMA(1, 0, At, B0); PG8_MMA(1, 1, At, B1); PG8_BAR; PG8_SCHED;
        }
        if constexpr (ALIGN_EPI) { if (wr == 0) PG8_BAR; }
        if constexpr (!Epi::AFTER_DRAIN) { E(acc, cur, wr, wc, fr, fq); S.done(cur); }
        if (!has_next) break;
#pragma unroll
        for (int a = 0; a < 2; ++a)
#pragma unroll
            for (int b = 0; b < 2; ++b)
#pragma unroll
                for (int m = 0; m < 4; ++m)
#pragma unroll
                    for (int n = 0; n < 2; ++n) acc[a][b][m][n] = (f32x4){0.f, 0.f, 0.f, 0.f};
        cur = nxt; cA = nA; cB = nB; c00 = n00; c01 = n01; c10 = n10; c11 = n11; ++ui;
        if constexpr (ALIGN_EPI) { if (wr == 1) PG8_BAR; }
    }
    PG8_WAIT_V(0);
    if constexpr (!ALIGN_EPI) { if (wr == 0) PG8_BAR; }
    PG8_BAR;
    if constexpr (Epi::AFTER_DRAIN) { E.fused(acc, cur, wr, wc, fr, fq, lds, wid, lane); S.done(cur); }
#undef PG8_SA
#undef PG8_SB
#undef PG8_STG
#undef PG8_STGB
#undef PG8_LDA
#undef PG8_LDB
#undef PG8_MMA
#undef PG8_WAIT_V
#undef PG8_WAIT_L
#undef PG8_BAR
#undef PG8_SCHED
#undef PG8_OFFS
}

template <class Epi>
__device__ __forceinline__ void gemm128_unit(PG8_LAS unsigned char* lds, const char* A, unsigned lda, const char* B, unsigned ldb, int K, const Epi& E, const Unit& u) {
    const int tid = threadIdx.x, wid = __builtin_amdgcn_readfirstlane(tid >> 6), lane = tid & 63, wr = wid >> 2, wc = wid & 3, fr = lane & 15, fq = lane >> 4;
    const int nt = K / BK;
    int R0, C0, R1, C1; stage_rc(tid * 16, R0, C0); stage_rc(tid * 16 + 8192, R1, C1);
    const int Rb0 = (R0 & ~31) + perm32(R0 & 31), Rb1 = (R1 & ~31) + perm32(R1 & 31);
    const unsigned vB0 = (unsigned)Rb0 * ldb + (unsigned)C0 * 2u, vB1 = (unsigned)Rb1 * ldb + (unsigned)C1 * 2u, vA0 = (unsigned)R0 * lda + (unsigned)C0 * 2u, vA1 = (unsigned)R1 * lda + (unsigned)C1 * 2u;
    const size_t hstepB = (size_t)HALF * ldb;
    const unsigned ldsw = (unsigned)wid * 1024u;
    const int aoff = lds_byte(wr * 64 + fr, fq * 8), boff = lds_byte(wc * 32 + fr, fq * 8);
    constexpr int STG3 = 3 * HTB;
#define G8_STG(off, gbase, v0, v1) do { \
        __builtin_amdgcn_global_load_lds((const unsigned*)((const char*)(gbase) + (v0)), (PG8_LAS unsigned*)(lds + (off) + ldsw), 16, 0, 0); \
        __builtin_amdgcn_global_load_lds((const unsigned*)((const char*)(gbase) + (v1)), (PG8_LAS unsigned*)(lds + (off) + ldsw + 8192), 16, 0, 0); } while (0)
#define G8_TILE(so, kt) do { const char* bb_ = B + (size_t)(kt) * (BK * 2); const char* aa_ = A + (size_t)(kt) * (BK * 2); \
        G8_STG((so), bb_, vB0, vB1); G8_STG((so) + HTB, bb_ + hstepB, vB0, vB1); G8_STG((so) + 2 * HTB, aa_, vA0, vA1); } while (0)
#define G8_MMA(bj, Bt) do { __builtin_amdgcn_s_setprio(1); _Pragma("unroll") for (int m = 0; m < 4; ++m) _Pragma("unroll") for (int n = 0; n < 2; ++n) _Pragma("unroll") for (int k = 0; k < 2; ++k) \
        acc[bj][m][n] = __builtin_amdgcn_mfma_f32_16x16x32_bf16(Bt[n][k], At[m][k], acc[bj][m][n], 0, 0, 0); __builtin_amdgcn_s_setprio(0); } while (0)
    f32x4 acc[2][4][2];
#pragma unroll
    for (int b = 0; b < 2; ++b)
#pragma unroll
        for (int m = 0; m < 4; ++m)
#pragma unroll
            for (int n = 0; n < 2; ++n) acc[b][m][n] = (f32x4){0.f, 0.f, 0.f, 0.f};
    bf16x8 At[4][2], B0[2][2], B1[2][2];
    G8_TILE(0, 0); G8_TILE(STG3, 1);
    asm volatile("s_waitcnt vmcnt(6)" ::: "memory"); __builtin_amdgcn_s_barrier();
    if (wr == 1) __builtin_amdgcn_s_barrier();
    int so = 0;
    for (int t = 0; t < nt; ++t) {
        const int s2 = (so >= STG3) ? so - STG3 : so + 2 * STG3;
        const int kt2 = (t + 2 < nt) ? t + 2 : 0;
        G8_TILE(s2, kt2);
#pragma unroll
        for (int n = 0; n < 2; ++n)
#pragma unroll
            for (int k = 0; k < 2; ++k) { B0[n][k] = *(const PG8_LAS bf16x8*)(lds + so + boff + n * 2048 + k * 1024); B1[n][k] = *(const PG8_LAS bf16x8*)(lds + so + HTB + boff + n * 2048 + k * 1024); }
#pragma unroll
        for (int m = 0; m < 4; ++m)
#pragma unroll
            for (int k = 0; k < 2; ++k) At[m][k] = *(const PG8_LAS bf16x8*)(lds + so + 2 * HTB + aoff + m * 2048 + k * 1024);
        asm volatile("s_waitcnt vmcnt(6)" ::: "memory"); asm volatile("s_waitcnt lgkmcnt(0)" ::: "memory"); __builtin_amdgcn_s_barrier();
        G8_MMA(0, B0); G8_MMA(1, B1);
        __builtin_amdgcn_s_barrier(); __builtin_amdgcn_sched_barrier(0);
        so = (so == 2 * STG3) ? 0 : so + STG3;
    }
    if (wr == 0) __builtin_amdgcn_s_barrier();
    E(acc, u, wr, wc, fr, fq);
    asm volatile("s_waitcnt vmcnt(0)" ::: "memory"); __builtin_amdgcn_s_barrier();
#undef G8_STG
#undef G8_TILE
#undef G8_MMA
}
}

#define LAS __attribute__((address_space(3)))
typedef unsigned short bf16;
typedef unsigned v4u __attribute__((ext_vector_type(4)));
typedef unsigned v2u __attribute__((ext_vector_type(2)));
#define RLX_AGENT __ATOMIC_RELAXED, __HIP_MEMORY_SCOPE_AGENT
#define LDS_WAIT() asm volatile("s_waitcnt lgkmcnt(0)" ::: "memory")
#define VM_WAIT() asm volatile("s_waitcnt vmcnt(0)" ::: "memory")
__device__ __forceinline__ unsigned pk2(float lo, float hi) { return (unsigned)f2bf(lo) | ((unsigned)f2bf(hi) << 16); }
__device__ __forceinline__ float bf2f(unsigned short b) { return __uint_as_float(((unsigned)b) << 16); }

#define XB_TMO      128
#define XB_XCNT(j)  (256  + 64 * (j))
#define XB_XSUB(j)  (1280 + 64 * (j))
#define XB_XGEN(j)  (2304 + 64 * (j))
#define XB_TOP      3328
#define XB_TOPGEN   3392
#define XCD_BAR_WORDS 3456
#define XB_SPIN_CAP (1u << 18)
__device__ __forceinline__ unsigned xb_ld(unsigned* p)              { return __hip_atomic_load(p, __ATOMIC_RELAXED, __HIP_MEMORY_SCOPE_AGENT); }
__device__ __forceinline__ unsigned xb_add(unsigned* p, unsigned v) { return __hip_atomic_fetch_add(p, v, __ATOMIC_RELAXED, __HIP_MEMORY_SCOPE_AGENT); }
__device__ __forceinline__ unsigned xb_xcc_id() { return (unsigned)__builtin_amdgcn_s_getreg((3 << 11) | 20) & 0xFu; }
#define XB_SPIN(cond, bar) do { unsigned _sp = 0; while (cond) { __builtin_amdgcn_s_sleep(1); \
    if ((++_sp & 255u) == 0u) { if (xb_ld(&(bar)[XB_TMO])) break; if (_sp > XB_SPIN_CAP) { atomicAdd(&(bar)[XB_TMO], 1u); break; } } } } while (0)
struct XcdBarrier { unsigned* bar; unsigned x; volatile LAS unsigned* st; };
__device__ __forceinline__ XcdBarrier xcd_barrier_post(unsigned* bar, volatile LAS unsigned* st) {
    XcdBarrier b; b.bar = bar; b.x = xb_xcc_id(); b.st = st;
    if (threadIdx.x == 0) (void)xb_add(&bar[XB_XCNT(b.x)], 1u);
    return b;
}
__device__ __forceinline__ void xcd_barrier_complete(unsigned* bar, unsigned x, unsigned& nloc, unsigned& nx) {
    const unsigned G = gridDim.x * gridDim.y * gridDim.z;
    unsigned sum, cnt, mine, sp = 0u;
    for (;;) {
        sum = 0u; cnt = 0u; mine = 0u;
#pragma unroll
        for (unsigned j = 0; j < 16; ++j) { const unsigned c = xb_ld(&bar[XB_XCNT(j)]); sum += c; cnt += (c > 0u) ? 1u : 0u; mine = (j == x) ? c : mine; }
        if (sum == G) break;
        __builtin_amdgcn_s_sleep(1);
        if ((++sp & 255u) == 0u) { if (xb_ld(&bar[XB_TMO])) break; if (sp > XB_SPIN_CAP) { atomicAdd(&bar[XB_TMO], 1u); break; } }
    }
    nloc = mine > 0u ? mine : 1u; nx = cnt > 0u ? cnt : 1u;
}
__device__ __forceinline__ void xcd_barrier(const XcdBarrier& b) {
    asm volatile("s_waitcnt vmcnt(0)" ::: "memory");
    __syncthreads();
    if (threadIdx.x == 0) {
        unsigned* bar = b.bar;
        __builtin_amdgcn_s_waitcnt(0);
        unsigned nloc = b.st[0], nx = b.st[1];
        if (nloc == 0u) { xcd_barrier_complete(bar, b.x, nloc, nx); b.st[0] = nloc; b.st[1] = nx; }
        const unsigned old = xb_add(&bar[XB_XSUB(b.x)], 1u);
        const unsigned gen = old / nloc;
        if (old + 1u == (gen + 1u) * nloc) {
            __builtin_amdgcn_fence(__ATOMIC_RELEASE, "agent");
            asm volatile("s_waitcnt vmcnt(0)" ::: "memory");
            const unsigned og = xb_add(&bar[XB_TOP], 1u);
            const unsigned tg = og / nx;
            if (og + 1u == (tg + 1u) * nx) xb_add(&bar[XB_TOPGEN], 1u);
            else XB_SPIN(xb_ld(&bar[XB_TOPGEN]) == tg, bar);
            __builtin_amdgcn_fence(__ATOMIC_ACQUIRE, "agent");
            xb_add(&bar[XB_XGEN(b.x)], 1u);
            asm volatile("s_waitcnt vmcnt(0)" ::: "memory");
        } else {
            XB_SPIN(xb_ld(&bar[XB_XGEN(b.x)]) == gen, bar);
            __builtin_amdgcn_fence(__ATOMIC_ACQUIRE, "agent");
            asm volatile("s_waitcnt vmcnt(0)" ::: "memory");
        }
    }
    __syncthreads();
}

template <class PF>
__device__ __forceinline__ void xcd_barrier_pf(const XcdBarrier& b, const PF& pf) {
    asm volatile("s_waitcnt vmcnt(0)" ::: "memory");
    __syncthreads();
    if (threadIdx.x >= 64) pf();
    if (threadIdx.x == 0) {
        unsigned* bar = b.bar;
        __builtin_amdgcn_s_waitcnt(0);
        unsigned nloc = b.st[0], nx = b.st[1];
        if (nloc == 0u) { xcd_barrier_complete(bar, b.x, nloc, nx); b.st[0] = nloc; b.st[1] = nx; }
        const unsigned old = xb_add(&bar[XB_XSUB(b.x)], 1u);
        const unsigned gen = old / nloc;
        if (old + 1u == (gen + 1u) * nloc) {
            __builtin_amdgcn_fence(__ATOMIC_RELEASE, "agent");
            asm volatile("s_waitcnt vmcnt(0)" ::: "memory");
            const unsigned og = xb_add(&bar[XB_TOP], 1u);
            const unsigned tg = og / nx;
            if (og + 1u == (tg + 1u) * nx) xb_add(&bar[XB_TOPGEN], 1u);
            else XB_SPIN(xb_ld(&bar[XB_TOPGEN]) == tg, bar);
            __builtin_amdgcn_fence(__ATOMIC_ACQUIRE, "agent");
            xb_add(&bar[XB_XGEN(b.x)], 1u);
            asm volatile("s_waitcnt vmcnt(0)" ::: "memory");
        } else {
            XB_SPIN(xb_ld(&bar[XB_XGEN(b.x)]) == gen, bar);
            __builtin_amdgcn_fence(__ATOMIC_ACQUIRE, "agent");
            asm volatile("s_waitcnt vmcnt(0)" ::: "memory");
        }
    }
    if (threadIdx.x < 64) pf();
    __syncthreads();
}

constexpr size_t MiB = 1u << 20;
constexpr int PROJP = 6400;
constexpr size_t WS_CTL = 0, CTL_ZERO_BYTES = 1 * MiB;
constexpr int CW_BAR = 4096;
constexpr int CW_CNT = 16384;
constexpr int CW_Q = 24576;
constexpr int CW_ROWSQ1 = 32768, CW_ROWSQ2 = 32768 + 8192;
constexpr size_t WS_WIN = 2 * MiB;
constexpr size_t WS_WOUT = 28 * MiB;
constexpr size_t WS_WXQ = 36 * MiB;
constexpr size_t WS_WXKV = 44 * MiB;
constexpr size_t WS_WXO = 60 * MiB;
constexpr size_t WS_H0 = 68 * MiB;
constexpr size_t WS_HM = 100 * MiB;
constexpr size_t WS_PROJ = 104 * MiB;
constexpr size_t WS_ALR = 204 * MiB;
constexpr size_t WS_KV = 205 * MiB;
constexpr size_t WS_CAT = 214 * MiB;
constexpr size_t WS_X1 = 246 * MiB;
constexpr size_t WS_X1B = 310 * MiB;
constexpr size_t WS_QX = 342 * MiB;
constexpr size_t WS_OX = 374 * MiB;
constexpr size_t WS_X2 = 406 * MiB;
constexpr size_t WS_GU = WS_X1;
constexpr size_t WS_GS = WS_X1B;
constexpr size_t WS_GQD = WS_QX;
constexpr size_t WS_GKI = WS_QX + 8 * MiB;
constexpr size_t WS_GEL = WS_QX + 16 * MiB;
constexpr size_t WS_PB = WS_H0;
constexpr size_t WS_HF = 854 * MiB;
constexpr size_t WS_HB = 886 * MiB;
constexpr size_t WS_YB = 902 * MiB;
constexpr size_t WS_WR = 966 * MiB;
constexpr size_t WS_LIST = 967 * MiB;
constexpr size_t WS_GATE = 969 * MiB;
constexpr size_t WS_MKT = WS_OX;
constexpr size_t WS_NVT = WS_OX + 16 * MiB;
constexpr size_t WS_NEW_END = 970 * MiB;

constexpr int RING_OFF = 0, RING_BYTES = 147456;
constexpr int LDSCTL_OFF = RING_BYTES, MISC_OFF = LDSCTL_OFF + 320;
constexpr int LDS_BYTES = 163840;
constexpr int NWAVES = 8;

struct Frame {
    LAS unsigned char* lds; volatile LAS unsigned* MISC; unsigned* ctl;
    int tid, lane, wave, G, vcu;
    unsigned char* ws;
};

__device__ __forceinline__ void p0_transpose_item(const float* W, int K, int ldw, int ncols, const float* gain, bf16* WT, int row_off, LAS float* scr, int item, int lane) {
    const int nblk = (ncols + 63) / 64, kb = item / nblk, nb = item % nblk, k0 = 64 * kb, n0 = 64 * nb;
    const int lk = lane >> 4, ln = (lane & 15) * 4; const bool ok = (n0 + ln) < ncols;
    f32x4 v[16];
#pragma unroll
    for (int i = 0; i < 16; ++i) v[i] = ok ? __builtin_nontemporal_load((const f32x4*)(W + (size_t)(k0 + 4 * i + lk) * ldw + n0 + ln)) : (f32x4){0.f, 0.f, 0.f, 0.f};
#pragma unroll
    for (int i = 0; i < 16; ++i) { const int kk = 4 * i + lk; const float g = gain ? gain[k0 + kk] : 1.0f; LAS float* d = scr + kk * 65 + ln; d[0] = v[i][0] * g; d[1] = v[i][1] * g; d[2] = v[i][2] * g; d[3] = v[i][3] * g; }
    LDS_WAIT(); asm volatile("" ::: "memory");
    const int c = lane & 7;
#pragma unroll
    for (int j = 0; j < 8; ++j) { const int n = (lane >> 3) + 8 * j; const LAS float* sp = scr + (8 * c) * 65 + n;
        v4u o; o.x = pk2(sp[0 * 65], sp[1 * 65]); o.y = pk2(sp[2 * 65], sp[3 * 65]); o.z = pk2(sp[4 * 65], sp[5 * 65]); o.w = pk2(sp[6 * 65], sp[7 * 65]);
        *(v4u*)(WT + (size_t)(row_off + n0 + n) * K + k0 + 8 * c) = o; }
    LDS_WAIT(); asm volatile("" ::: "memory");
}
__device__ __forceinline__ float wave_sum(float v) {
#pragma unroll
    for (int o = 1; o < 64; o <<= 1) v += __shfl_xor(v, o);
    return v;
}
__device__ __forceinline__ void rms_row_to_bf16(const float* xrow, const float* gain, bf16* orow, int lane) {
    const f32x4* xr = (const f32x4*)xrow + lane; const f32x4* gr = (const f32x4*)gain + lane;
    f32x4 v[8]; float s = 0.f;
#pragma unroll
    for (int j = 0; j < 8; ++j) { v[j] = __builtin_nontemporal_load(xr + 64 * j); s += (v[j].x * v[j].x + v[j].y * v[j].y) + (v[j].z * v[j].z + v[j].w * v[j].w); }
    const float rstd = rsqrtf(wave_sum(s) * (1.f / D) + EPS);
    unsigned long long* o8 = (unsigned long long*)orow + lane;
#pragma unroll
    for (int j = 0; j < 8; ++j) { const f32x4 g = gr[64 * j]; o8[64 * j] = (unsigned long long)pk2(v[j].x * rstd * g.x, v[j].y * rstd * g.y) | ((unsigned long long)pk2(v[j].z * rstd * g.z, v[j].w * rstd * g.w) << 32); }
}

struct EpiBf16 {
    static constexpr bool PERM = true, AFTER_DRAIN = false;
    bf16* O; int ldc;
    __device__ __forceinline__ void operator()(const f32x4 (&acc)[2][2][4][2], const pg8::Unit& u, int wr, int wc, int fr, int fq) const {
        const int row0 = u.pm * 256 + wr * 64 + fr, col0 = u.pn * 256 + wc * 32 + 8 * fq;
#pragma unroll
        for (int ai = 0; ai < 2; ++ai)
#pragma unroll
            for (int m = 0; m < 4; ++m) { bf16* rowp = O + (size_t)(row0 + ai * 128 + m * 16) * ldc + col0;
#pragma unroll
                for (int bj = 0; bj < 2; ++bj) { const f32x4 v0 = acc[ai][bj][m][0], v1 = acc[ai][bj][m][1];
                    v4u w; w.x = pg8::cvt_pk_bf16(v0[0], v0[1]); w.y = pg8::cvt_pk_bf16(v0[2], v0[3]); w.z = pg8::cvt_pk_bf16(v1[0], v1[1]); w.w = pg8::cvt_pk_bf16(v1[2], v1[3]);
                    *(v4u*)(rowp + bj * 128) = w; } }
    }
};
struct EpiProj {
    static constexpr bool PERM = true, AFTER_DRAIN = false;
    bf16* O; float* alr;
    __device__ __forceinline__ void operator()(const f32x4 (&acc)[2][2][4][2], const pg8::Unit& u, int wr, int wc, int fr, int fq) const {
        const int row0 = u.pm * 256 + wr * 64 + fr, col0 = u.pn * 256 + wc * 32 + 8 * fq;
#pragma unroll
        for (int ai = 0; ai < 2; ++ai)
#pragma unroll
            for (int m = 0; m < 4; ++m) { const int row = row0 + ai * 128 + m * 16; bf16* rowp = O + (size_t)row * PROJP + col0;
#pragma unroll
                for (int bj = 0; bj < 2; ++bj) { const f32x4 v0 = acc[ai][bj][m][0], v1 = acc[ai][bj][m][1];
                    v4u w; w.x = pg8::cvt_pk_bf16(v0[0], v0[1]); w.y = pg8::cvt_pk_bf16(v0[2], v0[3]); w.z = pg8::cvt_pk_bf16(v1[0], v1[1]); w.w = pg8::cvt_pk_bf16(v1[2], v1[3]);
                    *(v4u*)(rowp + bj * 128) = w; }
                if (u.pn == C_ALR / 256 && wc == 0 && fq < 2) { float* ap = alr + (size_t)row * GRANK + 8 * fq; *(f32x4*)ap = acc[ai][0][m][0]; *(f32x4*)(ap + 4) = acc[ai][0][m][1]; } }
    }
};

struct EpiResid {
    static constexpr bool PERM = true, AFTER_DRAIN = false;
    const float* R; const bf16* Rb; float* O; bf16* Ob; float* rowsq;
    __device__ __forceinline__ void operator()(const f32x4 (&acc)[2][2][4][2], const pg8::Unit& u, int wr, int wc, int fr, int fq) const {
        const int row0 = u.pm * 256 + wr * 64 + fr, col0 = u.pn * 256 + wc * 32 + 8 * fq;
#pragma unroll
        for (int ai = 0; ai < 2; ++ai) {
            f32x4 rr[4][2][2];
#pragma unroll
            for (int m = 0; m < 4; ++m) { const size_t off = (size_t)(row0 + ai * 128 + m * 16) * D + col0;
#pragma unroll
                for (int bj = 0; bj < 2; ++bj) {
                    if (R) { rr[m][bj][0] = __builtin_nontemporal_load((const f32x4*)(R + off + bj * 128)); rr[m][bj][1] = __builtin_nontemporal_load((const f32x4*)(R + off + bj * 128 + 4)); }
                    else { const v4u rb = *(const v4u*)(Rb + off + bj * 128); rr[m][bj][0] = (f32x4){__uint_as_float(rb.x << 16), __uint_as_float(rb.x & 0xffff0000u), __uint_as_float(rb.y << 16), __uint_as_float(rb.y & 0xffff0000u)};
                        rr[m][bj][1] = (f32x4){__uint_as_float(rb.z << 16), __uint_as_float(rb.z & 0xffff0000u), __uint_as_float(rb.w << 16), __uint_as_float(rb.w & 0xffff0000u)}; } } }
#pragma unroll
            for (int m = 0; m < 4; ++m) { const int row = row0 + ai * 128 + m * 16; const size_t off = (size_t)row * D + col0; float ss = 0.f;
#pragma unroll
                for (int bj = 0; bj < 2; ++bj) { const f32x4 v0 = acc[ai][bj][m][0] + rr[m][bj][0], v1 = acc[ai][bj][m][1] + rr[m][bj][1];
                    if (O) { *(f32x4*)(O + off + bj * 128) = v0; *(f32x4*)(O + off + bj * 128 + 4) = v1; }
                    ss += (v0[0] * v0[0] + v0[1] * v0[1]) + (v0[2] * v0[2] + v0[3] * v0[3]) + (v1[0] * v1[0] + v1[1] * v1[1]) + (v1[2] * v1[2] + v1[3] * v1[3]);
                    if (Ob) { v4u w; w.x = pg8::cvt_pk_bf16(v0[0], v0[1]); w.y = pg8::cvt_pk_bf16(v0[2], v0[3]); w.z = pg8::cvt_pk_bf16(v1[0], v1[1]); w.w = pg8::cvt_pk_bf16(v1[2], v1[3]);
                        *(v4u*)(Ob + off + bj * 128) = w; } }
                ss += __shfl_xor(ss, 16); ss += __shfl_xor(ss, 32);
                if (fq == 0) atomicAdd(rowsq + row, ss); }
            asm volatile("" ::: "memory"); }
    }
};
struct EpiRowScaleBf16 {
    static constexpr bool PERM = true, AFTER_DRAIN = false;
    bf16* O; const float* rowsq;
    __device__ __forceinline__ void operator()(const f32x4 (&acc)[2][2][4][2], const pg8::Unit& u, int wr, int wc, int fr, int fq) const {
        const int row0 = u.pm * 256 + wr * 64 + fr, col0 = u.pn * 256 + wc * 32 + 8 * fq;
#pragma unroll
        for (int ai = 0; ai < 2; ++ai)
#pragma unroll
            for (int m = 0; m < 4; ++m) { const int row = row0 + ai * 128 + m * 16; const float rs = rsqrtf(rowsq[row] * (1.0f / D) + EPS); bf16* rowp = O + (size_t)row * D + col0;
#pragma unroll
                for (int bj = 0; bj < 2; ++bj) { const f32x4 v0 = acc[ai][bj][m][0] * rs, v1 = acc[ai][bj][m][1] * rs;
                    v4u w; w.x = pg8::cvt_pk_bf16(v0[0], v0[1]); w.y = pg8::cvt_pk_bf16(v0[2], v0[3]); w.z = pg8::cvt_pk_bf16(v1[0], v1[1]); w.w = pg8::cvt_pk_bf16(v1[2], v1[3]);
                    *(v4u*)(rowp + bj * 128) = w; } }
    }
};

typedef __bf16 bf16x2_t __attribute__((ext_vector_type(2)));
typedef float f32x2_t __attribute__((ext_vector_type(2)));
typedef float f32x16 __attribute__((ext_vector_type(16)));
typedef short s16x4 __attribute__((ext_vector_type(4)));
__device__ __forceinline__ unsigned pkbf(float a, float b) { f32x2_t f = {a, b}; bf16x2_t h = __builtin_convertvector(f, bf16x2_t); return __builtin_bit_cast(unsigned, h); }
__device__ __forceinline__ unsigned offb(unsigned row, unsigned ch) { return 256u * row + 16u * (ch ^ (((row & 3u) << 2) | ((row >> 2) & 3u))); }
__device__ __forceinline__ void tr_read8(unsigned a0, unsigned a1, unsigned a2, unsigned a3, unsigned a4, unsigned a5, unsigned a6, unsigned a7,
                                         s16x4& r0, s16x4& r1, s16x4& r2, s16x4& r3, s16x4& r4, s16x4& r5, s16x4& r6, s16x4& r7) {
    asm volatile("ds_read_b64_tr_b16 %0, %8\n\tds_read_b64_tr_b16 %1, %9\n\tds_read_b64_tr_b16 %2, %10\n\tds_read_b64_tr_b16 %3, %11\n\t"
                 "ds_read_b64_tr_b16 %4, %12\n\tds_read_b64_tr_b16 %5, %13\n\tds_read_b64_tr_b16 %6, %14\n\tds_read_b64_tr_b16 %7, %15\n\ts_waitcnt lgkmcnt(0)"
                 : "=&v"(r0), "=&v"(r1), "=&v"(r2), "=&v"(r3), "=&v"(r4), "=&v"(r5), "=&v"(r6), "=&v"(r7)
                 : "v"(a0), "v"(a1), "v"(a2), "v"(a3), "v"(a4), "v"(a5), "v"(a6), "v"(a7) : "memory");
}
__device__ __forceinline__ void sb_wave_unit(LAS unsigned char* wl, const bf16* __restrict__ proj, const float* __restrict__ gain, bf16* __restrict__ cat, int b, int hd, int qi, int lane) {
    const int r = lane & 31, h = lane >> 5, t = 32 * qi + r;
    const size_t rowq = (size_t)(b * SEQ + t) * PROJP;
    bf16x8 Bq[8];
#pragma unroll
    for (int ks = 0; ks < 8; ++ks) Bq[ks] = *(const bf16x8*)(proj + rowq + C_QSB + hd * SBD + 16 * ks + 8 * h);
    f32x16 O[4];
#pragma unroll
    for (int db = 0; db < 4; ++db)
#pragma unroll
        for (int i = 0; i < 16; ++i) O[db][i] = 0.f;
    float R = 1.0f;
    const unsigned lbase = (unsigned)(size_t)wl;
    const int srow = lane >> 4, sch = lane & 15;
    v4u sreg[8];
    { const bf16* src = proj + (size_t)(b * SEQ + 32 * qi + srow) * PROJP + hd * SBD + sch * 8 + C_KSB;
#pragma unroll
      for (int i = 0; i < 8; ++i) sreg[i] = *(const v4u*)(src + (size_t)(4 * i) * PROJP); }
    const unsigned blk = (lane >> 4) & 1, q4 = (lane & 15) >> 2, p4 = lane & 3;
    const float cexp = 0.08838834764831845f * 1.4426950408889634f;
    for (int kt = qi; kt >= 0; --kt) {
#pragma unroll
        for (int i = 0; i < 8; ++i) *(LAS v4u*)(wl + offb(4 * i + srow, sch)) = sreg[i];
        { const bf16* src = proj + (size_t)(b * SEQ + 32 * kt + srow) * PROJP + hd * SBD + sch * 8 + C_VSB;
#pragma unroll
          for (int i = 0; i < 8; ++i) sreg[i] = *(const v4u*)(src + (size_t)(4 * i) * PROJP); }
        asm volatile("s_waitcnt lgkmcnt(0)" ::: "memory");
        f32x16 S;
#pragma unroll
        for (int i = 0; i < 16; ++i) S[i] = 0.f;
#pragma unroll
        for (int ks = 0; ks < 8; ++ks) { const bf16x8 Kf = *(const LAS bf16x8*)(wl + offb(r, 2 * ks + h)); S = __builtin_amdgcn_mfma_f32_32x32x16_bf16(Kf, Bq[ks], S, 0, 0, 0); }
        float w[16], keep[16];
        const bool diag = (kt == qi);
#pragma unroll
        for (int i = 0; i < 16; ++i) { const int key = (i & 3) + 8 * (i >> 2) + 4 * h;
            const float e = __builtin_amdgcn_exp2f(fminf(S[i] * cexp, 115.f)); const float kp = __builtin_amdgcn_rcpf(1.f + e);
            const bool ok = !diag || key < r;
            keep[i] = ok ? kp : 1.f; w[i] = ok ? e * kp : 0.f; }
        float tot[4], oth[4], sf[16];
#pragma unroll
        for (int g = 0; g < 4; ++g) { sf[4 * g + 3] = 1.f; sf[4 * g + 2] = keep[4 * g + 3]; sf[4 * g + 1] = sf[4 * g + 2] * keep[4 * g + 2]; sf[4 * g] = sf[4 * g + 1] * keep[4 * g + 1]; tot[g] = sf[4 * g] * keep[4 * g]; }
#pragma unroll
        for (int g = 0; g < 4; ++g) oth[g] = __shfl_xor(tot[g], 32);
        float Cg[4]; Cg[3] = R; Cg[2] = Cg[3] * (tot[3] * oth[3]); Cg[1] = Cg[2] * (tot[2] * oth[2]); Cg[0] = Cg[1] * (tot[1] * oth[1]);
        R = Cg[0] * (tot[0] * oth[0]);
#pragma unroll
        for (int g = 0; g < 4; ++g) { const float E = h ? Cg[g] : Cg[g] * oth[g];
#pragma unroll
            for (int p = 0; p < 4; ++p) w[4 * g + p] = w[4 * g + p] * (sf[4 * g + p] * E); }
#pragma unroll
        for (int i = 0; i < 8; ++i) *(LAS v4u*)(wl + 8192 + offb(4 * i + srow, sch)) = sreg[i];
        if (kt > 0) { const bf16* src = proj + (size_t)(b * SEQ + 32 * (kt - 1) + srow) * PROJP + hd * SBD + sch * 8 + C_KSB;
#pragma unroll
            for (int i = 0; i < 8; ++i) sreg[i] = *(const v4u*)(src + (size_t)(4 * i) * PROJP); }
        asm volatile("s_waitcnt lgkmcnt(0)" ::: "memory");
#pragma unroll
        for (int s2 = 0; s2 < 2; ++s2) {
            v4u wp; wp.x = pkbf(w[8 * s2], w[8 * s2 + 1]); wp.y = pkbf(w[8 * s2 + 2], w[8 * s2 + 3]); wp.z = pkbf(w[8 * s2 + 4], w[8 * s2 + 5]); wp.w = pkbf(w[8 * s2 + 6], w[8 * s2 + 7]);
            const bf16x8 Wf = __builtin_bit_cast(bf16x8, wp);
            s16x4 v0a, v0b, v1a, v1b, v2a, v2b, v3a, v3b;
            const unsigned rb0 = 16 * s2 + 4 * h + q4, rb1 = rb0 + 8, cb = 2 * blk + (p4 >> 1), bo = lbase + 8192 + 8 * (p4 & 1);
            tr_read8(bo + offb(rb0, cb), bo + offb(rb1, cb), bo + offb(rb0, 4 + cb), bo + offb(rb1, 4 + cb), bo + offb(rb0, 8 + cb), bo + offb(rb1, 8 + cb), bo + offb(rb0, 12 + cb), bo + offb(rb1, 12 + cb),
                     v0a, v0b, v1a, v1b, v2a, v2b, v3a, v3b);
            O[0] = __builtin_amdgcn_mfma_f32_32x32x16_bf16(__builtin_shufflevector(v0a, v0b, 0, 1, 2, 3, 4, 5, 6, 7), Wf, O[0], 0, 0, 0);
            O[1] = __builtin_amdgcn_mfma_f32_32x32x16_bf16(__builtin_shufflevector(v1a, v1b, 0, 1, 2, 3, 4, 5, 6, 7), Wf, O[1], 0, 0, 0);
            O[2] = __builtin_amdgcn_mfma_f32_32x32x16_bf16(__builtin_shufflevector(v2a, v2b, 0, 1, 2, 3, 4, 5, 6, 7), Wf, O[2], 0, 0, 0);
            O[3] = __builtin_amdgcn_mfma_f32_32x32x16_bf16(__builtin_shufflevector(v3a, v3b, 0, 1, 2, 3, 4, 5, 6, 7), Wf, O[3], 0, 0, 0);
        }
        if (__all(R == 0.f)) break;
    }
    float ss = 0.f;
#pragma unroll
    for (int db = 0; db < 4; ++db)
#pragma unroll
        for (int i = 0; i < 16; ++i) ss += O[db][i] * O[db][i];
    ss += __shfl_xor(ss, 32);
    const float rs = rsqrtf(ss * (1.0f / SBD) + EPS);
    bf16* orow = cat + (size_t)(b * SEQ + t) * D + hd * SBD;
#pragma unroll
    for (int db = 0; db < 4; ++db)
#pragma unroll
        for (int g = 0; g < 4; ++g) { const int d = 32 * db + 8 * g + 4 * h; const f32x4 gv = *(const f32x4*)(gain + hd * SBD + d);
            v2u o; o.x = pkbf(O[db][4 * g] * rs * gv[0], O[db][4 * g + 1] * rs * gv[1]); o.y = pkbf(O[db][4 * g + 2] * rs * gv[2], O[db][4 * g + 3] * rs * gv[3]);
            *(v2u*)(orow + d) = o; }
}

__device__ __forceinline__ void sb_wg_unit(LAS unsigned char* sm0, const bf16* __restrict__ proj, const float* __restrict__ gain, bf16* __restrict__ cat, int item, int wave, int lane) {
    const int qg = (SEQ / 256 - 1) - item / (BATCH * SBH), bh = item % (BATCH * SBH), b = bh / SBH, hd = bh % SBH;
    LAS unsigned char* sm = sm0;
    LAS int* doneAt = (LAS int*)(sm0 + RING_BYTES + 8192);
    const int qi = 8 * qg + wave, r = lane & 31, h = lane >> 5, t = 32 * qi + r;
    const size_t rowq = (size_t)(b * SEQ + t) * PROJP;
    bf16x8 Bq[8];
#pragma unroll
    for (int ks = 0; ks < 8; ++ks) Bq[ks] = *(const bf16x8*)(proj + rowq + C_QSB + hd * SBD + 16 * ks + 8 * h);
    f32x16 O[4];
#pragma unroll
    for (int db = 0; db < 4; ++db)
#pragma unroll
        for (int i = 0; i < 16; ++i) O[db][i] = 0.f;
    float R = 1.0f; bool done = false;
    const int prow0 = 4 * wave + (lane >> 4); const unsigned sw0 = (unsigned)((((lane >> 4) & 3) << 2) | (wave & 3));
    const unsigned pch0 = (unsigned)(lane & 15) ^ sw0;
    const bf16* kv0 = proj + (size_t)(b * SEQ + prow0) * PROJP + hd * SBD;
    __syncthreads();
    if (lane == 0) doneAt[wave] = -1;
#define SBW_DMA(kt_) do { int kq_ = (kt_); asm volatile("" : "+s"(kq_)); const unsigned st_ = (unsigned)(kq_ % 9) * 16384u + (unsigned)wave * 1024u; const size_t ro_ = (size_t)(32 * kq_) * PROJP; \
        __builtin_amdgcn_global_load_lds((const unsigned*)(kv0 + ro_ + C_KSB + pch0 * 8), (LAS unsigned*)(sm + st_), 16, 0, 0); \
        __builtin_amdgcn_global_load_lds((const unsigned*)(kv0 + ro_ + C_VSB + pch0 * 8), (LAS unsigned*)(sm + st_ + 8192), 16, 0, 0); } while (0)
    const int ktop = 8 * qg + 7;
#pragma unroll
    for (int i = 0; i < 8; ++i) SBW_DMA(ktop - i);
    const unsigned blk = (lane >> 4) & 1, q4 = (lane & 15) >> 2, p4 = lane & 3;
    const float cexp = 0.08838834764831845f * 1.4426950408889634f;
    for (int s = 0; ; ++s) {
        asm volatile("s_waitcnt vmcnt(0) lgkmcnt(0)" ::: "memory");
        __builtin_amdgcn_s_barrier(); asm volatile("" ::: "memory");
        { int nd = 0;
#pragma unroll
          for (int w8 = 0; w8 < 8; ++w8) { const int da = doneAt[w8]; nd += (da >= 0 && da < s) ? 1 : 0; }
          if (nd == 8) break; }
        { const int knew = ktop - 8 - s; if (knew >= 0) SBW_DMA(knew); }
        const int kt = qi - s;
        if (!done) {
            int kq = kt; asm volatile("" : "+s"(kq));
            LAS unsigned char* Kt = sm + (kq % 9) * 16384; const unsigned vb = (unsigned)(size_t)Kt + 8192u;
            f32x16 S;
#pragma unroll
            for (int i = 0; i < 16; ++i) S[i] = 0.f;
#pragma unroll
            for (int ks = 0; ks < 8; ++ks) { const bf16x8 Kf = *(const LAS bf16x8*)(Kt + offb(r, 2 * ks + h)); S = __builtin_amdgcn_mfma_f32_32x32x16_bf16(Kf, Bq[ks], S, 0, 0, 0); }
            float w[16], keep[16];
            const bool diag = (s == 0);
#pragma unroll
            for (int i = 0; i < 16; ++i) { const int key = (i & 3) + 8 * (i >> 2) + 4 * h;
                const float e = __builtin_amdgcn_exp2f(fminf(S[i] * cexp, 115.f)); const float kp = __builtin_amdgcn_rcpf(1.f + e);
                const bool ok = !diag || key < r;
                keep[i] = ok ? kp : 1.f; w[i] = ok ? e * kp : 0.f; }
            float tot[4], oth[4], sf[16];
#pragma unroll
            for (int g = 0; g < 4; ++g) { sf[4 * g + 3] = 1.f; sf[4 * g + 2] = keep[4 * g + 3]; sf[4 * g + 1] = sf[4 * g + 2] * keep[4 * g + 2]; sf[4 * g] = sf[4 * g + 1] * keep[4 * g + 1]; tot[g] = sf[4 * g] * keep[4 * g]; }
#pragma unroll
            for (int g = 0; g < 4; ++g) oth[g] = __shfl_xor(tot[g], 32);
            float Cg[4]; Cg[3] = R; Cg[2] = Cg[3] * (tot[3] * oth[3]); Cg[1] = Cg[2] * (tot[2] * oth[2]); Cg[0] = Cg[1] * (tot[1] * oth[1]);
            R = Cg[0] * (tot[0] * oth[0]);
#pragma unroll
            for (int g = 0; g < 4; ++g) { const float E = h ? Cg[g] : Cg[g] * oth[g];
#pragma unroll
                for (int p = 0; p < 4; ++p) w[4 * g + p] = w[4 * g + p] * (sf[4 * g + p] * E); }
#pragma unroll
            for (int s2 = 0; s2 < 2; ++s2) {
                v4u wp; wp.x = pkbf(w[8 * s2], w[8 * s2 + 1]); wp.y = pkbf(w[8 * s2 + 2], w[8 * s2 + 3]); wp.z = pkbf(w[8 * s2 + 4], w[8 * s2 + 5]); wp.w = pkbf(w[8 * s2 + 6], w[8 * s2 + 7]);
                const bf16x8 Wf = __builtin_bit_cast(bf16x8, wp);
                s16x4 v0a, v0b, v1a, v1b, v2a, v2b, v3a, v3b;
                const unsigned rb0 = 16 * s2 + 4 * h + q4, rb1 = rb0 + 8, cb = 2 * blk + (p4 >> 1), bo = vb + 8 * (p4 & 1);
                tr_read8(bo + offb(rb0, cb), bo + offb(rb1, cb), bo + offb(rb0, 4 + cb), bo + offb(rb1, 4 + cb), bo + offb(rb0, 8 + cb), bo + offb(rb1, 8 + cb), bo + offb(rb0, 12 + cb), bo + offb(rb1, 12 + cb),
                         v0a, v0b, v1a, v1b, v2a, v2b, v3a, v3b);
                O[0] = __builtin_amdgcn_mfma_f32_32x32x16_bf16(__builtin_shufflevector(v0a, v0b, 0, 1, 2, 3, 4, 5, 6, 7), Wf, O[0], 0, 0, 0);
                O[1] = __builtin_amdgcn_mfma_f32_32x32x16_bf16(__builtin_shufflevector(v1a, v1b, 0, 1, 2, 3, 4, 5, 6, 7), Wf, O[1], 0, 0, 0);
                O[2] = __builtin_amdgcn_mfma_f32_32x32x16_bf16(__builtin_shufflevector(v2a, v2b, 0, 1, 2, 3, 4, 5, 6, 7), Wf, O[2], 0, 0, 0);
                O[3] = __builtin_amdgcn_mfma_f32_32x32x16_bf16(__builtin_shufflevector(v3a, v3b, 0, 1, 2, 3, 4, 5, 6, 7), Wf, O[3], 0, 0, 0);
            }
            if (__all(R < 5.0e-20f) || kt == 0) { done = true; if (lane == 0) doneAt[wave] = s; }
        }
    }
#undef SBW_DMA
    asm volatile("s_waitcnt vmcnt(0)" ::: "memory");
    float ss = 0.f;
#pragma unroll
    for (int db = 0; db < 4; ++db)
#pragma unroll
        for (int i = 0; i < 16; ++i) ss += O[db][i] * O[db][i];
    ss += __shfl_xor(ss, 32);
    const float rs = rsqrtf(ss * (1.0f / SBD) + EPS);
    bf16* orow = cat + (size_t)(b * SEQ + t) * D + hd * SBD;
#pragma unroll
    for (int db = 0; db < 4; ++db) { unsigned w[4][2];
#pragma unroll
        for (int g = 0; g < 4; ++g) { const int d = 32 * db + 8 * g + 4 * h; const f32x4 gv = *(const f32x4*)(gain + hd * SBD + d);
            w[g][0] = pkbf(O[db][4 * g] * rs * gv[0], O[db][4 * g + 1] * rs * gv[1]); w[g][1] = pkbf(O[db][4 * g + 2] * rs * gv[2], O[db][4 * g + 3] * rs * gv[3]); }
        const v2u s0 = __builtin_amdgcn_permlane32_swap(w[0][0], w[1][0], false, false), s1 = __builtin_amdgcn_permlane32_swap(w[0][1], w[1][1], false, false);
        const v2u s2 = __builtin_amdgcn_permlane32_swap(w[2][0], w[3][0], false, false), s3 = __builtin_amdgcn_permlane32_swap(w[2][1], w[3][1], false, false);
        *(v4u*)(orow + 32 * db + 8 * h) = (v4u){s0.x, s1.x, s0.y, s1.y}; *(v4u*)(orow + 32 * db + 16 + 8 * h) = (v4u){s2.x, s3.x, s2.y, s3.y}; }
}

struct MktSched { const char* KV; const char* WqN; unsigned ldb; int K, G, c;
    __device__ __forceinline__ bool next(int i, pg8::Unit& u) const { const int L = i * G + c; if (L >= 128) return false; const int b = L >> 5, h = (L >> 3) & 3, kt = L & 7;
        u.pm = b * 4 + h; u.pn = kt; u.z = L; u.mv = 256; u.A = KV + ((size_t)(b * MEM) * 2 * D + h * XD) * 2; u.B = WqN + ((size_t)(kt * 256) * D + h * XD) * 2; return true; }
    __device__ __forceinline__ unsigned arow(const pg8::Unit&, int r) const { return (unsigned)r * (2 * D * 2); }
    __device__ __forceinline__ void a_ready(const pg8::Unit&) const {}
    __device__ __forceinline__ void done(const pg8::Unit&) const {} };
struct NvtSched { const char* WoT; const char* KV; unsigned ldb; int K, G, c;
    __device__ __forceinline__ bool next(int i, pg8::Unit& u) const { const int L = i * G + c; if (L >= 128) return false; const int b = L >> 5, h = (L >> 3) & 3, nt = L & 7;
        u.pm = b * 8 + nt; u.pn = h; u.z = L; u.mv = 256; u.A = WoT + ((size_t)(nt * 256) * D + h * XD) * 2; u.B = KV + ((size_t)(b * MEM) * 2 * D + D + h * XD) * 2; return true; }
    __device__ __forceinline__ unsigned arow(const pg8::Unit&, int r) const { return (unsigned)r * (D * 2); }
    __device__ __forceinline__ void a_ready(const pg8::Unit&) const {}
    __device__ __forceinline__ void done(const pg8::Unit&) const {} };
struct XLogitSched { const char* X1; const char* MKT; unsigned ldb; int K, G, c;
    __device__ __forceinline__ bool next(int i, pg8::Unit& u) const { const int Lr = i * G + c; if (Lr >= 128) return false; const int rp = 4 * (Lr & 7) + (Lr >> 5), h = (Lr >> 3) & 3, L = rp * 4 + h, b = rp >> 3, qt = rp & 7;
        u.pm = b * 8 + qt; u.pn = h; u.z = L; u.mv = 256; u.A = X1 + (size_t)(b * SEQ + qt * 256) * D * 2; u.B = MKT + (size_t)(b * 1024 + h * 256) * D * 2; return true; }
    __device__ __forceinline__ unsigned arow(const pg8::Unit&, int r) const { return (unsigned)r * (D * 2); }
    __device__ __forceinline__ void a_ready(const pg8::Unit&) const {}
    __device__ __forceinline__ void done(const pg8::Unit&) const {} };
struct EpiSoftmaxP {
    static constexpr bool PERM = true, AFTER_DRAIN = false;
    bf16* P; LAS float* tab; const float* rowsq;
    __device__ __forceinline__ void operator()(const f32x4 (&acc)[2][2][4][2], const pg8::Unit& u, int wr, int wc, int fr, int fq) const {
        const float sc = 0.044194173824159216f * 1.4426950408889634f;
        LAS float* Tm = tab; LAS float* Ts = tab + 1024;
        float rsc[2][4];
#pragma unroll
        for (int ai = 0; ai < 2; ++ai)
#pragma unroll
            for (int m = 0; m < 4; ++m) { rsc[ai][m] = sc * rsqrtf(rowsq[u.pm * 256 + ai * 128 + wr * 64 + m * 16 + fr] * (1.0f / D) + EPS); float v = -3.0e38f;
#pragma unroll
                for (int bj = 0; bj < 2; ++bj)
#pragma unroll
                    for (int n = 0; n < 2; ++n) { const f32x4 a = acc[ai][bj][m][n]; v = fmaxf(v, fmaxf(fmaxf(a[0], a[1]), fmaxf(a[2], a[3]))); }
                v = fmaxf(v, __shfl_xor(v, 16)); v = fmaxf(v, __shfl_xor(v, 32));
                if (fq == 0) Tm[(ai * 128 + wr * 64 + m * 16 + fr) * 4 + wc] = v; }
        asm volatile("s_waitcnt lgkmcnt(0)" ::: "memory"); __builtin_amdgcn_s_barrier(); asm volatile("" ::: "memory");
        float e[2][2][4][2][4];
#pragma unroll
        for (int ai = 0; ai < 2; ++ai)
#pragma unroll
            for (int m = 0; m < 4; ++m) { const f32x4 t4 = *(const LAS f32x4*)(Tm + (ai * 128 + wr * 64 + m * 16 + fr) * 4); const float k2 = rsc[ai][m], mr = fmaxf(fmaxf(t4[0], t4[1]), fmaxf(t4[2], t4[3])) * k2; float sacc = 0.f;
#pragma unroll
                for (int bj = 0; bj < 2; ++bj)
#pragma unroll
                    for (int n = 0; n < 2; ++n)
#pragma unroll
                        for (int j = 0; j < 4; ++j) { const float x = __builtin_amdgcn_exp2f(acc[ai][bj][m][n][j] * k2 - mr); e[ai][bj][m][n][j] = x; sacc += x; }
                sacc += __shfl_xor(sacc, 16); sacc += __shfl_xor(sacc, 32);
                if (fq == 0) Ts[(ai * 128 + wr * 64 + m * 16 + fr) * 4 + wc] = sacc; }
        asm volatile("s_waitcnt lgkmcnt(0)" ::: "memory"); __builtin_amdgcn_s_barrier(); asm volatile("" ::: "memory");
        const int col0 = u.pn * 256 + wc * 32 + 8 * fq;
#pragma unroll
        for (int ai = 0; ai < 2; ++ai)
#pragma unroll
            for (int m = 0; m < 4; ++m) { const int rl = ai * 128 + wr * 64 + m * 16 + fr; const f32x4 t4 = *(const LAS f32x4*)(Ts + rl * 4); const float inv = 1.0f / ((t4[0] + t4[1]) + (t4[2] + t4[3]));
                bf16* rowp = P + (size_t)(u.pm * 256 + rl) * 1024 + col0;
#pragma unroll
                for (int bj = 0; bj < 2; ++bj) { v4u w; w.x = pkbf(e[ai][bj][m][0][0] * inv, e[ai][bj][m][0][1] * inv); w.y = pkbf(e[ai][bj][m][0][2] * inv, e[ai][bj][m][0][3] * inv);
                    w.z = pkbf(e[ai][bj][m][1][0] * inv, e[ai][bj][m][1][1] * inv); w.w = pkbf(e[ai][bj][m][1][2] * inv, e[ai][bj][m][1][3] * inv); *(v4u*)(rowp + bj * 128) = w; } }
    }
};
struct EpiSoftmax128 {
    bf16* P; LAS float* tab; const float* rowsq;
    __device__ __forceinline__ void operator()(const f32x4 (&acc)[2][4][2], const pg8::Unit& u, int wr, int wc, int fr, int fq) const {
        const float sc = 0.044194173824159216f * 1.4426950408889634f;
        LAS float* Tm = tab; LAS float* Ts = tab + 512;
        float rsc[4];
#pragma unroll
        for (int m = 0; m < 4; ++m) { rsc[m] = sc * rsqrtf(rowsq[u.pm * 128 + wr * 64 + m * 16 + fr] * (1.0f / D) + EPS); float v = -3.0e38f;
#pragma unroll
            for (int bj = 0; bj < 2; ++bj)
#pragma unroll
                for (int n = 0; n < 2; ++n) { const f32x4 a = acc[bj][m][n]; v = fmaxf(v, fmaxf(fmaxf(a[0], a[1]), fmaxf(a[2], a[3]))); }
            v = fmaxf(v, __shfl_xor(v, 16)); v = fmaxf(v, __shfl_xor(v, 32));
            if (fq == 0) Tm[(wr * 64 + m * 16 + fr) * 4 + wc] = v; }
        asm volatile("s_waitcnt lgkmcnt(0)" ::: "memory"); __builtin_amdgcn_s_barrier(); asm volatile("" ::: "memory");
        float e[2][4][2][4];
#pragma unroll
        for (int m = 0; m < 4; ++m) { const f32x4 t4 = *(const LAS f32x4*)(Tm + (wr * 64 + m * 16 + fr) * 4); const float k2 = rsc[m], mr = fmaxf(fmaxf(t4[0], t4[1]), fmaxf(t4[2], t4[3])) * k2; float sacc = 0.f;
#pragma unroll
            for (int bj = 0; bj < 2; ++bj)
#pragma unroll
                for (int n = 0; n < 2; ++n)
#pragma unroll
                    for (int j = 0; j < 4; ++j) { const float x = __builtin_amdgcn_exp2f(acc[bj][m][n][j] * k2 - mr); e[bj][m][n][j] = x; sacc += x; }
            sacc += __shfl_xor(sacc, 16); sacc += __shfl_xor(sacc, 32);
            if (fq == 0) Ts[(wr * 64 + m * 16 + fr) * 4 + wc] = sacc; }
        asm volatile("s_waitcnt lgkmcnt(0)" ::: "memory"); __builtin_amdgcn_s_barrier(); asm volatile("" ::: "memory");
        const int col0 = u.pn * 256 + wc * 32 + 8 * fq;
#pragma unroll
        for (int m = 0; m < 4; ++m) { const int rl = wr * 64 + m * 16 + fr; const f32x4 t4 = *(const LAS f32x4*)(Ts + rl * 4); const float inv = 1.0f / ((t4[0] + t4[1]) + (t4[2] + t4[3]));
            bf16* rowp = P + (size_t)(u.pm * 128 + rl) * 1024 + col0;
#pragma unroll
            for (int bj = 0; bj < 2; ++bj) { v4u w; w.x = pkbf(e[bj][m][0][0] * inv, e[bj][m][0][1] * inv); w.y = pkbf(e[bj][m][0][2] * inv, e[bj][m][0][3] * inv);
                w.z = pkbf(e[bj][m][1][0] * inv, e[bj][m][1][1] * inv); w.w = pkbf(e[bj][m][1][2] * inv, e[bj][m][1][3] * inv); *(v4u*)(rowp + bj * 128) = w; } }
    }
};
struct XOutSched { const char* P; const char* NVT; unsigned ldb; int K, G, c;
    __device__ __forceinline__ bool next(int i, pg8::Unit& u) const { const int Lr = i * G + c; if (Lr >= 256) return false; const int rp = 4 * (Lr & 7) + (Lr >> 6), nt = (Lr >> 3) & 7, L = rp * 8 + nt, b = rp >> 3, qt = rp & 7;
        u.pm = b * 8 + qt; u.pn = nt; u.z = L; u.mv = 256; u.A = P + (size_t)(b * SEQ + qt * 256) * 1024 * 2; u.B = NVT + (size_t)(b * D + nt * 256) * 1024 * 2; return true; }
    __device__ __forceinline__ unsigned arow(const pg8::Unit&, int r) const { return (unsigned)r * (1024 * 2); }
    __device__ __forceinline__ void a_ready(const pg8::Unit&) const {}
    __device__ __forceinline__ void done(const pg8::Unit&) const {} };

template <int MODE>
__device__ __forceinline__ void moe_stream_unit(LAS unsigned char* lds, const char* __restrict__ Ab, unsigned lda, int ashift, const float* __restrict__ W0, const float* __restrict__ W1, int ldw, int K, int colbase,
                                                const int* __restrict__ list, int n_e, bf16* __restrict__ Out, const float* __restrict__ gate, int tid, int wave, int lane) {
    const int wr = wave >> 2, wc = wave & 3, r = lane & 31, h = lane >> 5;
    const int nt = K / 32;
    const unsigned blane = (unsigned)(((lane >> 5) * ldw + 4 * (lane & 31)) * 4);
    const char* Wg0 = (const char*)(W0 + colbase); const char* Wg1 = (MODE == 0) ? (const char*)(W1 + colbase) : (const char*)(W0 + colbase + 128);
    const unsigned a_base = (unsigned)(wr * 2048 + r * 64), a_sw0 = (unsigned)(((h ^ ((r >> 2) & 3)) & 3) << 4), a_sw1 = (unsigned)((((2 + h) ^ ((r >> 2) & 3)) & 3) << 4);
    const unsigned b_base = (unsigned)((h * 8 * 128 + 32 * wc + r) * 4);
    for (int base = 0; base < n_e; base += 320) {
        const int nrows = (n_e - base) < 320 ? (n_e - base) : 320, nblk = (nrows + 31) >> 5;
        __syncthreads();
        unsigned aoff[3];
#pragma unroll
        for (int i = 0; i < 3; ++i) { const int pc = (i < 2) ? (wave + 8 * i) : (16 + (wave & 3)); const int m = 16 * pc + (lane >> 2), mm = m < nrows ? m : nrows - 1; const int id = list[base + mm];
            aoff[i] = (unsigned)(id >> ashift) * lda + (unsigned)(((lane & 3) ^ ((m >> 2) & 3)) * 16); }
        f32x16 acc[5][2];
#pragma unroll
        for (int j = 0; j < 5; ++j)
#pragma unroll
            for (int nb = 0; nb < 2; ++nb)
#pragma unroll
                for (int i = 0; i < 16; ++i) acc[j][nb][i] = 0.f;
#define MS_DMAB(t) do { int tq_ = (t); asm volatile("" : "+s"(tq_)); const unsigned st_ = 40960u + (unsigned)(tq_ % 3) * 32768u + (unsigned)wave * 1024u; const size_t kro_ = ((size_t)tq_ * 32 + 2 * wave) * (size_t)ldw * 4; \
            __builtin_amdgcn_global_load_lds((const unsigned*)(Wg0 + kro_ + blane), (LAS unsigned*)(lds + st_), 16, 0, 2); \
            __builtin_amdgcn_global_load_lds((const unsigned*)(Wg0 + kro_ + (size_t)ldw * 64 + blane), (LAS unsigned*)(lds + st_ + 8192), 16, 0, 2); \
            __builtin_amdgcn_global_load_lds((const unsigned*)(Wg1 + kro_ + blane), (LAS unsigned*)(lds + st_ + 16384), 16, 0, 2); \
            __builtin_amdgcn_global_load_lds((const unsigned*)(Wg1 + kro_ + (size_t)ldw * 64 + blane), (LAS unsigned*)(lds + st_ + 24576), 16, 0, 2); } while (0)
#define MS_DMAA(t) do { int tq_ = (t); asm volatile("" : "+s"(tq_)); const unsigned st_ = (unsigned)(tq_ & 1) * 20480u; const char* ap_ = Ab + (size_t)tq_ * 64; \
            __builtin_amdgcn_global_load_lds((const unsigned*)(ap_ + aoff[0]), (LAS unsigned*)(lds + st_ + wave * 1024), 16, 0, 0); \
            __builtin_amdgcn_global_load_lds((const unsigned*)(ap_ + aoff[1]), (LAS unsigned*)(lds + st_ + (wave + 8) * 1024), 16, 0, 0); \
            __builtin_amdgcn_global_load_lds((const unsigned*)(ap_ + aoff[2]), (LAS unsigned*)(lds + st_ + (16 + (wave & 3)) * 1024), 16, 0, 0); } while (0)
        MS_DMAB(0); MS_DMAA(0); if (nt > 1) MS_DMAB(1);
        for (int t = 0; t < nt; ++t) {
            int tq = t; asm volatile("" : "+s"(tq));
            LAS unsigned char* Bs = lds + 40960 + (tq % 3) * 32768; LAS unsigned char* As = lds + (tq & 1) * 20480;
            if (t + 1 < nt) asm volatile("s_waitcnt vmcnt(4)" ::: "memory"); else asm volatile("s_waitcnt vmcnt(0)" ::: "memory");
            __builtin_amdgcn_s_barrier(); asm volatile("" ::: "memory");
            if (t + 1 < nt) MS_DMAA(t + 1);
            if (t + 2 < nt) MS_DMAB(t + 2);
            const LAS unsigned char* Ar = As + a_base; const LAS float* Br = (const LAS float*)(Bs + b_base);
#pragma unroll
            for (int ks = 0; ks < 2; ++ks) {
                bf16x8 Bf[2];
#pragma unroll
                for (int nb = 0; nb < 2; ++nb) { const LAS float* bp = Br + nb * 4096 + ks * 2048;
                    v4u w; w.x = pkbf(bp[0], bp[128]); w.y = pkbf(bp[256], bp[384]); w.z = pkbf(bp[512], bp[640]); w.w = pkbf(bp[768], bp[896]); Bf[nb] = __builtin_bit_cast(bf16x8, w); }
#pragma unroll
                for (int j = 0; j < 5; ++j) { const int mb = wr + 2 * j;
                    if (mb < nblk) { const bf16x8 Af = *(const LAS bf16x8*)(Ar + (ks ? a_sw1 : a_sw0) + j * 4096);
                        acc[j][0] = __builtin_amdgcn_mfma_f32_32x32x16_bf16(Bf[0], Af, acc[j][0], 0, 0, 0); acc[j][1] = __builtin_amdgcn_mfma_f32_32x32x16_bf16(Bf[1], Af, acc[j][1], 0, 0, 0); } }
            }
        }
#undef MS_DMAB
#undef MS_DMAA
#pragma unroll
        for (int j = 0; j < 5; ++j) { const int mb = wr + 2 * j, m = 32 * mb + r;
            if (mb < nblk && m < nrows) { const int pair = list[base + m];
                if (MODE == 0) {
#pragma unroll
                    for (int g = 0; g < 4; ++g) { float hv[4];
#pragma unroll
                        for (int p2 = 0; p2 < 4; ++p2) { const float gv = acc[j][0][4 * g + p2], uv = acc[j][1][4 * g + p2]; hv[p2] = gv / (1.f + __expf(-gv)) * uv; }
                        v2u w; w.x = pkbf(hv[0], hv[1]); w.y = pkbf(hv[2], hv[3]); *(v2u*)(Out + (size_t)pair * FF + colbase + 32 * wc + 8 * g + 4 * h) = w; }
                } else { const float gt = gate[pair];
#pragma unroll
                    for (int nb = 0; nb < 2; ++nb)
#pragma unroll
                        for (int g = 0; g < 4; ++g) { v2u w; w.x = pkbf(acc[j][nb][4 * g] * gt, acc[j][nb][4 * g + 1] * gt); w.y = pkbf(acc[j][nb][4 * g + 2] * gt, acc[j][nb][4 * g + 3] * gt);
                            *(v2u*)(Out + (size_t)pair * D + colbase + 128 * nb + 32 * wc + 8 * g + 4 * h) = w; } } } }
    }
}

template <int MODE> __device__ __forceinline__ int moe_expert(int u) { const int x8 = u & 7, y = u >> 3; return x8 * 8 + (MODE == 0 ? (y >> 2) : (y >> 3)); }
template <int MODE> __device__ __forceinline__ int moe_colbase(int u) { const int y = u >> 3; return MODE == 0 ? 128 * (y & 3) : 256 * (y & 7); }
__device__ __forceinline__ void moe_dma_b(LAS unsigned char* lds, const char* Wg0, const char* Wg1, int ldw, int tile, int stage, int wave, int lane) {
    int tq = tile; asm volatile("" : "+s"(tq));
    const unsigned blane = (unsigned)(((lane >> 5) * ldw + 4 * (lane & 31)) * 4);
    const unsigned st = 40960u + (unsigned)stage * 32768u + (unsigned)wave * 1024u; const size_t kro = ((size_t)tq * 32 + 2 * wave) * (size_t)ldw * 4;
    __builtin_amdgcn_global_load_lds((const unsigned*)(Wg0 + kro + blane), (LAS unsigned*)(lds + st), 16, 0, 2);
    __builtin_amdgcn_global_load_lds((const unsigned*)(Wg0 + kro + (size_t)ldw * 64 + blane), (LAS unsigned*)(lds + st + 8192), 16, 0, 2);
    __builtin_amdgcn_global_load_lds((const unsigned*)(Wg1 + kro + blane), (LAS unsigned*)(lds + st + 16384), 16, 0, 2);
    __builtin_amdgcn_global_load_lds((const unsigned*)(Wg1 + kro + (size_t)ldw * 64 + blane), (LAS unsigned*)(lds + st + 24576), 16, 0, 2);
}
template <int MODE> __device__ __forceinline__ void moe_wptr(const float* Wa, const float* Wb, int u, const char*& Wg0, const char*& Wg1) {
    const int e = moe_expert<MODE>(u), cb = moe_colbase<MODE>(u);
    if (MODE == 0) { Wg0 = (const char*)(Wa + (size_t)e * D * FF + cb); Wg1 = (const char*)(Wb + (size_t)e * D * FF + cb); }
    else { Wg0 = (const char*)(Wa + (size_t)e * FF * D + cb); Wg1 = Wg0 + 128 * 4; }
}
template <int MODE> __device__ __forceinline__ void moe_prefetch(LAS unsigned char* lds, const float* Wa, const float* Wb, int wave, int lane) {
    constexpr int NU = (MODE == 0) ? NE * 4 : NE * 8, ldw = (MODE == 0) ? FF : D;
    if ((int)blockIdx.x < NU) { const char* w0; const char* w1; moe_wptr<MODE>(Wa, Wb, (int)blockIdx.x, w0, w1); moe_dma_b(lds, w0, w1, ldw, 0, 0, wave, lane); moe_dma_b(lds, w0, w1, ldw, 1, 1, wave, lane); }
}
template <int MODE>
__device__ __forceinline__ void moe_stream_wg(LAS unsigned char* lds, const char* __restrict__ Ab, unsigned lda, int ashift, const float* __restrict__ Wa, const float* __restrict__ Wb,
                                              const int* __restrict__ elist, const int* __restrict__ ecnt, bf16* __restrict__ Out, const float* __restrict__ gate, int G, bool pre, int tid, int wave, int lane) {
    constexpr int NU = (MODE == 0) ? NE * 4 : NE * 8, K = (MODE == 0) ? D : FF, ldw = (MODE == 0) ? FF : D, nt = K / 32;
    const int wr = wave >> 2, wc = wave & 3, r = lane & 31, h = lane >> 5;
    const unsigned a_base = (unsigned)(wr * 2048 + r * 64), a_sw0 = (unsigned)(((h ^ ((r >> 2) & 3)) & 3) << 4), a_sw1 = (unsigned)((((2 + h) ^ ((r >> 2) & 3)) & 3) << 4);
    const unsigned b_base = (unsigned)((h * 8 * 128 + 32 * wc + r) * 4);
    int u = (int)blockIdx.x, base = 0, ne = 0; bool have = false;
    for (; u < NU; u += G) { ne = ecnt[moe_expert<MODE>(u) * 64]; if (ne > 0) { have = true; break; } }
    if (pre && !(have && u == (int)blockIdx.x)) { asm volatile("s_waitcnt vmcnt(0)" ::: "memory"); pre = false; }
    if (!pre) __syncthreads();
    if (!have) return;
    const char* Wg0; const char* Wg1; moe_wptr<MODE>(Wa, Wb, u, Wg0, Wg1);
    if (!pre) { moe_dma_b(lds, Wg0, Wg1, ldw, 0, 0, wave, lane); moe_dma_b(lds, Wg0, Wg1, ldw, 1, 1, wave, lane); }
    int ph = 0;
    unsigned aoff[3], naoff[3];
#define MW_AOFF(dst, lst, bs, nr) do { _Pragma("unroll") for (int i = 0; i < 3; ++i) { const int pc = (i < 2) ? (wave + 8 * i) : (16 + (wave & 3)); const int m = 16 * pc + (lane >> 2), mm = m < (nr) ? m : (nr) - 1; const int id = (lst)[(bs) + mm]; \
            dst[i] = (unsigned)(id >> ashift) * lda + (unsigned)(((lane & 3) ^ ((m >> 2) & 3)) * 16); } } while (0)
#define MW_DMAA(t, ao) do { int tq_ = (t); asm volatile("" : "+s"(tq_)); const unsigned st_ = (unsigned)(tq_ & 1) * 20480u; const char* ap_ = Ab + (size_t)tq_ * 64; \
            __builtin_amdgcn_global_load_lds((const unsigned*)(ap_ + ao[0]), (LAS unsigned*)(lds + st_ + wave * 1024), 16, 0, 0); \
            __builtin_amdgcn_global_load_lds((const unsigned*)(ap_ + ao[1]), (LAS unsigned*)(lds + st_ + (wave + 8) * 1024), 16, 0, 0); \
            __builtin_amdgcn_global_load_lds((const unsigned*)(ap_ + ao[2]), (LAS unsigned*)(lds + st_ + (16 + (wave & 3)) * 1024), 16, 0, 0); } while (0)
    { const int nr0 = ne < 320 ? ne : 320; const int* l0 = elist + (size_t)moe_expert<MODE>(u) * NTOK; MW_AOFF(aoff, l0, 0, nr0); }
    MW_DMAA(0, aoff);
    for (;;) {
        const int* list = elist + (size_t)moe_expert<MODE>(u) * NTOK; const int colbase = moe_colbase<MODE>(u);
        const int nrows = (ne - base) < 320 ? (ne - base) : 320, nblk = (nrows + 31) >> 5;
        int nu = u, nbase = base + 320, nne = ne; bool hn = true;
        if (nbase >= ne) { hn = false; for (nu = u + G; nu < NU; nu += G) { nne = ecnt[moe_expert<MODE>(nu) * 64]; if (nne > 0) { hn = true; nbase = 0; break; } } }
        const char* nW0 = Wg0; const char* nW1 = Wg1;
        if (hn) { moe_wptr<MODE>(Wa, Wb, nu, nW0, nW1); const int nnr = (nne - nbase) < 320 ? (nne - nbase) : 320; const int* nl = elist + (size_t)moe_expert<MODE>(nu) * NTOK; MW_AOFF(naoff, nl, nbase, nnr); }
        f32x16 acc[5][2];
#pragma unroll
        for (int j = 0; j < 5; ++j)
#pragma unroll
            for (int nb = 0; nb < 2; ++nb)
#pragma unroll
                for (int i = 0; i < 16; ++i) acc[j][nb][i] = 0.f;
        for (int t = 0; t < nt; ++t) {
            int tq = t; asm volatile("" : "+s"(tq));
            const int sb = (ph + tq) % 3;
            LAS unsigned char* Bs = lds + 40960 + sb * 32768; LAS unsigned char* As = lds + (tq & 1) * 20480;
            if (t > 0 && (t + 1 < nt || hn)) asm volatile("s_waitcnt vmcnt(4)" ::: "memory"); else asm volatile("s_waitcnt vmcnt(0)" ::: "memory");
            __builtin_amdgcn_s_barrier(); asm volatile("" ::: "memory");
            if (t + 1 < nt) MW_DMAA(t + 1, aoff); else if (hn) MW_DMAA(0, naoff);
            if (t + 2 < nt) moe_dma_b(lds, Wg0, Wg1, ldw, t + 2, (ph + t + 2) % 3, wave, lane); else if (hn) moe_dma_b(lds, nW0, nW1, ldw, t + 2 - nt, (ph + t + 2) % 3, wave, lane);
            const LAS unsigned char* Ar = As + a_base; const LAS float* Br = (const LAS float*)(Bs + b_base);
#pragma unroll
            for (int ks = 0; ks < 2; ++ks) {
                bf16x8 Bf[2];
#pragma unroll
                for (int nb = 0; nb < 2; ++nb) { const LAS float* bp = Br + nb * 4096 + ks * 2048;
                    v4u w; w.x = pkbf(bp[0], bp[128]); w.y = pkbf(bp[256], bp[384]); w.z = pkbf(bp[512], bp[640]); w.w = pkbf(bp[768], bp[896]); Bf[nb] = __builtin_bit_cast(bf16x8, w); }
#pragma unroll
                for (int j = 0; j < 5; ++j) { const int mb = wr + 2 * j;
                    if (mb < nblk) { const bf16x8 Af = *(const LAS bf16x8*)(Ar + (ks ? a_sw1 : a_sw0) + j * 4096);
                        acc[j][0] = __builtin_amdgcn_mfma_f32_32x32x16_bf16(Bf[0], Af, acc[j][0], 0, 0, 0); acc[j][1] = __builtin_amdgcn_mfma_f32_32x32x16_bf16(Bf[1], Af, acc[j][1], 0, 0, 0); } }
            }
        }
#pragma unroll
        for (int j = 0; j < 5; ++j) { const int mb = wr + 2 * j, m = 32 * mb + r;
            if (mb < nblk) { const bool live = m < nrows; const int pair = list[base + (live ? m : nrows - 1)];
                if (MODE == 0) { unsigned w[4][2];
#pragma unroll
                    for (int g = 0; g < 4; ++g) { float hv[4];
#pragma unroll
                        for (int p2 = 0; p2 < 4; ++p2) { const float gv = acc[j][0][4 * g + p2], uv = acc[j][1][4 * g + p2]; hv[p2] = gv / (1.f + __expf(-gv)) * uv; }
                        w[g][0] = pkbf(hv[0], hv[1]); w[g][1] = pkbf(hv[2], hv[3]); }
                    const v2u s0 = __builtin_amdgcn_permlane32_swap(w[0][0], w[1][0], false, false), s1 = __builtin_amdgcn_permlane32_swap(w[0][1], w[1][1], false, false);
                    const v2u s2 = __builtin_amdgcn_permlane32_swap(w[2][0], w[3][0], false, false), s3 = __builtin_amdgcn_permlane32_swap(w[2][1], w[3][1], false, false);
                    if (live) { bf16* op = Out + (size_t)pair * FF + colbase + 32 * wc + 8 * h; *(v4u*)op = (v4u){s0.x, s1.x, s0.y, s1.y}; *(v4u*)(op + 16) = (v4u){s2.x, s3.x, s2.y, s3.y}; }
                } else { const float gt = gate[pair];
#pragma unroll
                    for (int nb = 0; nb < 2; ++nb) { unsigned w[4][2];
#pragma unroll
                        for (int g = 0; g < 4; ++g) { w[g][0] = pkbf(acc[j][nb][4 * g] * gt, acc[j][nb][4 * g + 1] * gt); w[g][1] = pkbf(acc[j][nb][4 * g + 2] * gt, acc[j][nb][4 * g + 3] * gt); }
                        const v2u s0 = __builtin_amdgcn_permlane32_swap(w[0][0], w[1][0], false, false), s1 = __builtin_amdgcn_permlane32_swap(w[0][1], w[1][1], false, false);
                        const v2u s2 = __builtin_amdgcn_permlane32_swap(w[2][0], w[3][0], false, false), s3 = __builtin_amdgcn_permlane32_swap(w[2][1], w[3][1], false, false);
                        if (live) { bf16* op = Out + (size_t)pair * D + colbase + 128 * nb + 32 * wc + 8 * h; *(v4u*)op = (v4u){s0.x, s1.x, s0.y, s1.y}; *(v4u*)(op + 16) = (v4u){s2.x, s3.x, s2.y, s3.y}; } } } } }
        if (!hn) break;
        u = nu; base = nbase; ne = nne; Wg0 = nW0; Wg1 = nW1; ph = (ph + nt) % 3;
#pragma unroll
        for (int i = 0; i < 3; ++i) aoff[i] = naoff[i];
    }
#undef MW_AOFF
#undef MW_DMAA
}

__device__ __forceinline__ float softplus_f(float z) { return fmaxf(z, 0.f) + log1pf(__expf(-fabsf(z))); }
__device__ __forceinline__ void tr_read2(unsigned a0, unsigned a1, s16x4& r0, s16x4& r1) {
    asm volatile("ds_read_b64_tr_b16 %0, %2\n\tds_read_b64_tr_b16 %1, %3\n\ts_waitcnt lgkmcnt(0)" : "=&v"(r0), "=&v"(r1) : "v"(a0), "v"(a1) : "memory");
}
__device__ __forceinline__ void gla_stage_v(LAS unsigned char* vt, const bf16* __restrict__ proj, size_t row0, int hd, int tid) {
#pragma unroll
    for (int i = 0; i < 4; ++i) { const int id = i * 512 + tid, row = id >> 5, ch = id & 31;
        const v4u x = *(const v4u*)(proj + (row0 + row) * PROJP + C_VG + hd * GDV + ch * 8);
        *(LAS v4u*)(vt + (ch >> 4) * 16384 + offb(row, ch & 15)) = x; }
}
__device__ __forceinline__ void gla_pass1_unit(LAS unsigned char* sm, const bf16* __restrict__ proj, const float* __restrict__ alr, const float* __restrict__ wg, const float* __restrict__ bg,
                                               bf16* __restrict__ qdg, bf16* __restrict__ kig, float* __restrict__ elg, bf16* __restrict__ Ug, int unit, int tid, int wave, int lane) {
    LAS unsigned char* vt = sm; LAS unsigned char* kit = sm + 32768; LAS float* ptot = (LAS float*)(sm + 49152);
    const int c = unit & 31, hd = (unit >> 5) & 3, b = unit >> 7;
    const size_t row0 = (size_t)b * SEQ + c * CHUNK;
    const int j = tid & 127, part = tid >> 7;
    __syncthreads();
    gla_stage_v(vt, proj, row0, hd, tid);
    LAS float* alds = ptot + 512;
    if (tid < 256) *(LAS f32x4*)(alds + tid * 4) = *(const f32x4*)(alr + row0 * GRANK + tid * 4);
    float wgr[GRANK];
#pragma unroll
    for (int r = 0; r < GRANK; ++r) wgr[r] = wg[r * 512 + hd * GDK + j];
    const float bj = bg[hd * GDK + j];
    __syncthreads();
    float cl[16]; float run = 0.f;
#pragma unroll
    for (int tt = 0; tt < 16; ++tt) { const LAS f32x4* ap = (const LAS f32x4*)(alds + (part * 16 + tt) * GRANK); const f32x4 a0 = ap[0], a1 = ap[1], a2 = ap[2], a3 = ap[3];
        float sacc = bj + ((a0[0] * wgr[0] + a0[1] * wgr[1]) + (a0[2] * wgr[2] + a0[3] * wgr[3])) + ((a1[0] * wgr[4] + a1[1] * wgr[5]) + (a1[2] * wgr[6] + a1[3] * wgr[7]))
                   + ((a2[0] * wgr[8] + a2[1] * wgr[9]) + (a2[2] * wgr[10] + a2[3] * wgr[11])) + ((a3[0] * wgr[12] + a3[1] * wgr[13]) + (a3[2] * wgr[14] + a3[3] * wgr[15]));
        run -= (fmaxf(-sacc, 0.f) + __logf(1.0f + __expf(-fabsf(sacc)))) * (1.0f / 16.0f); cl[tt] = run; }
    ptot[part * 128 + j] = run;
    __syncthreads();
    const float prefix = (part > 0 ? ptot[j] : 0.f) + (part > 1 ? ptot[128 + j] : 0.f) + (part > 2 ? ptot[256 + j] : 0.f);
    LAS float* cumt = alds + 1024;
#pragma unroll
    for (int tt = 0; tt < 16; ++tt) cumt[(part * 16 + tt) * 128 + j] = prefix + cl[tt];
    if (part == 3) elg[(size_t)unit * 128 + j] = __expf(prefix + run);
    __syncthreads();
#pragma unroll
    for (int i = 0; i < 2; ++i) { const int id = i * 512 + tid, t = id >> 4, cch = id & 15;
        const v4u q8 = *(const v4u*)(proj + (row0 + t) * PROJP + C_QG + hd * GDK + cch * 8), k8 = *(const v4u*)(proj + (row0 + t) * PROJP + C_KG + hd * GDK + cch * 8);
        const f32x4 c0 = *(const LAS f32x4*)(cumt + t * 128 + cch * 8), c1 = *(const LAS f32x4*)(cumt + t * 128 + cch * 8 + 4);
        v4u qo, ko;
#pragma unroll
        for (int e2 = 0; e2 < 4; ++e2) { const float ca = e2 < 2 ? c0[2 * e2] : c1[2 * e2 - 4], cb = e2 < 2 ? c0[2 * e2 + 1] : c1[2 * e2 - 3];
            const float ea = __expf(ca), eb = __expf(cb), ia = __builtin_amdgcn_rcpf(ea), ib = __builtin_amdgcn_rcpf(eb);
            const float qa = __uint_as_float(q8[e2] << 16), qb = __uint_as_float(q8[e2] & 0xffff0000u), ka = __uint_as_float(k8[e2] << 16), kb2 = __uint_as_float(k8[e2] & 0xffff0000u);
            qo[e2] = pkbf(qa * 0.08838834764831845f * ea, qb * 0.08838834764831845f * eb); ko[e2] = pkbf(ka * ia, kb2 * ib); }
        const size_t gi = (row0 + t) * 512 + hd * GDK + cch * 8;
        *(v4u*)(qdg + gi) = qo; *(v4u*)(kig + gi) = ko;
        *(LAS v4u*)(kit + offb(t, cch)) = ko; }
    __syncthreads();
    const unsigned vbase = (unsigned)(size_t)vt + (wave >> 2) * 16384, kbase = (unsigned)(size_t)kit;
    const unsigned h = lane >> 5, blk = (lane >> 4) & 1, q4 = (lane & 15) >> 2, p4 = lane & 3;
    f32x16 U[4];
#pragma unroll
    for (int db = 0; db < 4; ++db)
#pragma unroll
        for (int i = 0; i < 16; ++i) U[db][i] = 0.f;
#pragma unroll
    for (int ks = 0; ks < 4; ++ks) {
        const unsigned r0 = 16 * ks + 8 * h + q4, r1 = r0 + 4, cc = 2 * blk + (p4 >> 1), bo = 8 * (p4 & 1);
        s16x4 a0, a1; tr_read2(vbase + offb(r0, 4 * (wave & 3) + cc) + bo, vbase + offb(r1, 4 * (wave & 3) + cc) + bo, a0, a1);
        const bf16x8 Af = __builtin_shufflevector(a0, a1, 0, 1, 2, 3, 4, 5, 6, 7);
#pragma unroll
        for (int db = 0; db < 4; ++db) { s16x4 b0, b1; tr_read2(kbase + offb(r0, 4 * db + cc) + bo, kbase + offb(r1, 4 * db + cc) + bo, b0, b1);
            U[db] = __builtin_amdgcn_mfma_f32_32x32x16_bf16(Af, __builtin_shufflevector(b0, b1, 0, 1, 2, 3, 4, 5, 6, 7), U[db], 0, 0, 0); }
    }
    bf16* up = Ug + (size_t)unit * 32768;
#pragma unroll
    for (int db = 0; db < 4; ++db)
#pragma unroll
        for (int i = 0; i < 16; ++i) up[(size_t)(32 * wave + (i & 3) + 8 * (i >> 2) + 4 * h) * 128 + 32 * db + (lane & 31)] = f2bf(U[db][i]);
}
__device__ __forceinline__ void gla_pass3_pair(LAS unsigned char* sm, const bf16* __restrict__ proj, const bf16* __restrict__ qdg, const bf16* __restrict__ kig, const bf16* __restrict__ Sg,
                                               const float* __restrict__ gain, const float* __restrict__ br, bf16* __restrict__ cat, int unit0, int unit1, int tid, int wave, int lane) {
    LAS float* nt = (LAS float*)(sm + 65536);
    const int ug = wave >> 2, gwv = wave & 3, unit = ug ? unit1 : unit0;
    const int c = unit & 31, hd = (unit >> 5) & 3, b = unit >> 7;
    const size_t row0 = (size_t)b * SEQ + c * CHUNK;
    __syncthreads();
#pragma unroll
    for (int i = 0; i < 8; ++i) { const int id = i * 512 + tid, tl = id >> 11, rem = id & 2047, row = rem >> 5, ch = rem & 31; const int us = tl ? unit1 : unit0;
        const size_t r0s = (size_t)(us >> 7) * SEQ + (us & 31) * CHUNK; const int hs = (us >> 5) & 3;
        const v4u x = *(const v4u*)(proj + (r0s + row) * PROJP + C_VG + hs * GDV + ch * 8);
        *(LAS v4u*)(sm + tl * 32768 + (ch >> 4) * 16384 + offb(row, ch & 15)) = x; }
    LAS unsigned char* vt = sm + ug * 32768;
    const int tb = gwv & 1, dq2 = gwv >> 1, r = lane & 31, h = lane >> 5, t = 32 * tb + r;
    bf16x8 Bq[8];
#pragma unroll
    for (int ks = 0; ks < 8; ++ks) Bq[ks] = *(const bf16x8*)(qdg + (row0 + t) * 512 + hd * GDK + 16 * ks + 8 * h);
    f32x16 O[4];
#pragma unroll
    for (int dvb = 0; dvb < 4; ++dvb)
#pragma unroll
        for (int i = 0; i < 16; ++i) O[dvb][i] = 0.f;
    const bf16* Sp = Sg + (size_t)unit * 32768;
    bf16x8 Kf0[8];
#pragma unroll
    for (int ks = 0; ks < 8; ++ks) Kf0[ks] = *(const bf16x8*)(kig + (row0 + r) * 512 + hd * GDK + 16 * ks + 8 * h);
#pragma unroll
    for (int dvb = 0; dvb < 4; ++dvb)
#pragma unroll
        for (int ks = 0; ks < 8; ++ks) { const bf16x8 Sf = *(const bf16x8*)(Sp + (size_t)(32 * (4 * dq2 + dvb) + r) * 128 + 16 * ks + 8 * h);
            O[dvb] = __builtin_amdgcn_mfma_f32_32x32x16_bf16(Sf, Bq[ks], O[dvb], 0, 0, 0); }
    __syncthreads();
    const unsigned blk = (lane >> 4) & 1, q4 = (lane & 15) >> 2, p4 = lane & 3;
    v2u rgp[4][4];
#pragma unroll
    for (int dvb = 0; dvb < 4; ++dvb)
#pragma unroll
        for (int g = 0; g < 4; ++g) rgp[dvb][g] = *(const v2u*)(proj + (row0 + t) * PROJP + C_RG + hd * GDV + 32 * (4 * dq2 + dvb) + 8 * g + 4 * h);
    for (int sb = 0; sb <= tb; ++sb) {
        f32x16 ST;
#pragma unroll
        for (int i = 0; i < 16; ++i) ST[i] = 0.f;
#pragma unroll
        for (int ks = 0; ks < 8; ++ks) { const bf16x8 Kf = (sb == 0) ? Kf0[ks] : *(const bf16x8*)(kig + (row0 + 32 * sb + r) * 512 + hd * GDK + 16 * ks + 8 * h);
            ST = __builtin_amdgcn_mfma_f32_32x32x16_bf16(Kf, Bq[ks], ST, 0, 0, 0); }
        const bool diag = (sb == tb);
        float w[16];
#pragma unroll
        for (int i = 0; i < 16; ++i) { const int sl = (i & 3) + 8 * (i >> 2) + 4 * h; w[i] = (!diag || sl <= r) ? ST[i] : 0.f; }
#pragma unroll
        for (int s2 = 0; s2 < 2; ++s2) {
            v4u wp; wp.x = pkbf(w[8 * s2], w[8 * s2 + 1]); wp.y = pkbf(w[8 * s2 + 2], w[8 * s2 + 3]); wp.z = pkbf(w[8 * s2 + 4], w[8 * s2 + 5]); wp.w = pkbf(w[8 * s2 + 6], w[8 * s2 + 7]);
            const bf16x8 Wf = __builtin_bit_cast(bf16x8, wp);
            const unsigned rb0 = 32 * sb + 16 * s2 + 4 * h + q4, rb1 = rb0 + 8, cb = 2 * blk + (p4 >> 1), bo = 8 * (p4 & 1);
            const unsigned base = (unsigned)(size_t)vt + dq2 * 16384 + bo;
            s16x4 v0a, v0b, v1a, v1b, v2a, v2b, v3a, v3b;
            tr_read8(base + offb(rb0, cb), base + offb(rb1, cb), base + offb(rb0, 4 + cb), base + offb(rb1, 4 + cb), base + offb(rb0, 8 + cb), base + offb(rb1, 8 + cb), base + offb(rb0, 12 + cb), base + offb(rb1, 12 + cb),
                     v0a, v0b, v1a, v1b, v2a, v2b, v3a, v3b);
            O[0] = __builtin_amdgcn_mfma_f32_32x32x16_bf16(__builtin_shufflevector(v0a, v0b, 0, 1, 2, 3, 4, 5, 6, 7), Wf, O[0], 0, 0, 0);
            O[1] = __builtin_amdgcn_mfma_f32_32x32x16_bf16(__builtin_shufflevector(v1a, v1b, 0, 1, 2, 3, 4, 5, 6, 7), Wf, O[1], 0, 0, 0);
            O[2] = __builtin_amdgcn_mfma_f32_32x32x16_bf16(__builtin_shufflevector(v2a, v2b, 0, 1, 2, 3, 4, 5, 6, 7), Wf, O[2], 0, 0, 0);
            O[3] = __builtin_amdgcn_mfma_f32_32x32x16_bf16(__builtin_shufflevector(v3a, v3b, 0, 1, 2, 3, 4, 5, 6, 7), Wf, O[3], 0, 0, 0);
        }
    }
    float ss = 0.f;
#pragma unroll
    for (int dvb = 0; dvb < 4; ++dvb)
#pragma unroll
        for (int i = 0; i < 16; ++i) ss += O[dvb][i] * O[dvb][i];
    ss += __shfl_xor(ss, 32);
    if (h == 0) nt[(ug * 64 + t) * 2 + dq2] = ss;
    __syncthreads();
    const float rs = rsqrtf((nt[(ug * 64 + t) * 2] + nt[(ug * 64 + t) * 2 + 1]) * (1.0f / GDV) + EPS);
#pragma unroll
    for (int dvb = 0; dvb < 4; ++dvb) { unsigned w[4][2];
#pragma unroll
        for (int g = 0; g < 4; ++g) { const int cidx = hd * GDV + 32 * (4 * dq2 + dvb) + 8 * g + 4 * h;
            const v2u rg = rgp[dvb][g]; const f32x4 gv = *(const f32x4*)(gain + cidx), bv = *(const f32x4*)(br + cidx);
            const float rr[4] = {__uint_as_float(rg.x << 16) + bv[0], __uint_as_float(rg.x & 0xffff0000u) + bv[1], __uint_as_float(rg.y << 16) + bv[2], __uint_as_float(rg.y & 0xffff0000u) + bv[3]};
            float y[4];
#pragma unroll
            for (int i = 0; i < 4; ++i) y[i] = O[dvb][4 * g + i] * rs * gv[i] * (rr[i] / (1.f + __expf(-rr[i])));
            w[g][0] = pkbf(y[0], y[1]); w[g][1] = pkbf(y[2], y[3]); }
        const v2u s0 = __builtin_amdgcn_permlane32_swap(w[0][0], w[1][0], false, false), s1 = __builtin_amdgcn_permlane32_swap(w[0][1], w[1][1], false, false);
        const v2u s2 = __builtin_amdgcn_permlane32_swap(w[2][0], w[3][0], false, false), s3 = __builtin_amdgcn_permlane32_swap(w[2][1], w[3][1], false, false);
        bf16* op = cat + (row0 + t) * D + 1024 + hd * GDV + 32 * (4 * dq2 + dvb) + 8 * h;
        *(v4u*)op = (v4u){s0.x, s1.x, s0.y, s1.y}; *(v4u*)(op + 16) = (v4u){s2.x, s3.x, s2.y, s3.y}; }
}

__device__ __forceinline__ void proj_tail_item(LAS unsigned char* sm, const bf16* __restrict__ h0, const bf16* __restrict__ WinT, bf16* __restrict__ proj, int item, int tid, int wave, int lane) {
    LAS float* red = (LAS float*)sm;
    const int fr = lane & 15, kg = lane >> 4; const size_t row0 = (size_t)item * 64;
    f32x4 acc[4];
#pragma unroll
    for (int mt = 0; mt < 4; ++mt) acc[mt] = (f32x4){0.f, 0.f, 0.f, 0.f};
    __syncthreads();
#pragma unroll
    for (int ks = 0; ks < 8; ++ks) { const int k0 = 256 * wave + 32 * ks + 8 * kg;
        const bf16x8 Bf = *(const bf16x8*)(WinT + (size_t)(6144 + fr) * D + k0);
#pragma unroll
        for (int mt = 0; mt < 4; ++mt) { const bf16x8 Af = *(const bf16x8*)(h0 + (row0 + 16 * mt + fr) * D + k0); acc[mt] = __builtin_amdgcn_mfma_f32_16x16x32_bf16(Af, Bf, acc[mt], 0, 0, 0); } }
#pragma unroll
    for (int mt = 0; mt < 4; ++mt)
#pragma unroll
        for (int jj = 0; jj < 4; ++jj) red[(wave * 64 + 16 * mt + 4 * kg + jj) * 16 + fr] = acc[mt][jj];
    __syncthreads();
#pragma unroll
    for (int i = 0; i < 2; ++i) { const int o = i * 512 + tid; float a = 0.f;
#pragma unroll
        for (int w8 = 0; w8 < 8; ++w8) a += red[w8 * 1024 + o];
        proj[(row0 + (o >> 4)) * PROJP + 6144 + (o & 15)] = f2bf(a); }
}

struct Args { const float* in[24]; float* out; unsigned char* ws; int ph_lo, ph_hi; };
__global__ void __launch_bounds__(NWAVES * 64, 2) mk_fwd(Args args) {
    extern __shared__ __attribute__((aligned(16))) unsigned char lds[];
    Frame F;
    F.lds = (LAS unsigned char*)lds; F.MISC = (volatile LAS unsigned*)(F.lds + MISC_OFF);
    F.tid = threadIdx.x; F.lane = F.tid & 63; F.wave = __builtin_amdgcn_readfirstlane(F.tid >> 6);
    F.G = gridDim.x; { const int bx = blockIdx.x; F.vcu = (F.G % 8 == 0) ? (bx % 8) * (F.G / 8) + bx / 8 : bx; }
    F.ws = args.ws; F.ctl = (unsigned*)(args.ws + WS_CTL);
    for (int u = F.tid; u < (LDS_BYTES - LDSCTL_OFF) / 4; u += NWAVES * 64) ((LAS unsigned*)(F.lds + LDSCTL_OFF))[u] = 0u;
    __syncthreads();
    const int lo = args.ph_lo, hi = args.ph_hi;
    const bool multi = (hi - lo) > 1;
    XcdBarrier bar; bar.bar = F.ctl + CW_BAR; bar.x = 0; bar.st = nullptr;
    if (multi) bar = xcd_barrier_post(F.ctl + CW_BAR, F.MISC + 8);
#ifndef DUP_PHASE
#define DUP_PHASE -1
#endif
#define IN(k) (lo <= (k) && (k) < hi)
#define REP(k) for (int rep_ = 0; rep_ < ((DUP_PHASE) == (k) ? 2 : 1); ++rep_)
#define SEAM(k) do { if (IN(k) && IN((k) + 1)) xcd_barrier(bar); } while (0)
    const float* const* in = args.in;
    unsigned char* ws = args.ws;
    bf16* WinT = (bf16*)(ws + WS_WIN); bf16* WoutT = (bf16*)(ws + WS_WOUT); bf16* WxqT = (bf16*)(ws + WS_WXQ); bf16* WxkvT = (bf16*)(ws + WS_WXKV); bf16* WxoT = (bf16*)(ws + WS_WXO);
    bf16* h0 = (bf16*)(ws + WS_H0); bf16* hm = (bf16*)(ws + WS_HM); bf16* projb = (bf16*)(ws + WS_PROJ); float* alr = (float*)(ws + WS_ALR);
    bf16* KVb = (bf16*)(ws + WS_KV); bf16* MKT = (bf16*)(ws + WS_MKT); bf16* NVT = (bf16*)(ws + WS_NVT);
    bf16* catb = (bf16*)(ws + WS_CAT); float* x1 = (float*)(ws + WS_X1); bf16* x1b = (bf16*)(ws + WS_X1B); bf16* qx = (bf16*)(ws + WS_QX); bf16* oxb = (bf16*)(ws + WS_OX); bf16* x2b = (bf16*)(ws + WS_X2);
    bf16* Pb = (bf16*)(ws + WS_PB);
    bf16* hf = (bf16*)(ws + WS_HF); bf16* Hb = (bf16*)(ws + WS_HB); bf16* Yb = (bf16*)(ws + WS_YB);
    bf16* WrHi = (bf16*)(ws + WS_WR); bf16* WrLo = (bf16*)(ws + WS_WR + 512 * 1024); int* elist = (int*)(ws + WS_LIST); float* gatev = (float*)(ws + WS_GATE); int* ecnt = (int*)(F.ctl + CW_CNT);
    float* rowsq1 = (float*)(F.ctl + CW_ROWSQ1); float* rowsq2 = (float*)(F.ctl + CW_ROWSQ2);

    if (IN(0)) REP(0) {
        LAS float* scr = (LAS float*)(F.lds + RING_OFF + F.wave * 18432);
        const int gw = F.vcu * NWAVES + F.wave, NGW = F.G * NWAVES;
        constexpr int KB = D / 64;
        constexpr int I_IN = KB * ((PROJ + 63) / 64), I_KV = KB * (2 * D / 64);
        constexpr int NITEMS = I_IN + I_KV;
        for (int it = gw; it < NITEMS; it += NGW) {
            if (it < I_IN) p0_transpose_item(in[3], D, PROJ, PROJ, nullptr, WinT, 0, scr, it, F.lane);
            else p0_transpose_item(in[13], D, 2 * D, 2 * D, nullptr, WxkvT, 0, scr, it - I_IN, F.lane);
        }
        { const size_t z0 = (size_t)(((PROJ + 63) / 64) * 64) * D, z1 = (size_t)PROJP * D; v4u zz = {0u, 0u, 0u, 0u};
          for (size_t i = z0 / 8 + (size_t)blockIdx.x * 512 + F.tid; i < z1 / 8; i += (size_t)F.G * 512) ((v4u*)WinT)[i] = zz; }
        for (int i = blockIdx.x * 512 + F.tid; i < 80 * D; i += F.G * 512) { const int n = i / D, k = i % D; const float v = n < 8 ? in[16][k * 8 + n] : (n < 72 ? in[18][k * 64 + n - 8] : 0.f);
            const int j = ((((k >> 5) * 5 + (n >> 4)) * 64) + ((k & 31) >> 3) * 16 + (n & 15)) * 8 + (k & 7);
            const unsigned short hi = f2bf(v); WrHi[j] = hi; WrLo[j] = f2bf(v - bf2f(hi)); }
        for (int m = gw; m < NTOK; m += NGW) rms_row_to_bf16(in[0] + (size_t)m * D, in[2], h0 + (size_t)m * D, F.lane);
        for (int m = gw; m < NMEM; m += NGW) rms_row_to_bf16(in[1] + (size_t)m * D, in[11], hm + (size_t)m * D, F.lane);
    }
    SEAM(0);
    if (IN(1)) REP(1) {
        pg8::DenseSched S{(const char*)h0, (const char*)WinT, D * 2, D * 2, D, NTOK / 256, 24, F.G, (int)blockIdx.x};
        EpiProj E{projb, alr};
        pg8::gemm_phase<EpiProj, pg8::DenseSched, true>(F.lds + RING_OFF, S, E);
    }
    SEAM(1);
    if (IN(2)) REP(2) {
        { pg8::DenseSched S{(const char*)hm, (const char*)WxkvT, D * 2, D * 2, D, NMEM / 256, 2 * D / 256, F.G, (int)blockIdx.x};
          EpiBf16 E{KVb, 2 * D};
          pg8::gemm_phase<EpiBf16, pg8::DenseSched, true>(F.lds + RING_OFF, S, E); }
        { const int first = (F.G > 64 + 32) ? 64 : 0, nl = F.G - first, li = (int)blockIdx.x - first;
          if (li >= 0) { LAS float* scr = (LAS float*)(F.lds + RING_OFF + F.wave * 18432);
              constexpr int I_SQ = (D / 64) * (D / 64);
              for (int it = li * NWAVES + F.wave; it < 2 * I_SQ; it += nl * NWAVES) {
                  if (it < I_SQ) p0_transpose_item(in[9], D, D, D, nullptr, WoutT, 0, scr, it, F.lane);
                  else p0_transpose_item(in[14], D, D, D, nullptr, WxoT, 0, scr, it - I_SQ, F.lane); }
              for (int i = li * 512 + F.tid; i < D * D / 4; i += nl * 512) { const f32x4 v = ((const f32x4*)in[12])[i]; const float g = in[10][i / (D / 4)]; v2u o; o.x = pkbf(v[0] * g, v[1] * g); o.y = pkbf(v[2] * g, v[3] * g); ((v2u*)WxqT)[i] = o; } } }
        for (;;) {
            if (F.tid == 0) F.MISC[20] = (unsigned)__hip_atomic_fetch_add(F.ctl + CW_Q + 128, 1u, __ATOMIC_RELAXED, __HIP_MEMORY_SCOPE_AGENT);
            __syncthreads();
            const int item = (int)F.MISC[20];
            __syncthreads();
            if (item >= NTOK / 64) break;
            proj_tail_item(F.lds + RING_OFF, h0, WinT, projb, item, F.tid, F.wave, F.lane);
        }
        for (;;) {
            if (F.tid == 0) F.MISC[20] = (unsigned)__hip_atomic_fetch_add(F.ctl + CW_Q, 1u, __ATOMIC_RELAXED, __HIP_MEMORY_SCOPE_AGENT);
            __syncthreads();
            const int item = (int)F.MISC[20];
            __syncthreads();
            if (item >= 512) break;
            gla_pass1_unit(F.lds + RING_OFF, projb, alr, in[4], in[5], (bf16*)(ws + WS_GQD), (bf16*)(ws + WS_GKI), (float*)(ws + WS_GEL), (bf16*)(ws + WS_GU), item, F.tid, F.wave, F.lane);
        }
        for (;;) {
            if (F.tid == 0) F.MISC[20] = (unsigned)__hip_atomic_fetch_add(F.ctl + CW_Q + 64, 1u, __ATOMIC_RELAXED, __HIP_MEMORY_SCOPE_AGENT);
            __syncthreads();
            const int item = (int)F.MISC[20];
            __syncthreads();
            if (item >= BATCH * SBH * (SEQ / 32) / NWAVES) break;
            sb_wg_unit(F.lds + RING_OFF, projb, in[7], catb, item, F.wave, F.lane);
        }
    }
    SEAM(2);
    if (IN(3)) REP(3) {
        { MktSched S{(const char*)KVb, (const char*)WxqT, D * 2, XD, F.G, (int)blockIdx.x}; EpiBf16 E{MKT, D};
          pg8::gemm_phase<EpiBf16, MktSched, true>(F.lds + RING_OFF, S, E); }
        { NvtSched S{(const char*)WxoT, (const char*)KVb, 2 * D * 2, XD, F.G, ((int)blockIdx.x + F.G - 128) % F.G}; EpiBf16 E{NVT, 1024};
          pg8::gemm_phase<EpiBf16, NvtSched, true>(F.lds + RING_OFF, S, E); }
        const bf16* Ug = (const bf16*)(ws + WS_GU); const float* elg = (const float*)(ws + WS_GEL); bf16* Sg = (bf16*)(ws + WS_GS);
        for (int g = blockIdx.x * 512 + F.tid; g < BATCH * GH * 8192; g += F.G * 512) { const int bh = g >> 13, idx = g & 8191, dk = (idx & 31) * 4;
            f32x4 S4 = {0.f, 0.f, 0.f, 0.f};
#pragma unroll 8
            for (int c = 0; c < 32; ++c) { const size_t u = (size_t)bh * 32 + c; const v2u ub = __builtin_nontemporal_load((const v2u*)(Ug + u * 32768 + (size_t)idx * 4)); const f32x4 u4 = {__uint_as_float(ub.x << 16), __uint_as_float(ub.x & 0xffff0000u), __uint_as_float(ub.y << 16), __uint_as_float(ub.y & 0xffff0000u)}, e4 = *(const f32x4*)(elg + u * 128 + dk);
                v2u o; o.x = pkbf(S4[0], S4[1]); o.y = pkbf(S4[2], S4[3]); *(v2u*)(Sg + u * 32768 + (size_t)idx * 4) = o;
                S4 = (S4 + u4) * e4; } }
    }
    SEAM(3);
    if (IN(4)) REP(4) {
        for (int unit = blockIdx.x; unit < 512; unit += 2 * F.G)
            gla_pass3_pair(F.lds + RING_OFF, projb, (const bf16*)(ws + WS_GQD), (const bf16*)(ws + WS_GKI), (const bf16*)(ws + WS_GS), in[8], in[6], catb, unit, (unit + F.G < 512) ? unit + F.G : unit, F.tid, F.wave, F.lane);
    }
    SEAM(4);
    if (IN(5)) REP(5) {
        pg8::DenseSched S{(const char*)catb, (const char*)WoutT, D * 2, D * 2, D, NTOK / 256, D / 256, F.G, (int)blockIdx.x};
        EpiResid E{in[0], nullptr, nullptr, x1b, rowsq1};
        pg8::gemm_phase<EpiResid, pg8::DenseSched, false>(F.lds + RING_OFF, S, E);
    }
    SEAM(5);
    if (IN(6)) REP(6) {
        EpiSoftmax128 E{Pb, (LAS float*)(F.lds + LDSCTL_OFF + 1024), rowsq1};
        for (int c = blockIdx.x; c < 256; c += F.G) { const int hp = 8 * (c & 7) + (c >> 5), h = (c >> 3) & 3, b = hp >> 4;
            pg8::Unit u; u.pm = hp; u.pn = h; u.z = c; u.mv = 128; u.A = (const char*)x1b + (size_t)hp * 128 * D * 2; u.B = (const char*)MKT + (size_t)(b * 1024 + h * 256) * D * 2;
            pg8::gemm128_unit<EpiSoftmax128>(F.lds + RING_OFF, u.A, D * 2, u.B, D * 2, D, E, u); }
    }
    SEAM(6);
    if (IN(7)) REP(7) {
        XOutSched S{(const char*)Pb, (const char*)NVT, 1024 * 2, 1024, F.G, (int)blockIdx.x};
        EpiResid E{nullptr, x1b, nullptr, x2b, rowsq2};
        pg8::gemm_phase<EpiResid, XOutSched, false>(F.lds + RING_OFF, S, E);
    }
    SEAM(7);
    if (IN(8)) REP(8) {
        LAS float* red = (LAS float*)(F.lds + RING_OFF);
        LAS float* lg = (LAS float*)(F.lds + RING_OFF + 81920);
        const int kg = F.lane >> 4, fr = F.lane & 15;
        for (int tile = blockIdx.x; tile < NTOK / 32; tile += F.G) {
            const int row0 = tile * 32;
            f32x4 racc[2][5];
#pragma unroll
            for (int rt = 0; rt < 2; ++rt)
#pragma unroll
                for (int nt = 0; nt < 5; ++nt) racc[rt][nt] = (f32x4){0.f, 0.f, 0.f, 0.f};
            float rs[2];
#pragma unroll
            for (int rt = 0; rt < 2; ++rt) rs[rt] = rsqrtf(rowsq2[row0 + 16 * rt + fr] * (1.0f / D) + EPS);
            for (int kh = 0; kh < 4; ++kh) {
                v4u xa[2][2];
#pragma unroll
                for (int k4 = 0; k4 < 2; ++k4)
#pragma unroll
                    for (int rt = 0; rt < 2; ++rt) { const size_t ro = (size_t)(row0 + 16 * rt + fr) * D + 256 * F.wave + 32 * (2 * kh + k4) + 8 * kg; xa[k4][rt] = __builtin_nontemporal_load((const v4u*)(x2b + ro)); }
#pragma unroll
                for (int k4 = 0; k4 < 2; ++k4) {
                    const int k0 = 256 * F.wave + 32 * (2 * kh + k4) + 8 * kg;
                    const f32x4 g0 = *(const f32x4*)(in[15] + k0), g1 = *(const f32x4*)(in[15] + k0 + 4);
                    bf16x8 Ahi[2], Alo[2];
#pragma unroll
                    for (int rt = 0; rt < 2; ++rt) { const size_t ro = (size_t)(row0 + 16 * rt + fr) * D + k0; const v4u xb = xa[k4][rt]; const f32x4 a0 = {__uint_as_float(xb.x << 16), __uint_as_float(xb.x & 0xffff0000u), __uint_as_float(xb.y << 16), __uint_as_float(xb.y & 0xffff0000u)}, a1 = {__uint_as_float(xb.z << 16), __uint_as_float(xb.z & 0xffff0000u), __uint_as_float(xb.w << 16), __uint_as_float(xb.w & 0xffff0000u)};
                        float v[8]; v[0] = a0[0] * rs[rt] * g0[0]; v[1] = a0[1] * rs[rt] * g0[1]; v[2] = a0[2] * rs[rt] * g0[2]; v[3] = a0[3] * rs[rt] * g0[3];
                        v[4] = a1[0] * rs[rt] * g1[0]; v[5] = a1[1] * rs[rt] * g1[1]; v[6] = a1[2] * rs[rt] * g1[2]; v[7] = a1[3] * rs[rt] * g1[3];
                        v4u hp, lp;
#pragma unroll
                        for (int j = 0; j < 4; ++j) { const unsigned hpk = pkbf(v[2 * j], v[2 * j + 1]); hp[j] = hpk; lp[j] = pkbf(v[2 * j] - __uint_as_float(hpk << 16), v[2 * j + 1] - __uint_as_float(hpk & 0xffff0000u)); }
                        *(v4u*)(hf + ro) = hp; Ahi[rt] = __builtin_bit_cast(bf16x8, hp); Alo[rt] = __builtin_bit_cast(bf16x8, lp); }
#pragma unroll
                    for (int nt = 0; nt < 5; ++nt) { const size_t bo = (size_t)((((8 * F.wave + 2 * kh + k4) * 5 + nt) * 64 + F.lane) * 8); const bf16x8 Bh = *(const bf16x8*)(WrHi + bo), Bl = *(const bf16x8*)(WrLo + bo);
#pragma unroll
                        for (int rt = 0; rt < 2; ++rt) { racc[rt][nt] = __builtin_amdgcn_mfma_f32_16x16x32_bf16(Ahi[rt], Bh, racc[rt][nt], 0, 0, 0);
                            racc[rt][nt] = __builtin_amdgcn_mfma_f32_16x16x32_bf16(Alo[rt], Bh, racc[rt][nt], 0, 0, 0); racc[rt][nt] = __builtin_amdgcn_mfma_f32_16x16x32_bf16(Ahi[rt], Bl, racc[rt][nt], 0, 0, 0); } }
                }
            }
#pragma unroll
            for (int rt = 0; rt < 2; ++rt)
#pragma unroll
                for (int nt = 0; nt < 5; ++nt)
#pragma unroll
                    for (int j = 0; j < 4; ++j) red[(F.wave * 32 + 16 * rt + 4 * kg + j) * 80 + 16 * nt + fr] = racc[rt][nt][j];
            __syncthreads();
            for (int o = F.tid; o < 32 * 80; o += 512) { float a = 0.f;
#pragma unroll
                for (int w8 = 0; w8 < 8; ++w8) a += red[w8 * 2560 + o]; lg[o] = a; }
            __syncthreads();
            if (F.tid < 32) { const int tkn = row0 + F.tid; const LAS float* l = lg + F.tid * 80;
                int g = 0; float mg = l[0] + in[17][0];
                for (int i = 1; i < 8; ++i) { const float v = l[i] + in[17][i]; if (v > mg) { mg = v; g = i; } }
                float sg = 0.f; for (int i = 0; i < 8; ++i) sg += __expf(l[i] + in[17][i] - mg);
                const float ptop = 1.f / sg;
                int i1 = 0; float m1 = l[8 + g * 8] + in[19][g * 8];
                for (int i = 1; i < 8; ++i) { const float v = l[8 + g * 8 + i] + in[19][g * 8 + i]; if (v > m1) { m1 = v; i1 = i; } }
                int i2 = 0; float m2 = -3.4e38f;
                for (int i = 0; i < 8; ++i) { const float v = l[8 + g * 8 + i] + in[19][g * 8 + i]; if (i != i1 && v > m2) { m2 = v; i2 = i; } }
                const float rr = __expf(m2 - m1), w1 = 1.f / (1.f + rr), w2 = rr / (1.f + rr);
                const int e1 = g * 8 + i1, e2 = g * 8 + i2;
                const int s1 = atomicAdd(&ecnt[e1 * 64], 1), s2 = atomicAdd(&ecnt[e2 * 64], 1);
                elist[(size_t)e1 * NTOK + s1] = tkn * 2; gatev[tkn * 2] = ptop * w1;
                elist[(size_t)e2 * NTOK + s2] = tkn * 2 + 1; gatev[tkn * 2 + 1] = ptop * w2; }
            __syncthreads();
        }
    }
    const bool pre9 = IN(8) && IN(9), pre10 = IN(9) && IN(10);
    if (pre9) xcd_barrier_pf(bar, [&]() { moe_prefetch<0>(F.lds + RING_OFF, in[20], in[21], F.wave, F.lane); });
    if (IN(9)) REP(9) {
        moe_stream_wg<0>(F.lds + RING_OFF, (const char*)hf, D * 2, 1, in[20], in[21], elist, ecnt, Hb, nullptr, F.G, pre9 && rep_ == 0, F.tid, F.wave, F.lane);
    }
    if (pre10) xcd_barrier_pf(bar, [&]() { moe_prefetch<1>(F.lds + RING_OFF, in[22], nullptr, F.wave, F.lane); });
    if (IN(10)) REP(10) {
        moe_stream_wg<1>(F.lds + RING_OFF, (const char*)Hb, FF * 2, 0, in[22], nullptr, elist, ecnt, Yb, gatev, F.G, pre10 && rep_ == 0, F.tid, F.wave, F.lane);
    }
    SEAM(10);
    if (IN(11)) REP(11) {
        const int gw = F.vcu * NWAVES + F.wave, NGW = F.G * NWAVES;
        for (int m = gw; m < NTOK; m += NGW) {
            const v2u* xr = (const v2u*)(x2b + (size_t)m * D) + F.lane; const v2u* y0 = (const v2u*)(Yb + (size_t)(2 * m) * D) + F.lane; const v2u* y1 = (const v2u*)(Yb + (size_t)(2 * m + 1) * D) + F.lane;
            f32x4 v[8]; float ssq = 0.f;
#pragma unroll
            for (int j = 0; j < 8; ++j) { const v2u a = __builtin_nontemporal_load(y0 + 64 * j), b2 = __builtin_nontemporal_load(y1 + 64 * j), xx = __builtin_nontemporal_load(xr + 64 * j); f32x4 t4;
                t4[0] = __uint_as_float(xx.x << 16) + __uint_as_float(a.x << 16) + __uint_as_float(b2.x << 16); t4[1] = __uint_as_float(xx.x & 0xffff0000u) + __uint_as_float(a.x & 0xffff0000u) + __uint_as_float(b2.x & 0xffff0000u);
                t4[2] = __uint_as_float(xx.y << 16) + __uint_as_float(a.y << 16) + __uint_as_float(b2.y << 16); t4[3] = __uint_as_float(xx.y & 0xffff0000u) + __uint_as_float(a.y & 0xffff0000u) + __uint_as_float(b2.y & 0xffff0000u);
                v[j] = t4; ssq += (t4[0] * t4[0] + t4[1] * t4[1]) + (t4[2] * t4[2] + t4[3] * t4[3]); }
            const float rstd = rsqrtf(wave_sum(ssq) * (1.f / D) + EPS);
            f32x4* o4 = (f32x4*)(args.out + (size_t)m * D) + F.lane;
#pragma unroll
            for (int j = 0; j < 8; ++j) { const f32x4 g = ((const f32x4*)in[23])[64 * j + F.lane]; __builtin_nontemporal_store(v[j] * rstd * g, o4 + 64 * j); }
        }
    }
#undef IN
#undef SEAM
}


extern "C" void kernel_launch(void* const* d_in, const int* in_sizes, int n_in, void* d_out, int out_size, void* d_ws, size_t ws_size, hipStream_t stream) {
    static int grid = 0;
    if (!grid) {
        if (WS_NEW_END > ws_size || n_in != 24) { fprintf(stderr, "kernel_launch: workspace too small (%zu < %zu) or n_in %d != 24\n", ws_size, (size_t)WS_NEW_END, n_in); grid = -1; return; }
        (void)hipFuncSetAttribute((const void*)mk_fwd, hipFuncAttributeMaxDynamicSharedMemorySize, LDS_BYTES);
        int dev = 0, cus = 0, per_cu = 0; (void)hipGetDevice(&dev); (void)hipDeviceGetAttribute(&cus, hipDeviceAttributeMultiprocessorCount, dev);
        (void)hipOccupancyMaxActiveBlocksPerMultiprocessor(&per_cu, (const void*)mk_fwd, NWAVES * 64, LDS_BYTES);
        (void)hipGetLastError();
        grid = cus > 0 ? cus : 256;
        if (per_cu < 1) fprintf(stderr, "kernel_launch: occupancy query reports %d workgroups per CU\n", per_cu);
    }
    if (grid < 0) return;
    (void)hipMemsetAsync((char*)d_ws + WS_CTL, 0, CTL_ZERO_BYTES, stream);
    Args a{};
    for (int i = 0; i < 24; ++i) a.in[i] = (const float*)d_in[i];
    a.out = (float*)d_out; a.ws = (unsigned char*)d_ws; a.ph_lo = 0; a.ph_hi = 12;
#if defined(EXP_LO)
    a.ph_hi = EXP_HI + 1;
    hipLaunchKernelGGL(mk_fwd, dim3(grid), dim3(NWAVES * 64), LDS_BYTES, stream, a);
    (void)hipMemsetAsync((char*)d_ws + WS_CTL + CW_BAR * 4, 0, XCD_BAR_WORDS * 4, stream);
    if (EXP_LO <= 2 && 2 <= EXP_HI) (void)hipMemsetAsync((char*)d_ws + WS_CTL + CW_Q * 4, 0, 1024, stream);
    if (EXP_LO <= 5 && 5 <= EXP_HI) (void)hipMemsetAsync((char*)d_ws + WS_CTL + CW_ROWSQ1 * 4, 0, NTOK * 4, stream);
    if (EXP_LO <= 7 && 7 <= EXP_HI) (void)hipMemsetAsync((char*)d_ws + WS_CTL + CW_ROWSQ2 * 4, 0, NTOK * 4, stream);
    if (EXP_LO <= 8 && 8 <= EXP_HI) (void)hipMemsetAsync((char*)d_ws + WS_CTL + CW_CNT * 4, 0, NE * 256, stream);
    a.ph_lo = EXP_LO; a.ph_hi = 12;
#endif
    hipLaunchKernelGGL(mk_fwd, dim3(grid), dim3(NWAVES * 64), LDS_BYTES, stream, a);
}
```

```cpp
#include <hip/hip_runtime.h>
#include <cstdio>
#include <cstdint>

constexpr int D = 2048, BATCH = 4, SEQ = 2048, NTOK = BATCH * SEQ;
constexpr int MEM = 256, NMEM = BATCH * MEM;
constexpr int PROJ = 6160;
constexpr int C_QSB = 0, C_KSB = 1024, C_VSB = 2048, C_QG = 3072, C_KG = 3584, C_VG = 4096, C_ALR = 5120, C_RG = 5136;
constexpr int SBH = 8, SBD = 128, GH = 4, GDK = 128, GDV = 256, GRANK = 16, CHUNK = 64;
constexpr int XH = 4, XD = 512;
constexpr int NG = 8, EPG = 8, NE = 64, FF = 512, NPAIR = NTOK * 2;
constexpr float EPS = 1e-6f;

typedef short bf16x8 __attribute__((ext_vector_type(8)));
typedef float f32x4 __attribute__((ext_vector_type(4)));

__device__ __forceinline__ unsigned short f2bf(float f) { unsigned u = __float_as_uint(f); u += 0x7fffu + ((u >> 16) & 1u); return (unsigned short)(u >> 16); }

namespace pg8 {
#define PG8_LAS __attribute__((address_space(3)))
typedef unsigned short bf16_t;
typedef unsigned u32x4 __attribute__((ext_vector_type(4)));
typedef unsigned u32x2 __attribute__((ext_vector_type(2)));
constexpr int BM = 256, BK = 64, HALF = 128, HTB = HALF * BK * 2, STAGE_BYTES = 8 * HTB, NXCD = 8, WGM = 8;
__host__ __device__ __forceinline__ int lds_byte(int r, int c) { const int st = (r >> 4) * 2 + (c >> 5), rr = r & 15, cc = c & 31, ob = rr * 64 + cc * 2; return st * 1024 + (ob ^ (((ob >> 9) & 1) << 5)); }
__host__ __device__ __forceinline__ void stage_rc(int b, int& R, int& C) { const int st = b / 1024, sb = b % 1024, swz = sb ^ (((sb >> 9) & 1) << 5); R = (st >> 1) * 16 + swz / 64; C = (st & 1) * 32 + (swz % 64) / 2; }
__host__ __device__ __forceinline__ int perm32(int rho) { const int n = rho >> 4, i = rho & 15; return 8 * (i >> 2) + 4 * n + (i & 3); }
__device__ __forceinline__ unsigned cvt_pk_bf16(float lo, float hi) { unsigned r; asm volatile("v_cvt_pk_bf16_f32 %0, %1, %2" : "=v"(r) : "v"(lo), "v"(hi)); return r; }

struct Unit { const char* A; const char* B; int pm, pn, z, mv; };

__device__ __forceinline__ void tile_order(int L, int nM, int nN, int& pm, int& pn) {
    const int nwg = nM * nN; int wgid = L;
    { const int q = nwg / NXCD, r = nwg % NXCD, xcd = wgid % NXCD, off = wgid / NXCD; wgid = (xcd < r ? xcd * (q + 1) : r * (q + 1) + (xcd - r) * q) + off; }
    const int nig = WGM * nN, gid = wgid / nig, fm = gid * WGM, gsz = (nM - fm) < WGM ? (nM - fm) : WGM;
    pm = fm + ((wgid % nig) % gsz); pn = (wgid % nig) / gsz;
}
struct DenseSched {
    const char* A; const char* Bt; unsigned lda, ldb; int K, nM, nN, G, c;
    __device__ __forceinline__ bool next(int i, Unit& u) const { const long L = (long)i * G + c; if (c < 0 || L >= (long)nM * nN) return false; int pm, pn; tile_order((int)L, nM, nN, pm, pn);
        u.pm = pm; u.pn = pn; u.z = 0; u.mv = 256; u.A = A + (size_t)pm * 256 * lda; u.B = Bt + (size_t)pn * 256 * ldb; return true; }
    __device__ __forceinline__ unsigned arow(const Unit&, int r) const { return (unsigned)r * lda; }
    __device__ __forceinline__ void a_ready(const Unit&) const {}
    __device__ __forceinline__ void done(const Unit&) const {}
};

struct ColTileSched {
    const char* A; const char* Bt; unsigned lda, ldb; int K, nM, pn, G, c;
    __device__ __forceinline__ bool next(int i, Unit& u) const { const long L = (long)i * G + c; if (c < 0 || L >= nM) return false;
        u.pm = (int)L; u.pn = pn; u.z = 0; u.mv = 256; u.A = A + (size_t)L * 256 * lda; u.B = Bt + (size_t)pn * 256 * ldb; return true; }
    __device__ __forceinline__ unsigned arow(const Unit&, int r) const { return (unsigned)r * lda; }
    __device__ __forceinline__ void a_ready(const Unit&) const {}
    __device__ __forceinline__ void done(const Unit&) const {}
};

template <class Epi, class Sched, bool ALIGN_EPI>
__device__ __forceinline__ void gemm_phase(PG8_LAS unsigned char* lds, const Sched& S, const Epi& E) {
    const int tid = threadIdx.x, wid = __builtin_amdgcn_readfirstlane(tid >> 6), lane = tid & 63, wr = wid >> 2, wc = wid & 3, fr = lane & 15, fq = lane >> 4;
    const int nt = S.K / BK;
    int R0, C0, R1, C1; stage_rc(tid * 16, R0, C0); stage_rc(tid * 16 + 8192, R1, C1);
    const int Rb0 = Epi::PERM ? ((R0 & ~31) + perm32(R0 & 31)) : R0, Rb1 = Epi::PERM ? ((R1 & ~31) + perm32(R1 & 31)) : R1;
    const unsigned ldb = S.ldb;
    const unsigned vB0 = (unsigned)Rb0 * ldb + (unsigned)C0 * 2u, vB1 = (unsigned)Rb1 * ldb + (unsigned)C1 * 2u;
    const size_t kstep = (size_t)(BK * 2);
    const size_t hstepB = (size_t)HALF * ldb;
    const unsigned ldsw = (unsigned)wid * 1024u;
    const int aoff = lds_byte(wr * 64 + fr, fq * 8), boff = lds_byte(wc * 32 + fr, fq * 8);
#define PG8_SA(b, h) (((b) * 2 + (h)) * HTB)
#define PG8_SB(b, h) ((4 + (b) * 2 + (h)) * HTB)
#define PG8_STG(bufoff, gbase, v0, v1) do { \
        __builtin_amdgcn_global_load_lds((const unsigned*)((const char*)(gbase) + (v0)), (PG8_LAS unsigned*)(lds + (bufoff) + ldsw), 16, 0, 0); \
        __builtin_amdgcn_global_load_lds((const unsigned*)((const char*)(gbase) + (v1)), (PG8_LAS unsigned*)(lds + (bufoff) + ldsw + 8192), 16, 0, 0); } while (0)
#define PG8_STGB(bufoff, gbase) PG8_STG(bufoff, gbase, vB0, vB1)
#define PG8_LDA(dst, b, h) do { _Pragma("unroll") for (int m = 0; m < 4; ++m) _Pragma("unroll") for (int k = 0; k < 2; ++k) dst[m][k] = *(const PG8_LAS bf16x8*)(lds + PG8_SA(b, h) + aoff + m * 2048 + k * 1024); } while (0)
#define PG8_LDB(dst, b, h) do { _Pragma("unroll") for (int n = 0; n < 2; ++n) _Pragma("unroll") for (int k = 0; k < 2; ++k) dst[n][k] = *(const PG8_LAS bf16x8*)(lds + PG8_SB(b, h) + boff + n * 2048 + k * 1024); } while (0)
#define PG8_MMA(ai, bj, At, Bt) do { __builtin_amdgcn_s_setprio(1); _Pragma("unroll") for (int m = 0; m < 4; ++m) _Pragma("unroll") for (int n = 0; n < 2; ++n) _Pragma("unroll") for (int k = 0; k < 2; ++k) \
        acc[ai][bj][m][n] = __builtin_amdgcn_mfma_f32_16x16x32_bf16(Bt[n][k], At[m][k], acc[ai][bj][m][n], 0, 0, 0); __builtin_amdgcn_s_setprio(0); } while (0)
#define PG8_WAIT_V(n) asm volatile("s_waitcnt vmcnt(" #n ")" ::: "memory")
#define PG8_WAIT_L(n) asm volatile("s_waitcnt lgkmcnt(" #n ")" ::: "memory")
#define PG8_BAR __builtin_amdgcn_s_barrier()
#define PG8_SCHED __builtin_amdgcn_sched_barrier(0)
#define PG8_OFFS(u, o00, o01, o10, o11) do { o00 = S.arow(u, R0) + (unsigned)C0 * 2u; o01 = S.arow(u, R1) + (unsigned)C1 * 2u; o10 = S.arow(u, HALF + R0) + (unsigned)C0 * 2u; o11 = S.arow(u, HALF + R1) + (unsigned)C1 * 2u; } while (0)
    Unit cur, nxt; int ui = 0;
    if (!S.next(0, cur)) return;
    f32x4 acc[2][2][4][2];
#pragma unroll
    for (int a = 0; a < 2; ++a)
#pragma unroll
        for (int b = 0; b < 2; ++b)
#pragma unroll
            for (int m = 0; m < 4; ++m)
#pragma unroll
                for (int n = 0; n < 2; ++n) acc[a][b][m][n] = (f32x4){0.f, 0.f, 0.f, 0.f};
    bf16x8 At[4][2], B0[2][2], B1[2][2];
    const char* cA = cur.A; const char* cB = cur.B;
    unsigned c00, c01, c10, c11; PG8_OFFS(cur, c00, c01, c10, c11);
    S.a_ready(cur);
    PG8_STGB(PG8_SB(0, 0), cB); PG8_STGB(PG8_SB(0, 1), cB + hstepB); PG8_STG(PG8_SA(0, 0), cA, c00, c01); PG8_STG(PG8_SA(0, 1), cA, c10, c11);
    if (wr == 1) PG8_BAR;
    PG8_WAIT_V(2); PG8_BAR;
    PG8_STGB(PG8_SB(1, 0), cB + kstep); PG8_STG(PG8_SA(1, 0), cA + kstep, c00, c01); PG8_STGB(PG8_SB(1, 1), cB + hstepB + kstep);
    PG8_WAIT_V(6); PG8_BAR;
    for (;;) {
        const bool has_next = S.next(ui + 1, nxt);
        const char* nA = has_next ? nxt.A : cA; const char* nB = has_next ? nxt.B : cB;
        unsigned n00 = c00, n01 = c01, n10 = c10, n11 = c11;
        if (has_next) PG8_OFFS(nxt, n00, n01, n10, n11);
        for (int t = 0; t < nt; t += 2) {
            const bool last = (t == nt - 2);
            const char* a1 = cA + (size_t)(t + 1) * kstep;
            const char* a2 = last ? nA : cA + (size_t)(t + 2) * kstep; const char* b2 = last ? nB : cB + (size_t)(t + 2) * kstep;
            const char* a3 = a2 + kstep; const char* b3 = b2 + kstep;
            const unsigned x00 = last ? n00 : c00, x01 = last ? n01 : c01, x10 = last ? n10 : c10, x11 = last ? n11 : c11;
            if (last && has_next) S.a_ready(nxt);
            PG8_LDB(B0, 0, 0); PG8_LDB(B1, 0, 1); PG8_SCHED; PG8_LDA(At, 0, 0); PG8_STG(PG8_SA(1, 1), a1, c10, c11);
            PG8_WAIT_V(8); PG8_WAIT_L(0); PG8_BAR; PG8_MMA(0, 0, At, B0); PG8_MMA(0, 1, At, B1); PG8_BAR; PG8_SCHED;
            PG8_LDA(At, 0, 1); PG8_STGB(PG8_SB(0, 0), b2); PG8_STGB(PG8_SB(0, 1), b2 + hstepB); PG8_STG(PG8_SA(0, 0), a2, x00, x01);
            PG8_WAIT_V(8); PG8_WAIT_L(0); PG8_BAR; PG8_MMA(1, 0, At, B0); PG8_MMA(1, 1, At, B1); PG8_BAR; PG8_SCHED;
            PG8_LDB(B0, 1, 0); PG8_LDB(B1, 1, 1); PG8_SCHED; PG8_LDA(At, 1, 0); PG8_STG(PG8_SA(0, 1), a2, x10, x11);
            PG8_WAIT_V(8); PG8_WAIT_L(0); PG8_BAR; PG8_MMA(0, 0, At, B0); PG8_MMA(0, 1, At, B1); PG8_BAR; PG8_SCHED;
            PG8_LDA(At, 1, 1); PG8_STGB(PG8_SB(1, 0), b3); PG8_STGB(PG8_SB(1, 1), b3 + hstepB); PG8_STG(PG8_SA(1, 0), a3, x00, x01);
            PG8_WAIT_V(8); PG8_WAIT_L(0); PG8_BAR; PG8_MMA(1, 0, At, B0); PG8_MMA(1, 1, At, B1); PG8_BAR; PG8_SCHED;
        }
        if constexpr (ALIGN_EPI) { if (wr == 0) PG8_BAR; }
        if constexpr (!Epi::AFTER_DRAIN) { E(acc, cur, wr, wc, fr, fq); S.done(cur); }
        if (!has_next) break;
#pragma unroll
        for (int a = 0; a < 2; ++a)
#pragma unroll
            for (int b = 0; b < 2; ++b)
#pragma unroll
                for (int m = 0; m < 4; ++m)
#pragma unroll
                    for (int n = 0; n < 2; ++n) acc[a][b][m][n] = (f32x4){0.f, 0.f, 0.f, 0.f};
        cur = nxt; cA = nA; cB = nB; c00 = n00; c01 = n01; c10 = n10; c11 = n11; ++ui;
        if constexpr (ALIGN_EPI) { if (wr == 1) PG8_BAR; }
    }
    PG8_WAIT_V(0);
    if constexpr (!ALIGN_EPI) { if (wr == 0) PG8_BAR; }
    PG8_BAR;
    if constexpr (Epi::AFTER_DRAIN) { E.fused(acc, cur, wr, wc, fr, fq, lds, wid, lane); S.done(cur); }
#undef PG8_SA
#undef PG8_SB
#undef PG8_STG
#undef PG8_STGB
#undef PG8_LDA
#undef PG8_LDB
#undef PG8_MMA
#undef PG8_WAIT_V
#undef PG8_WAIT_L
#undef PG8_BAR
#undef PG8_SCHED
#undef PG8_OFFS
}

template <class Epi>
__device__ __forceinline__ void gemm128_unit(PG8_LAS unsigned char* lds, const char* A, unsigned lda, const char* B, unsigned ldb, int K, const Epi& E, const Unit& u) {
    const int tid = threadIdx.x, wid = __builtin_amdgcn_readfirstlane(tid >> 6), lane = tid & 63, wr = wid >> 2, wc = wid & 3, fr = lane & 15, fq = lane >> 4;
    const int nt = K / BK;
    int R0, C0, R1, C1; stage_rc(tid * 16, R0, C0); stage_rc(tid * 16 + 8192, R1, C1);
    const int Rb0 = (R0 & ~31) + perm32(R0 & 31), Rb1 = (R1 & ~31) + perm32(R1 & 31);
    const unsigned vB0 = (unsigned)Rb0 * ldb + (unsigned)C0 * 2u, vB1 = (unsigned)Rb1 * ldb + (unsigned)C1 * 2u, vA0 = (unsigned)R0 * lda + (unsigned)C0 * 2u, vA1 = (unsigned)R1 * lda + (unsigned)C1 * 2u;
    const size_t hstepB = (size_t)HALF * ldb;
    const unsigned ldsw = (unsigned)wid * 1024u;
    const int aoff = lds_byte(wr * 64 + fr, fq * 8), boff = lds_byte(wc * 32 + fr, fq * 8);
    constexpr int STG3 = 3 * HTB;
#define G8_STG(off, gbase, v0, v1) do { \
        __builtin_amdgcn_global_load_lds((const unsigned*)((const char*)(gbase) + (v0)), (PG8_LAS unsigned*)(lds + (off) + ldsw), 16, 0, 0); \
        __builtin_amdgcn_global_load_lds((const unsigned*)((const char*)(gbase) + (v1)), (PG8_LAS unsigned*)(lds + (off) + ldsw + 8192), 16, 0, 0); } while (0)
#define G8_TILE(so, kt) do { const char* bb_ = B + (size_t)(kt) * (BK * 2); const char* aa_ = A + (size_t)(kt) * (BK * 2); \
        G8_STG((so), bb_, vB0, vB1); G8_STG((so) + HTB, bb_ + hstepB, vB0, vB1); G8_STG((so) + 2 * HTB, aa_, vA0, vA1); } while (0)
#define G8_MMA(bj, Bt) do { __builtin_amdgcn_s_setprio(1); _Pragma("unroll") for (int m = 0; m < 4; ++m) _Pragma("unroll") for (int n = 0; n < 2; ++n) _Pragma("unroll") for (int k = 0; k < 2; ++k) \
        acc[bj][m][n] = __builtin_amdgcn_mfma_f32_16x16x32_bf16(Bt[n][k], At[m][k], acc[bj][m][n], 0, 0, 0); __builtin_amdgcn_s_setprio(0); } while (0)
    f32x4 acc[2][4][2];
#pragma unroll
    for (int b = 0; b < 2; ++b)
#pragma unroll
        for (int m = 0; m < 4; ++m)
#pragma unroll
            for (int n = 0; n < 2; ++n) acc[b][m][n] = (f32x4){0.f, 0.f, 0.f, 0.f};
    bf16x8 At[4][2], B0[2][2], B1[2][2];
    G8_TILE(0, 0); G8_TILE(STG3, 1);
    asm volatile("s_waitcnt vmcnt(6)" ::: "memory"); __builtin_amdgcn_s_barrier();
    if (wr == 1) __builtin_amdgcn_s_barrier();
    int so = 0;
    for (int t = 0; t < nt; ++t) {
        const int s2 = (so >= STG3) ? so - STG3 : so + 2 * STG3;
        const int kt2 = (t + 2 < nt) ? t + 2 : 0;
        G8_TILE(s2, kt2);
#pragma unroll
        for (int n = 0; n < 2; ++n)
#pragma unroll
            for (int k = 0; k < 2; ++k) { B0[n][k] = *(const PG8_LAS bf16x8*)(lds + so + boff + n * 2048 + k * 1024); B1[n][k] = *(const PG8_LAS bf16x8*)(lds + so + HTB + boff + n * 2048 + k * 1024); }
#pragma unroll
        for (int m = 0; m < 4; ++m)
#pragma unroll
            for (int k = 0; k < 2; ++k) At[m][k] = *(const PG8_LAS bf16x8*)(lds + so + 2 * HTB + aoff + m * 2048 + k * 1024);
        asm volatile("s_waitcnt vmcnt(6)" ::: "memory"); asm volatile("s_waitcnt lgkmcnt(0)" ::: "memory"); __builtin_amdgcn_s_barrier();
        G8_MMA(0, B0); G8_MMA(1, B1);
        __builtin_amdgcn_s_barrier(); __builtin_amdgcn_sched_barrier(0);
        so = (so == 2 * STG3) ? 0 : so + STG3;
    }
    if (wr == 0) __builtin_amdgcn_s_barrier();
    E(acc, u, wr, wc, fr, fq);
    asm volatile("s_waitcnt vmcnt(0)" ::: "memory"); __builtin_amdgcn_s_barrier();
#undef G8_STG
#undef G8_TILE
#undef G8_MMA
}
}

#define LAS __attribute__((address_space(3)))
typedef unsigned short bf16;
typedef unsigned v4u __attribute__((ext_vector_type(4)));
typedef unsigned v2u __attribute__((ext_vector_type(2)));
#define RLX_AGENT __ATOMIC_RELAXED, __HIP_MEMORY_SCOPE_AGENT
#define LDS_WAIT() asm volatile("s_waitcnt lgkmcnt(0)" ::: "memory")
#define VM_WAIT() asm volatile("s_waitcnt vmcnt(0)" ::: "memory")
__device__ __forceinline__ unsigned pk2(float lo, float hi) { return (unsigned)f2bf(lo) | ((unsigned)f2bf(hi) << 16); }
__device__ __forceinline__ float bf2f(unsigned short b) { return __uint_as_float(((unsigned)b) << 16); }

#define XB_TMO      128
#define XB_XCNT(j)  (256  + 64 * (j))
#define XB_XSUB(j)  (1280 + 64 * (j))
#define XB_XGEN(j)  (2304 + 64 * (j))
#define XB_TOP      3328
#define XB_TOPGEN   3392
#define XCD_BAR_WORDS 3456
#define XB_SPIN_CAP (1u << 18)
__device__ __forceinline__ unsigned xb_ld(unsigned* p)              { return __hip_atomic_load(p, __ATOMIC_RELAXED, __HIP_MEMORY_SCOPE_AGENT); }
__device__ __forceinline__ unsigned xb_add(unsigned* p, unsigned v) { return __hip_atomic_fetch_add(p, v, __ATOMIC_RELAXED, __HIP_MEMORY_SCOPE_AGENT); }
__device__ __forceinline__ unsigned xb_xcc_id() { return (unsigned)__builtin_amdgcn_s_getreg((3 << 11) | 20) & 0xFu; }
#define XB_SPIN(cond, bar) do { unsigned _sp = 0; while (cond) { __builtin_amdgcn_s_sleep(1); \
    if ((++_sp & 255u) == 0u) { if (xb_ld(&(bar)[XB_TMO])) break; if (_sp > XB_SPIN_CAP) { atomicAdd(&(bar)[XB_TMO], 1u); break; } } } } while (0)
struct XcdBarrier { unsigned* bar; unsigned x; volatile LAS unsigned* st; };
__device__ __forceinline__ XcdBarrier xcd_barrier_post(unsigned* bar, volatile LAS unsigned* st) {
    XcdBarrier b; b.bar = bar; b.x = xb_xcc_id(); b.st = st;
    if (threadIdx.x == 0) (void)xb_add(&bar[XB_XCNT(b.x)], 1u);
    return b;
}
__device__ __forceinline__ void xcd_barrier_complete(unsigned* bar, unsigned x, unsigned& nloc, unsigned& nx) {
    const unsigned G = gridDim.x * gridDim.y * gridDim.z;
    unsigned sum, cnt, mine, sp = 0u;
    for (;;) {
        sum = 0u; cnt = 0u; mine = 0u;
#pragma unroll
        for (unsigned j = 0; j < 16; ++j) { const unsigned c = xb_ld(&bar[XB_XCNT(j)]); sum += c; cnt += (c > 0u) ? 1u : 0u; mine = (j == x) ? c : mine; }
        if (sum == G) break;
        __builtin_amdgcn_s_sleep(1);
        if ((++sp & 255u) == 0u) { if (xb_ld(&bar[XB_TMO])) break; if (sp > XB_SPIN_CAP) { atomicAdd(&bar[XB_TMO], 1u); break; } }
    }
    nloc = mine > 0u ? mine : 1u; nx = cnt > 0u ? cnt : 1u;
}
__device__ __forceinline__ void xcd_barrier(const XcdBarrier& b) {
    asm volatile("s_waitcnt vmcnt(0)" ::: "memory");
    __syncthreads();
    if (threadIdx.x == 0) {
        unsigned* bar = b.bar;
        __builtin_amdgcn_s_waitcnt(0);
        unsigned nloc = b.st[0], nx = b.st[1];
        if (nloc == 0u) { xcd_barrier_complete(bar, b.x, nloc, nx); b.st[0] = nloc; b.st[1] = nx; }
        const unsigned old = xb_add(&bar[XB_XSUB(b.x)], 1u);
        const unsigned gen = old / nloc;
        if (old + 1u == (gen + 1u) * nloc) {
            __builtin_amdgcn_fence(__ATOMIC_RELEASE, "agent");
            asm volatile("s_waitcnt vmcnt(0)" ::: "memory");
            const unsigned og = xb_add(&bar[XB_TOP], 1u);
            const unsigned tg = og / nx;
            if (og + 1u == (tg + 1u) * nx) xb_add(&bar[XB_TOPGEN], 1u);
            else XB_SPIN(xb_ld(&bar[XB_TOPGEN]) == tg, bar);
            __builtin_amdgcn_fence(__ATOMIC_ACQUIRE, "agent");
            xb_add(&bar[XB_XGEN(b.x)], 1u);
            asm volatile("s_waitcnt vmcnt(0)" ::: "memory");
        } else {
            XB_SPIN(xb_ld(&bar[XB_XGEN(b.x)]) == gen, bar);
            __builtin_amdgcn_fence(__ATOMIC_ACQUIRE, "agent");
            asm volatile("s_waitcnt vmcnt(0)" ::: "memory");
        }
    }
    __syncthreads();
}

template <class PF>
__device__ __forceinline__ void xcd_barrier_pf(const XcdBarrier& b, const PF& pf) {
    asm volatile("s_waitcnt vmcnt(0)" ::: "memory");
    __syncthreads();
    if (threadIdx.x >= 64) pf();
    if (threadIdx.x == 0) {
        unsigned* bar = b.bar;
        __builtin_amdgcn_s_waitcnt(0);
        unsigned nloc = b.st[0], nx = b.st[1];
        if (nloc == 0u) { xcd_barrier_complete(bar, b.x, nloc, nx); b.st[0] = nloc; b.st[1] = nx; }
        const unsigned old = xb_add(&bar[XB_XSUB(b.x)], 1u);
        const unsigned gen = old / nloc;
        if (old + 1u == (gen + 1u) * nloc) {
            __builtin_amdgcn_fence(__ATOMIC_RELEASE, "agent");
            asm volatile("s_waitcnt vmcnt(0)" ::: "memory");
            const unsigned og = xb_add(&bar[XB_TOP], 1u);
            const unsigned tg = og / nx;
            if (og + 1u == (tg + 1u) * nx) xb_add(&bar[XB_TOPGEN], 1u);
            else XB_SPIN(xb_ld(&bar[XB_TOPGEN]) == tg, bar);
            __builtin_amdgcn_fence(__ATOMIC_ACQUIRE, "agent");
            xb_add(&bar[XB_XGEN(b.x)], 1u);
            asm volatile("s_waitcnt vmcnt(0)" ::: "memory");
        } else {
            XB_SPIN(xb_ld(&bar[XB_XGEN(b.x)]) == gen, bar);
            __builtin_amdgcn_fence(__ATOMIC_ACQUIRE, "agent");
            asm volatile("s_waitcnt vmcnt(0)" ::: "memory");
        }
    }
    if (threadIdx.x < 64) pf();
    __syncthreads();
}

constexpr size_t MiB = 1u << 20;
constexpr int PROJP = 6400;
constexpr size_t WS_CTL = 0, CTL_ZERO_BYTES = 1 * MiB;
constexpr int CW_BAR = 4096;
constexpr int CW_CNT = 16384;
constexpr int CW_Q = 24576;
constexpr int CW_ROWSQ1 = 32768, CW_ROWSQ2 = 32768 + 8192;
constexpr size_t WS_WIN = 2 * MiB;
constexpr size_t WS_WOUT = 28 * MiB;
constexpr size_t WS_WXQ = 36 * MiB;
constexpr size_t WS_WXKV = 44 * MiB;
constexpr size_t WS_WXO = 60 * MiB;
constexpr size_t WS_H0 = 68 * MiB;
constexpr size_t WS_HM = 100 * MiB;
constexpr size_t WS_PROJ = 104 * MiB;
constexpr size_t WS_ALR = 204 * MiB;
constexpr size_t WS_KV = 205 * MiB;
constexpr size_t WS_CAT = 214 * MiB;
constexpr size_t WS_X1 = 246 * MiB;
constexpr size_t WS_X1B = 310 * MiB;
constexpr size_t WS_QX = 342 * MiB;
constexpr size_t WS_OX = 374 * MiB;
constexpr size_t WS_X2 = 406 * MiB;
constexpr size_t WS_GU = WS_X1;
constexpr size_t WS_GS = WS_X1B;
constexpr size_t WS_GQD = WS_QX;
constexpr size_t WS_GKI = WS_QX + 8 * MiB;
constexpr size_t WS_GEL = WS_QX + 16 * MiB;
constexpr size_t WS_PB = WS_H0;
constexpr size_t WS_HF = 854 * MiB;
constexpr size_t WS_HB = 886 * MiB;
constexpr size_t WS_YB = 902 * MiB;
constexpr size_t WS_WR = 966 * MiB;
constexpr size_t WS_LIST = 967 * MiB;
constexpr size_t WS_GATE = 969 * MiB;
constexpr size_t WS_MKT = WS_OX;
constexpr size_t WS_NVT = WS_OX + 16 * MiB;
constexpr size_t WS_NEW_END = 970 * MiB;

constexpr int RING_OFF = 0, RING_BYTES = 147456;
constexpr int LDSCTL_OFF = RING_BYTES, MISC_OFF = LDSCTL_OFF + 320;
constexpr int LDS_BYTES = 163840;
constexpr int NWAVES = 8;

struct Frame {
    LAS unsigned char* lds; volatile LAS unsigned* MISC; unsigned* ctl;
    int tid, lane, wave, G, vcu;
    unsigned char* ws;
};

__device__ __forceinline__ void p0_transpose_item(const float* W, int K, int ldw, int ncols, const float* gain, bf16* WT, int row_off, LAS float* scr, int item, int lane) {
    const int nblk = (ncols + 63) / 64, kb = item / nblk, nb = item % nblk, k0 = 64 * kb, n0 = 64 * nb;
    const int lk = lane >> 4, ln = (lane & 15) * 4; const bool ok = (n0 + ln) < ncols;
    f32x4 v[16];
#pragma unroll
    for (int i = 0; i < 16; ++i) v[i] = ok ? __builtin_nontemporal_load((const f32x4*)(W + (size_t)(k0 + 4 * i + lk) * ldw + n0 + ln)) : (f32x4){0.f, 0.f, 0.f, 0.f};
#pragma unroll
    for (int i = 0; i < 16; ++i) { const int kk = 4 * i + lk; const float g = gain ? gain[k0 + kk] : 1.0f; LAS float* d = scr + kk * 65 + ln; d[0] = v[i][0] * g; d[1] = v[i][1] * g; d[2] = v[i][2] * g; d[3] = v[i][3] * g; }
    LDS_WAIT(); asm volatile("" ::: "memory");
    const int c = lane & 7;
#pragma unroll
    for (int j = 0; j < 8; ++j) { const int n = (lane >> 3) + 8 * j; const LAS float* sp = scr + (8 * c) * 65 + n;
        v4u o; o.x = pk2(sp[0 * 65], sp[1 * 65]); o.y = pk2(sp[2 * 65], sp[3 * 65]); o.z = pk2(sp[4 * 65], sp[5 * 65]); o.w = pk2(sp[6 * 65], sp[7 * 65]);
        *(v4u*)(WT + (size_t)(row_off + n0 + n) * K + k0 + 8 * c) = o; }
    LDS_WAIT(); asm volatile("" ::: "memory");
}
__device__ __forceinline__ float wave_sum(float v) {
#pragma unroll
    for (int o = 1; o < 64; o <<= 1) v += __shfl_xor(v, o);
    return v;
}
__device__ __forceinline__ void rms_row_to_bf16(const float* xrow, const float* gain, bf16* orow, int lane) {
    const f32x4* xr = (const f32x4*)xrow + lane; const f32x4* gr = (const f32x4*)gain + lane;
    f32x4 v[8]; float s = 0.f;
#pragma unroll
    for (int j = 0; j < 8; ++j) { v[j] = __builtin_nontemporal_load(xr + 64 * j); s += (v[j].x * v[j].x + v[j].y * v[j].y) + (v[j].z * v[j].z + v[j].w * v[j].w); }
    const float rstd = rsqrtf(wave_sum(s) * (1.f / D) + EPS);
    unsigned long long* o8 = (unsigned long long*)orow + lane;
#pragma unroll
    for (int j = 0; j < 8; ++j) { const f32x4 g = gr[64 * j]; o8[64 * j] = (unsigned long long)pk2(v[j].x * rstd * g.x, v[j].y * rstd * g.y) | ((unsigned long long)pk2(v[j].z * rstd * g.z, v[j].w * rstd * g.w) << 32); }
}

struct EpiBf16 {
    static constexpr bool PERM = true, AFTER_DRAIN = false;
    bf16* O; int ldc;
    __device__ __forceinline__ void operator()(const f32x4 (&acc)[2][2][4][2], const pg8::Unit& u, int wr, int wc, int fr, int fq) const {
        const int row0 = u.pm * 256 + wr * 64 + fr, col0 = u.pn * 256 + wc * 32 + 8 * fq;
#pragma unroll
        for (int ai = 0; ai < 2; ++ai)
#pragma unroll
            for (int m = 0; m < 4; ++m) { bf16* rowp = O + (size_t)(row0 + ai * 128 + m * 16) * ldc + col0;
#pragma unroll
                for (int bj = 0; bj < 2; ++bj) { const f32x4 v0 = acc[ai][bj][m][0], v1 = acc[ai][bj][m][1];
                    v4u w; w.x = pg8::cvt_pk_bf16(v0[0], v0[1]); w.y = pg8::cvt_pk_bf16(v0[2], v0[3]); w.z = pg8::cvt_pk_bf16(v1[0], v1[1]); w.w = pg8::cvt_pk_bf16(v1[2], v1[3]);
                    *(v4u*)(rowp + bj * 128) = w; } }
    }
};
struct EpiProj {
    static constexpr bool PERM = true, AFTER_DRAIN = false;
    bf16* O; float* alr;
    __device__ __forceinline__ void operator()(const f32x4 (&acc)[2][2][4][2], const pg8::Unit& u, int wr, int wc, int fr, int fq) const {
        const int row0 = u.pm * 256 + wr * 64 + fr, col0 = u.pn * 256 + wc * 32 + 8 * fq;
#pragma unroll
        for (int ai = 0; ai < 2; ++ai)
#pragma unroll
            for (int m = 0; m < 4; ++m) { const int row = row0 + ai * 128 + m * 16; bf16* rowp = O + (size_t)row * PROJP + col0;
#pragma unroll
                for (int bj = 0; bj < 2; ++bj) { const f32x4 v0 = acc[ai][bj][m][0], v1 = acc[ai][bj][m][1];
                    v4u w; w.x = pg8::cvt_pk_bf16(v0[0], v0[1]); w.y = pg8::cvt_pk_bf16(v0[2], v0[3]); w.z = pg8::cvt_pk_bf16(v1[0], v1[1]); w.w = pg8::cvt_pk_bf16(v1[2], v1[3]);
                    *(v4u*)(rowp + bj * 128) = w; }
                if (u.pn == C_ALR / 256 && wc == 0 && fq < 2) { float* ap = alr + (size_t)row * GRANK + 8 * fq; *(f32x4*)ap = acc[ai][0][m][0]; *(f32x4*)(ap + 4) = acc[ai][0][m][1]; } }
    }
};

struct EpiResid {
    static constexpr bool PERM = true, AFTER_DRAIN = false;
    const float* R; const bf16* Rb; float* O; bf16* Ob; float* rowsq;
    __device__ __forceinline__ void operator()(const f32x4 (&acc)[2][2][4][2], const pg8::Unit& u, int wr, int wc, int fr, int fq) const {
        const int row0 = u.pm * 256 + wr * 64 + fr, col0 = u.pn * 256 + wc * 32 + 8 * fq;
#pragma unroll
        for (int ai = 0; ai < 2; ++ai) {
            f32x4 rr[4][2][2];
#pragma unroll
            for (int m = 0; m < 4; ++m) { const size_t off = (size_t)(row0 + ai * 128 + m * 16) * D + col0;
#pragma unroll
                for (int bj = 0; bj < 2; ++bj) {
                    if (R) { rr[m][bj][0] = __builtin_nontemporal_load((const f32x4*)(R + off + bj * 128)); rr[m][bj][1] = __builtin_nontemporal_load((const f32x4*)(R + off + bj * 128 + 4)); }
                    else { const v4u rb = *(const v4u*)(Rb + off + bj * 128); rr[m][bj][0] = (f32x4){__uint_as_float(rb.x << 16), __uint_as_float(rb.x & 0xffff0000u), __uint_as_float(rb.y << 16), __uint_as_float(rb.y & 0xffff0000u)};
                        rr[m][bj][1] = (f32x4){__uint_as_float(rb.z << 16), __uint_as_float(rb.z & 0xffff0000u), __uint_as_float(rb.w << 16), __uint_as_float(rb.w & 0xffff0000u)}; } } }
#pragma unroll
            for (int m = 0; m < 4; ++m) { const int row = row0 + ai * 128 + m * 16; const size_t off = (size_t)row * D + col0; float ss = 0.f;
#pragma unroll
                for (int bj = 0; bj < 2; ++bj) { const f32x4 v0 = acc[ai][bj][m][0] + rr[m][bj][0], v1 = acc[ai][bj][m][1] + rr[m][bj][1];
                    if (O) { *(f32x4*)(O + off + bj * 128) = v0; *(f32x4*)(O + off + bj * 128 + 4) = v1; }
                    ss += (v0[0] * v0[0] + v0[1] * v0[1]) + (v0[2] * v0[2] + v0[3] * v0[3]) + (v1[0] * v1[0] + v1[1] * v1[1]) + (v1[2] * v1[2] + v1[3] * v1[3]);
                    if (Ob) { v4u w; w.x = pg8::cvt_pk_bf16(v0[0], v0[1]); w.y = pg8::cvt_pk_bf16(v0[2], v0[3]); w.z = pg8::cvt_pk_bf16(v1[0], v1[1]); w.w = pg8::cvt_pk_bf16(v1[2], v1[3]);
                        *(v4u*)(Ob + off + bj * 128) = w; } }
                ss += __shfl_xor(ss, 16); ss += __shfl_xor(ss, 32);
                if (fq == 0) atomicAdd(rowsq + row, ss); }
            asm volatile("" ::: "memory"); }
    }
};
struct EpiRowScaleBf16 {
    static constexpr bool PERM = true, AFTER_DRAIN = false;
    bf16* O; const float* rowsq;
    __device__ __forceinline__ void operator()(const f32x4 (&acc)[2][2][4][2], const pg8::Unit& u, int wr, int wc, int fr, int fq) const {
        const int row0 = u.pm * 256 + wr * 64 + fr, col0 = u.pn * 256 + wc * 32 + 8 * fq;
#pragma unroll
        for (int ai = 0; ai < 2; ++ai)
#pragma unroll
            for (int m = 0; m < 4; ++m) { const int row = row0 + ai * 128 + m * 16; const float rs = rsqrtf(rowsq[row] * (1.0f / D) + EPS); bf16* rowp = O + (size_t)row * D + col0;
#pragma unroll
                for (int bj = 0; bj < 2; ++bj) { const f32x4 v0 = acc[ai][bj][m][0] * rs, v1 = acc[ai][bj][m][1] * rs;
                    v4u w; w.x = pg8::cvt_pk_bf16(v0[0], v0[1]); w.y = pg8::cvt_pk_bf16(v0[2], v0[3]); w.z = pg8::cvt_pk_bf16(v1[0], v1[1]); w.w = pg8::cvt_pk_bf16(v1[2], v1[3]);
                    *(v4u*)(rowp + bj * 128) = w; } }
    }
};

typedef __bf16 bf16x2_t __attribute__((ext_vector_type(2)));
typedef float f32x2_t __attribute__((ext_vector_type(2)));
typedef float f32x16 __attribute__((ext_vector_type(16)));
typedef short s16x4 __attribute__((ext_vector_type(4)));
__device__ __forceinline__ unsigned pkbf(float a, float b) { f32x2_t f = {a, b}; bf16x2_t h = __builtin_convertvector(f, bf16x2_t); return __builtin_bit_cast(unsigned, h); }
__device__ __forceinline__ unsigned offb(unsigned row, unsigned ch) { return 256u * row + 16u * (ch ^ (((row & 3u) << 2) | ((row >> 2) & 3u))); }
__device__ __forceinline__ void tr_read8(unsigned a0, unsigned a1, unsigned a2, unsigned a3, unsigned a4, unsigned a5, unsigned a6, unsigned a7,
                                         s16x4& r0, s16x4& r1, s16x4& r2, s16x4& r3, s16x4& r4, s16x4& r5, s16x4& r6, s16x4& r7) {
    asm volatile("ds_read_b64_tr_b16 %0, %8\n\tds_read_b64_tr_b16 %1, %9\n\tds_read_b64_tr_b16 %2, %10\n\tds_read_b64_tr_b16 %3, %11\n\t"
                 "ds_read_b64_tr_b16 %4, %12\n\tds_read_b64_tr_b16 %5, %13\n\tds_read_b64_tr_b16 %6, %14\n\tds_read_b64_tr_b16 %7, %15\n\ts_waitcnt lgkmcnt(0)"
                 : "=&v"(r0), "=&v"(r1), "=&v"(r2), "=&v"(r3), "=&v"(r4), "=&v"(r5), "=&v"(r6), "=&v"(r7)
                 : "v"(a0), "v"(a1), "v"(a2), "v"(a3), "v"(a4), "v"(a5), "v"(a6), "v"(a7) : "memory");
}
__device__ __forceinline__ void sb_wave_unit(LAS unsigned char* wl, const bf16* __restrict__ proj, const float* __restrict__ gain, bf16* __restrict__ cat, int b, int hd, int qi, int lane) {
    const int r = lane & 31, h = lane >> 5, t = 32 * qi + r;
    const size_t rowq = (size_t)(b * SEQ + t) * PROJP;
    bf16x8 Bq[8];
#pragma unroll
    for (int ks = 0; ks < 8; ++ks) Bq[ks] = *(const bf16x8*)(proj + rowq + C_QSB + hd * SBD + 16 * ks + 8 * h);
    f32x16 O[4];
#pragma unroll
    for (int db = 0; db < 4; ++db)
#pragma unroll
        for (int i = 0; i < 16; ++i) O[db][i] = 0.f;
    float R = 1.0f;
    const unsigned lbase = (unsigned)(size_t)wl;
    const int srow = lane >> 4, sch = lane & 15;
    v4u sreg[8];
    { const bf16* src = proj + (size_t)(b * SEQ + 32 * qi + srow) * PROJP + hd * SBD + sch * 8 + C_KSB;
#pragma unroll
      for (int i = 0; i < 8; ++i) sreg[i] = *(const v4u*)(src + (size_t)(4 * i) * PROJP); }
    const unsigned blk = (lane >> 4) & 1, q4 = (lane & 15) >> 2, p4 = lane & 3;
    const float cexp = 0.08838834764831845f * 1.4426950408889634f;
    for (int kt = qi; kt >= 0; --kt) {
#pragma unroll
        for (int i = 0; i < 8; ++i) *(LAS v4u*)(wl + offb(4 * i + srow, sch)) = sreg[i];
        { const bf16* src = proj + (size_t)(b * SEQ + 32 * kt + srow) * PROJP + hd * SBD + sch * 8 + C_VSB;
#pragma unroll
          for (int i = 0; i < 8; ++i) sreg[i] = *(const v4u*)(src + (size_t)(4 * i) * PROJP); }
        asm volatile("s_waitcnt lgkmcnt(0)" ::: "memory");
        f32x16 S;
#pragma unroll
        for (int i = 0; i < 16; ++i) S[i] = 0.f;
#pragma unroll
        for (int ks = 0; ks < 8; ++ks) { const bf16x8 Kf = *(const LAS bf16x8*)(wl + offb(r, 2 * ks + h)); S = __builtin_amdgcn_mfma_f32_32x32x16_bf16(Kf, Bq[ks], S, 0, 0, 0); }
        float w[16], keep[16];
        const bool diag = (kt == qi);
#pragma unroll
        for (int i = 0; i < 16; ++i) { const int key = (i & 3) + 8 * (i >> 2) + 4 * h;
            const float e = __builtin_amdgcn_exp2f(fminf(S[i] * cexp, 115.f)); const float kp = __builtin_amdgcn_rcpf(1.f + e);
            const bool ok = !diag || key < r;
            keep[i] = ok ? kp : 1.f; w[i] = ok ? e * kp : 0.f; }
        float tot[4], oth[4], sf[16];
#pragma unroll
        for (int g = 0; g < 4; ++g) { sf[4 * g + 3] = 1.f; sf[4 * g + 2] = keep[4 * g + 3]; sf[4 * g + 1] = sf[4 * g + 2] * keep[4 * g + 2]; sf[4 * g] = sf[4 * g + 1] * keep[4 * g + 1]; tot[g] = sf[4 * g] * keep[4 * g]; }
#pragma unroll
        for (int g = 0; g < 4; ++g) oth[g] = __shfl_xor(tot[g], 32);
        float Cg[4]; Cg[3] = R; Cg[2] = Cg[3] * (tot[3] * oth[3]); Cg[1] = Cg[2] * (tot[2] * oth[2]); Cg[0] = Cg[1] * (tot[1] * oth[1]);
        R = Cg[0] * (tot[0] * oth[0]);
#pragma unroll
        for (int g = 0; g < 4; ++g) { const float E = h ? Cg[g] : Cg[g] * oth[g];
#pragma unroll
            for (int p = 0; p < 4; ++p) w[4 * g + p] = w[4 * g + p] * (sf[4 * g + p] * E); }
#pragma unroll
        for (int i = 0; i < 8; ++i) *(LAS v4u*)(wl + 8192 + offb(4 * i + srow, sch)) = sreg[i];
        if (kt > 0) { const bf16* src = proj + (size_t)(b * SEQ + 32 * (kt - 1) + srow) * PROJP + hd * SBD + sch * 8 + C_KSB;
#pragma unroll
            for (int i = 0; i < 8; ++i) sreg[i] = *(const v4u*)(src + (size_t)(4 * i) * PROJP); }
        asm volatile("s_waitcnt lgkmcnt(0)" ::: "memory");
#pragma unroll
        for (int s2 = 0; s2 < 2; ++s2) {
            v4u wp; wp.x = pkbf(w[8 * s2], w[8 * s2 + 1]); wp.y = pkbf(w[8 * s2 + 2], w[8 * s2 + 3]); wp.z = pkbf(w[8 * s2 + 4], w[8 * s2 + 5]); wp.w = pkbf(w[8 * s2 + 6], w[8 * s2 + 7]);
            const bf16x8 Wf = __builtin_bit_cast(bf16x8, wp);
            s16x4 v0a, v0b, v1a, v1b, v2a, v2b, v3a, v3b;
            const unsigned rb0 = 16 * s2 + 4 * h + q4, rb1 = rb0 + 8, cb = 2 * blk + (p4 >> 1), bo = lbase + 8192 + 8 * (p4 & 1);
            tr_read8(bo + offb(rb0, cb), bo + offb(rb1, cb), bo + offb(rb0, 4 + cb), bo + offb(rb1, 4 + cb), bo + offb(rb0, 8 + cb), bo + offb(rb1, 8 + cb), bo + offb(rb0, 12 + cb), bo + offb(rb1, 12 + cb),
                     v0a, v0b, v1a, v1b, v2a, v2b, v3a, v3b);
            O[0] = __builtin_amdgcn_mfma_f32_32x32x16_bf16(__builtin_shufflevector(v0a, v0b, 0, 1, 2, 3, 4, 5, 6, 7), Wf, O[0], 0, 0, 0);
            O[1] = __builtin_amdgcn_mfma_f32_32x32x16_bf16(__builtin_shufflevector(v1a, v1b, 0, 1, 2, 3, 4, 5, 6, 7), Wf, O[1], 0, 0, 0);
            O[2] = __builtin_amdgcn_mfma_f32_32x32x16_bf16(__builtin_shufflevector(v2a, v2b, 0, 1, 2, 3, 4, 5, 6, 7), Wf, O[2], 0, 0, 0);
            O[3] = __builtin_amdgcn_mfma_f32_32x32x16_bf16(__builtin_shufflevector(v3a, v3b, 0, 1, 2, 3, 4, 5, 6, 7), Wf, O[3], 0, 0, 0);
        }
        if (__all(R == 0.f)) break;
    }
    float ss = 0.f;
#pragma unroll
    for (int db = 0; db < 4; ++db)
#pragma unroll
        for (int i = 0; i < 16; ++i) ss += O[db][i] * O[db][i];
    ss += __shfl_xor(ss, 32);
    const float rs = rsqrtf(ss * (1.0f / SBD) + EPS);
    bf16* orow = cat + (size_t)(b * SEQ + t) * D + hd * SBD;
#pragma unroll
    for (int db = 0; db < 4; ++db)
#pragma unroll
        for (int g = 0; g < 4; ++g) { const int d = 32 * db + 8 * g + 4 * h; const f32x4 gv = *(const f32x4*)(gain + hd * SBD + d);
            v2u o; o.x = pkbf(O[db][4 * g] * rs * gv[0], O[db][4 * g + 1] * rs * gv[1]); o.y = pkbf(O[db][4 * g + 2] * rs * gv[2], O[db][4 * g + 3] * rs * gv[3]);
            *(v2u*)(orow + d) = o; }
}

__device__ __forceinline__ void sb_wg_unit(LAS unsigned char* sm0, const bf16* __restrict__ proj, const float* __restrict__ gain, bf16* __restrict__ cat, int item, int wave, int lane) {
    const int qg = (SEQ / 256 - 1) - item / (BATCH * SBH), bh = item % (BATCH * SBH), b = bh / SBH, hd = bh % SBH;
    LAS unsigned char* sm = sm0;
    LAS int* doneAt = (LAS int*)(sm0 + RING_BYTES + 8192);
    const int qi = 8 * qg + wave, r = lane & 31, h = lane >> 5, t = 32 * qi + r;
    const size_t rowq = (size_t)(b * SEQ + t) * PROJP;
    bf16x8 Bq[8];
#pragma unroll
    for (int ks = 0; ks < 8; ++ks) Bq[ks] = *(const bf16x8*)(proj + rowq + C_QSB + hd * SBD + 16 * ks + 8 * h);
    f32x16 O[4];
#pragma unroll
    for (int db = 0; db < 4; ++db)
#pragma unroll
        for (int i = 0; i < 16; ++i) O[db][i] = 0.f;
    float R = 1.0f; bool done = false;
    const int prow0 = 4 * wave + (lane >> 4); const unsigned sw0 = (unsigned)((((lane >> 4) & 3) << 2) | (wave & 3));
    const unsigned pch0 = (unsigned)(lane & 15) ^ sw0;
    const bf16* kv0 = proj + (size_t)(b * SEQ + prow0) * PROJP + hd * SBD;
    __syncthreads();
    if (lane == 0) doneAt[wave] = -1;
#define SBW_DMA(kt_) do { int kq_ = (kt_); asm volatile("" : "+s"(kq_)); const unsigned st_ = (unsigned)(kq_ % 9) * 16384u + (unsigned)wave * 1024u; const size_t ro_ = (size_t)(32 * kq_) * PROJP; \
        __builtin_amdgcn_global_load_lds((const unsigned*)(kv0 + ro_ + C_KSB + pch0 * 8), (LAS unsigned*)(sm + st_), 16, 0, 0); \
        __builtin_amdgcn_global_load_lds((const unsigned*)(kv0 + ro_ + C_VSB + pch0 * 8), (LAS unsigned*)(sm + st_ + 8192), 16, 0, 0); } while (0)
    const int ktop = 8 * qg + 7;
#pragma unroll
    for (int i = 0; i < 8; ++i) SBW_DMA(ktop - i);
    const unsigned blk = (lane >> 4) & 1, q4 = (lane & 15) >> 2, p4 = lane & 3;
    const float cexp = 0.08838834764831845f * 1.4426950408889634f;
    for (int s = 0; ; ++s) {
        asm volatile("s_waitcnt vmcnt(0) lgkmcnt(0)" ::: "memory");
        __builtin_amdgcn_s_barrier(); asm volatile("" ::: "memory");
        { int nd = 0;
#pragma unroll
          for (int w8 = 0; w8 < 8; ++w8) { const int da = doneAt[w8]; nd += (da >= 0 && da < s) ? 1 : 0; }
          if (nd == 8) break; }
        { const int knew = ktop - 8 - s; if (knew >= 0) SBW_DMA(knew); }
        const int kt = qi - s;
        if (!done) {
            int kq = kt; asm volatile("" : "+s"(kq));
            LAS unsigned char* Kt = sm + (kq % 9) * 16384; const unsigned vb = (unsigned)(size_t)Kt + 8192u;
            f32x16 S;
#pragma unroll
            for (int i = 0; i < 16; ++i) S[i] = 0.f;
#pragma unroll
            for (int ks = 0; ks < 8; ++ks) { const bf16x8 Kf = *(const LAS bf16x8*)(Kt + offb(r, 2 * ks + h)); S = __builtin_amdgcn_mfma_f32_32x32x16_bf16(Kf, Bq[ks], S, 0, 0, 0); }
            float w[16], keep[16];
            const bool diag = (s == 0);
#pragma unroll
            for (int i = 0; i < 16; ++i) { const int key = (i & 3) + 8 * (i >> 2) + 4 * h;
                const float e = __builtin_amdgcn_exp2f(fminf(S[i] * cexp, 115.f)); const float kp = __builtin_amdgcn_rcpf(1.f + e);
                const bool ok = !diag || key < r;
                keep[i] = ok ? kp : 1.f; w[i] = ok ? e * kp : 0.f; }
            float tot[4], oth[4], sf[16];
#pragma unroll
            for (int g = 0; g < 4; ++g) { sf[4 * g + 3] = 1.f; sf[4 * g + 2] = keep[4 * g + 3]; sf[4 * g + 1] = sf[4 * g + 2] * keep[4 * g + 2]; sf[4 * g] = sf[4 * g + 1] * keep[4 * g + 1]; tot[g] = sf[4 * g] * keep[4 * g]; }
#pragma unroll
            for (int g = 0; g < 4; ++g) oth[g] = __shfl_xor(tot[g], 32);
            float Cg[4]; Cg[3] = R; Cg[2] = Cg[3] * (tot[3] * oth[3]); Cg[1] = Cg[2] * (tot[2] * oth[2]); Cg[0] = Cg[1] * (tot[1] * oth[1]);
            R = Cg[0] * (tot[0] * oth[0]);
#pragma unroll
            for (int g = 0; g < 4; ++g) { const float E = h ? Cg[g] : Cg[g] * oth[g];
#pragma unroll
                for (int p = 0; p < 4; ++p) w[4 * g + p] = w[4 * g + p] * (sf[4 * g + p] * E); }
#pragma unroll
            for (int s2 = 0; s2 < 2; ++s2) {
                v4u wp; wp.x = pkbf(w[8 * s2], w[8 * s2 + 1]); wp.y = pkbf(w[8 * s2 + 2], w[8 * s2 + 3]); wp.z = pkbf(w[8 * s2 + 4], w[8 * s2 + 5]); wp.w = pkbf(w[8 * s2 + 6], w[8 * s2 + 7]);
                const bf16x8 Wf = __builtin_bit_cast(bf16x8, wp);
                s16x4 v0a, v0b, v1a, v1b, v2a, v2b, v3a, v3b;
                const unsigned rb0 = 16 * s2 + 4 * h + q4, rb1 = rb0 + 8, cb = 2 * blk + (p4 >> 1), bo = vb + 8 * (p4 & 1);
                tr_read8(bo + offb(rb0, cb), bo + offb(rb1, cb), bo + offb(rb0, 4 + cb), bo + offb(rb1, 4 + cb), bo + offb(rb0, 8 + cb), bo + offb(rb1, 8 + cb), bo + offb(rb0, 12 + cb), bo + offb(rb1, 12 + cb),
                         v0a, v0b, v1a, v1b, v2a, v2b, v3a, v3b);
                O[0] = __builtin_amdgcn_mfma_f32_32x32x16_bf16(__builtin_shufflevector(v0a, v0b, 0, 1, 2, 3, 4, 5, 6, 7), Wf, O[0], 0, 0, 0);
                O[1] = __builtin_amdgcn_mfma_f32_32x32x16_bf16(__builtin_shufflevector(v1a, v1b, 0, 1, 2, 3, 4, 5, 6, 7), Wf, O[1], 0, 0, 0);
                O[2] = __builtin_amdgcn_mfma_f32_32x32x16_bf16(__builtin_shufflevector(v2a, v2b, 0, 1, 2, 3, 4, 5, 6, 7), Wf, O[2], 0, 0, 0);
                O[3] = __builtin_amdgcn_mfma_f32_32x32x16_bf16(__builtin_shufflevector(v3a, v3b, 0, 1, 2, 3, 4, 5, 6, 7), Wf, O[3], 0, 0, 0);
            }
            if (__all(R < 5.0e-20f) || kt == 0) { done = true; if (lane == 0) doneAt[wave] = s; }
        }
    }
#undef SBW_DMA
    asm volatile("s_waitcnt vmcnt(0)" ::: "memory");
    float ss = 0.f;
#pragma unroll
    for (int db = 0; db < 4; ++db)
#pragma unroll
        for (int i = 0; i < 16; ++i) ss += O[db][i] * O[db][i];
    ss += __shfl_xor(ss, 32);
    const float rs = rsqrtf(ss * (1.0f / SBD) + EPS);
    bf16* orow = cat + (size_t)(b * SEQ + t) * D + hd * SBD;
#pragma unroll
    for (int db = 0; db < 4; ++db) { unsigned w[4][2];
#pragma unroll
        for (int g = 0; g < 4; ++g) { const int d = 32 * db + 8 * g + 4 * h; const f32x4 gv = *(const f32x4*)(gain + hd * SBD + d);
            w[g][0] = pkbf(O[db][4 * g] * rs * gv[0], O[db][4 * g + 1] * rs * gv[1]); w[g][1] = pkbf(O[db][4 * g + 2] * rs * gv[2], O[db][4 * g + 3] * rs * gv[3]); }
        const v2u s0 = __builtin_amdgcn_permlane32_swap(w[0][0], w[1][0], false, false), s1 = __builtin_amdgcn_permlane32_swap(w[0][1], w[1][1], false, false);
        const v2u s2 = __builtin_amdgcn_permlane32_swap(w[2][0], w[3][0], false, false), s3 = __builtin_amdgcn_permlane32_swap(w[2][1], w[3][1], false, false);
        *(v4u*)(orow + 32 * db + 8 * h) = (v4u){s0.x, s1.x, s0.y, s1.y}; *(v4u*)(orow + 32 * db + 16 + 8 * h) = (v4u){s2.x, s3.x, s2.y, s3.y}; }
}

struct MktSched { const char* KV; const char* WqN; unsigned ldb; int K, G, c;
    __device__ __forceinline__ bool next(int i, pg8::Unit& u) const { const int L = i * G + c; if (L >= 128) return false; const int b = L >> 5, h = (L >> 3) & 3, kt = L & 7;
        u.pm = b * 4 + h; u.pn = kt; u.z = L; u.mv = 256; u.A = KV + ((size_t)(b * MEM) * 2 * D + h * XD) * 2; u.B = WqN + ((size_t)(kt * 256) * D + h * XD) * 2; return true; }
    __device__ __forceinline__ unsigned arow(const pg8::Unit&, int r) const { return (unsigned)r * (2 * D * 2); }
    __device__ __forceinline__ void a_ready(const pg8::Unit&) const {}
    __device__ __forceinline__ void done(const pg8::Unit&) const {} };
struct NvtSched { const char* WoT; const char* KV; unsigned ldb; int K, G, c;
    __device__ __forceinline__ bool next(int i, pg8::Unit& u) const { const int L = i * G + c; if (L >= 128) return false; const int b = L >> 5, h = (L >> 3) & 3, nt = L & 7;
        u.pm = b * 8 + nt; u.pn = h; u.z = L; u.mv = 256; u.A = WoT + ((size_t)(nt * 256) * D + h * XD) * 2; u.B = KV + ((size_t)(b * MEM) * 2 * D + D + h * XD) * 2; return true; }
    __device__ __forceinline__ unsigned arow(const pg8::Unit&, int r) const { return (unsigned)r * (D * 2); }
    __device__ __forceinline__ void a_ready(const pg8::Unit&) const {}
    __device__ __forceinline__ void done(const pg8::Unit&) const {} };
struct XLogitSched { const char* X1; const char* MKT; unsigned ldb; int K, G, c;
    __device__ __forceinline__ bool next(int i, pg8::Unit& u) const { const int Lr = i * G + c; if (Lr >= 128) return false; const int rp = 4 * (Lr & 7) + (Lr >> 5), h = (Lr >> 3) & 3, L = rp * 4 + h, b = rp >> 3, qt = rp & 7;
        u.pm = b * 8 + qt; u.pn = h; u.z = L; u.mv = 256; u.A = X1 + (size_t)(b * SEQ + qt * 256) * D * 2; u.B = MKT + (size_t)(b * 1024 + h * 256) * D * 2; return true; }
    __device__ __forceinline__ unsigned arow(const pg8::Unit&, int r) const { return (unsigned)r * (D * 2); }
    __device__ __forceinline__ void a_ready(const pg8::Unit&) const {}
    __device__ __forceinline__ void done(const pg8::Unit&) const {} };
struct EpiSoftmaxP {
    static constexpr bool PERM = true, AFTER_DRAIN = false;
    bf16* P; LAS float* tab; const float* rowsq;
    __device__ __forceinline__ void operator()(const f32x4 (&acc)[2][2][4][2], const pg8::Unit& u, int wr, int wc, int fr, int fq) const {
        const float sc = 0.044194173824159216f * 1.4426950408889634f;
        LAS float* Tm = tab; LAS float* Ts = tab + 1024;
        float rsc[2][4];
#pragma unroll
        for (int ai = 0; ai < 2; ++ai)
#pragma unroll
            for (int m = 0; m < 4; ++m) { rsc[ai][m] = sc * rsqrtf(rowsq[u.pm * 256 + ai * 128 + wr * 64 + m * 16 + fr] * (1.0f / D) + EPS); float v = -3.0e38f;
#pragma unroll
                for (int bj = 0; bj < 2; ++bj)
#pragma unroll
                    for (int n = 0; n < 2; ++n) { const f32x4 a = acc[ai][bj][m][n]; v = fmaxf(v, fmaxf(fmaxf(a[0], a[1]), fmaxf(a[2], a[3]))); }
                v = fmaxf(v, __shfl_xor(v, 16)); v = fmaxf(v, __shfl_xor(v, 32));
                if (fq == 0) Tm[(ai * 128 + wr * 64 + m * 16 + fr) * 4 + wc] = v; }
        asm volatile("s_waitcnt lgkmcnt(0)" ::: "memory"); __builtin_amdgcn_s_barrier(); asm volatile("" ::: "memory");
        float e[2][2][4][2][4];
#pragma unroll
        for (int ai = 0; ai < 2; ++ai)
#pragma unroll
            for (int m = 0; m < 4; ++m) { const f32x4 t4 = *(const LAS f32x4*)(Tm + (ai * 128 + wr * 64 + m * 16 + fr) * 4); const float k2 = rsc[ai][m], mr = fmaxf(fmaxf(t4[0], t4[1]), fmaxf(t4[2], t4[3])) * k2; float sacc = 0.f;
#pragma unroll
                for (int bj = 0; bj < 2; ++bj)
#pragma unroll
                    for (int n = 0; n < 2; ++n)
#pragma unroll
                        for (int j = 0; j < 4; ++j) { const float x = __builtin_amdgcn_exp2f(acc[ai][bj][m][n][j] * k2 - mr); e[ai][bj][m][n][j] = x; sacc += x; }
                sacc += __shfl_xor(sacc, 16); sacc += __shfl_xor(sacc, 32);
                if (fq == 0) Ts[(ai * 128 + wr * 64 + m * 16 + fr) * 4 + wc] = sacc; }
        asm volatile("s_waitcnt lgkmcnt(0)" ::: "memory"); __builtin_amdgcn_s_barrier(); asm volatile("" ::: "memory");
        const int col0 = u.pn * 256 + wc * 32 + 8 * fq;
#pragma unroll
        for (int ai = 0; ai < 2; ++ai)
#pragma unroll
            for (int m = 0; m < 4; ++m) { const int rl = ai * 128 + wr * 64 + m * 16 + fr; const f32x4 t4 = *(const LAS f32x4*)(Ts + rl * 4); const float inv = 1.0f / ((t4[0] + t4[1]) + (t4[2] + t4[3]));
                bf16* rowp = P + (size_t)(u.pm * 256 + rl) * 1024 + col0;
#pragma unroll
                for (int bj = 0; bj < 2; ++bj) { v4u w; w.x = pkbf(e[ai][bj][m][0][0] * inv, e[ai][bj][m][0][1] * inv); w.y = pkbf(e[ai][bj][m][0][2] * inv, e[ai][bj][m][0][3] * inv);
                    w.z = pkbf(e[ai][bj][m][1][0] * inv, e[ai][bj][m][1][1] * inv); w.w = pkbf(e[ai][bj][m][1][2] * inv, e[ai][bj][m][1][3] * inv); *(v4u*)(rowp + bj * 128) = w; } }
    }
};
struct EpiSoftmax128 {
    bf16* P; LAS float* tab; const float* rowsq;
    __device__ __forceinline__ void operator()(const f32x4 (&acc)[2][4][2], const pg8::Unit& u, int wr, int wc, int fr, int fq) const {
        const float sc = 0.044194173824159216f * 1.4426950408889634f;
        LAS float* Tm = tab; LAS float* Ts = tab + 512;
        float rsc[4];
#pragma unroll
        for (int m = 0; m < 4; ++m) { rsc[m] = sc * rsqrtf(rowsq[u.pm * 128 + wr * 64 + m * 16 + fr] * (1.0f / D) + EPS); float v = -3.0e38f;
#pragma unroll
            for (int bj = 0; bj < 2; ++bj)
#pragma unroll
                for (int n = 0; n < 2; ++n) { const f32x4 a = acc[bj][m][n]; v = fmaxf(v, fmaxf(fmaxf(a[0], a[1]), fmaxf(a[2], a[3]))); }
            v = fmaxf(v, __shfl_xor(v, 16)); v = fmaxf(v, __shfl_xor(v, 32));
            if (fq == 0) Tm[(wr * 64 + m * 16 + fr) * 4 + wc] = v; }
        asm volatile("s_waitcnt lgkmcnt(0)" ::: "memory"); __builtin_amdgcn_s_barrier(); asm volatile("" ::: "memory");
        float e[2][4][2][4];
#pragma unroll
        for (int m = 0; m < 4; ++m) { const f32x4 t4 = *(const LAS f32x4*)(Tm + (wr * 64 + m * 16 + fr) * 4); const float k2 = rsc[m], mr = fmaxf(fmaxf(t4[0], t4[1]), fmaxf(t4[2], t4[3])) * k2; float sacc = 0.f;
#pragma unroll
            for (int bj = 0; bj < 2; ++bj)
#pragma unroll
                for (int n = 0; n < 2; ++n)
#pragma unroll
                    for (int j = 0; j < 4; ++j) { const float x = __builtin_amdgcn_exp2f(acc[bj][m][n][j] * k2 - mr); e[bj][m][n][j] = x; sacc += x; }
            sacc += __shfl_xor(sacc, 16); sacc += __shfl_xor(sacc, 32);
            if (fq == 0) Ts[(wr * 64 + m * 16 + fr) * 4 + wc] = sacc; }
        asm volatile("s_waitcnt lgkmcnt(0)" ::: "memory"); __builtin_amdgcn_s_barrier(); asm volatile("" ::: "memory");
        const int col0 = u.pn * 256 + wc * 32 + 8 * fq;
#pragma unroll
        for (int m = 0; m < 4; ++m) { const int rl = wr * 64 + m * 16 + fr; const f32x4 t4 = *(const LAS f32x4*)(Ts + rl * 4); const float inv = 1.0f / ((t4[0] + t4[1]) + (t4[2] + t4[3]));
            bf16* rowp = P + (size_t)(u.pm * 128 + rl) * 1024 + col0;
#pragma unroll
            for (int bj = 0; bj < 2; ++bj) { v4u w; w.x = pkbf(e[bj][m][0][0] * inv, e[bj][m][0][1] * inv); w.y = pkbf(e[bj][m][0][2] * inv, e[bj][m][0][3] * inv);
                w.z = pkbf(e[bj][m][1][0] * inv, e[bj][m][1][1] * inv); w.w = pkbf(e[bj][m][1][2] * inv, e[bj][m][1][3] * inv); *(v4u*)(rowp + bj * 128) = w; } }
    }
};
struct XOutSched { const char* P; const char* NVT; unsigned ldb; int K, G, c;
    __device__ __forceinline__ bool next(int i, pg8::Unit& u) const { const int Lr = i * G + c; if (Lr >= 256) return false; const int rp = 4 * (Lr & 7) + (Lr >> 6), nt = (Lr >> 3) & 7, L = rp * 8 + nt, b = rp >> 3, qt = rp & 7;
        u.pm = b * 8 + qt; u.pn = nt; u.z = L; u.mv = 256; u.A = P + (size_t)(b * SEQ + qt * 256) * 1024 * 2; u.B = NVT + (size_t)(b * D + nt * 256) * 1024 * 2; return true; }
    __device__ __forceinline__ unsigned arow(const pg8::Unit&, int r) const { return (unsigned)r * (1024 * 2); }
    __device__ __forceinline__ void a_ready(const pg8::Unit&) const {}
    __device__ __forceinline__ void done(const pg8::Unit&) const {} };

template <int MODE>
__device__ __forceinline__ void moe_stream_unit(LAS unsigned char* lds, const char* __restrict__ Ab, unsigned lda, int ashift, const float* __restrict__ W0, const float* __restrict__ W1, int ldw, int K, int colbase,
                                                const int* __restrict__ list, int n_e, bf16* __restrict__ Out, const float* __restrict__ gate, int tid, int wave, int lane) {
    const int wr = wave >> 2, wc = wave & 3, r = lane & 31, h = lane >> 5;
    const int nt = K / 32;
    const unsigned blane = (unsigned)(((lane >> 5) * ldw + 4 * (lane & 31)) * 4);
    const char* Wg0 = (const char*)(W0 + colbase); const char* Wg1 = (MODE == 0) ? (const char*)(W1 + colbase) : (const char*)(W0 + colbase + 128);
    const unsigned a_base = (unsigned)(wr * 2048 + r * 64), a_sw0 = (unsigned)(((h ^ ((r >> 2) & 3)) & 3) << 4), a_sw1 = (unsigned)((((2 + h) ^ ((r >> 2) & 3)) & 3) << 4);
    const unsigned b_base = (unsigned)((h * 8 * 128 + 32 * wc + r) * 4);
    for (int base = 0; base < n_e; base += 320) {
        const int nrows = (n_e - base) < 320 ? (n_e - base) : 320, nblk = (nrows + 31) >> 5;
        __syncthreads();
        unsigned aoff[3];
#pragma unroll
        for (int i = 0; i < 3; ++i) { const int pc = (i < 2) ? (wave + 8 * i) : (16 + (wave & 3)); const int m = 16 * pc + (lane >> 2), mm = m < nrows ? m : nrows - 1; const int id = list[base + mm];
            aoff[i] = (unsigned)(id >> ashift) * lda + (unsigned)(((lane & 3) ^ ((m >> 2) & 3)) * 16); }
        f32x16 acc[5][2];
#pragma unroll
        for (int j = 0; j < 5; ++j)
#pragma unroll
            for (int nb = 0; nb < 2; ++nb)
#pragma unroll
                for (int i = 0; i < 16; ++i) acc[j][nb][i] = 0.f;
#define MS_DMAB(t) do { int tq_ = (t); asm volatile("" : "+s"(tq_)); const unsigned st_ = 40960u + (unsigned)(tq_ % 3) * 32768u + (unsigned)wave * 1024u; const size_t kro_ = ((size_t)tq_ * 32 + 2 * wave) * (size_t)ldw * 4; \
            __builtin_amdgcn_global_load_lds((const unsigned*)(Wg0 + kro_ + blane), (LAS unsigned*)(lds + st_), 16, 0, 2); \
            __builtin_amdgcn_global_load_lds((const unsigned*)(Wg0 + kro_ + (size_t)ldw * 64 + blane), (LAS unsigned*)(lds + st_ + 8192), 16, 0, 2); \
            __builtin_amdgcn_global_load_lds((const unsigned*)(Wg1 + kro_ + blane), (LAS unsigned*)(lds + st_ + 16384), 16, 0, 2); \
            __builtin_amdgcn_global_load_lds((const unsigned*)(Wg1 + kro_ + (size_t)ldw * 64 + blane), (LAS unsigned*)(lds + st_ + 24576), 16, 0, 2); } while (0)
#define MS_DMAA(t) do { int tq_ = (t); asm volatile("" : "+s"(tq_)); const unsigned st_ = (unsigned)(tq_ & 1) * 20480u; const char* ap_ = Ab + (size_t)tq_ * 64; \
            __builtin_amdgcn_global_load_lds((const unsigned*)(ap_ + aoff[0]), (LAS unsigned*)(lds + st_ + wave * 1024), 16, 0, 0); \
            __builtin_amdgcn_global_load_lds((const unsigned*)(ap_ + aoff[1]), (LAS unsigned*)(lds + st_ + (wave + 8) * 1024), 16, 0, 0); \
            __builtin_amdgcn_global_load_lds((const unsigned*)(ap_ + aoff[2]), (LAS unsigned*)(lds + st_ + (16 + (wave & 3)) * 1024), 16, 0, 0); } while (0)
        MS_DMAB(0); MS_DMAA(0); if (nt > 1) MS_DMAB(1);
        for (int t = 0; t < nt; ++t) {
            int tq = t; asm volatile("" : "+s"(tq));
            LAS unsigned char* Bs = lds + 40960 + (tq % 3) * 32768; LAS unsigned char* As = lds + (tq & 1) * 20480;
            if (t + 1 < nt) asm volatile("s_waitcnt vmcnt(4)" ::: "memory"); else asm volatile("s_waitcnt vmcnt(0)" ::: "memory");
            __builtin_amdgcn_s_barrier(); asm volatile("" ::: "memory");
            if (t + 1 < nt) MS_DMAA(t + 1);
            if (t + 2 < nt) MS_DMAB(t + 2);
            const LAS unsigned char* Ar = As + a_base; const LAS float* Br = (const LAS float*)(Bs + b_base);
#pragma unroll
            for (int ks = 0; ks < 2; ++ks) {
                bf16x8 Bf[2];
#pragma unroll
                for (int nb = 0; nb < 2; ++nb) { const LAS float* bp = Br + nb * 4096 + ks * 2048;
                    v4u w; w.x = pkbf(bp[0], bp[128]); w.y = pkbf(bp[256], bp[384]); w.z = pkbf(bp[512], bp[640]); w.w = pkbf(bp[768], bp[896]); Bf[nb] = __builtin_bit_cast(bf16x8, w); }
#pragma unroll
                for (int j = 0; j < 5; ++j) { const int mb = wr + 2 * j;
                    if (mb < nblk) { const bf16x8 Af = *(const LAS bf16x8*)(Ar + (ks ? a_sw1 : a_sw0) + j * 4096);
                        acc[j][0] = __builtin_amdgcn_mfma_f32_32x32x16_bf16(Bf[0], Af, acc[j][0], 0, 0, 0); acc[j][1] = __builtin_amdgcn_mfma_f32_32x32x16_bf16(Bf[1], Af, acc[j][1], 0, 0, 0); } }
            }
        }
#undef MS_DMAB
#undef MS_DMAA
#pragma unroll
        for (int j = 0; j < 5; ++j) { const int mb = wr + 2 * j, m = 32 * mb + r;
            if (mb < nblk && m < nrows) { const int pair = list[base + m];
                if (MODE == 0) {
#pragma unroll
                    for (int g = 0; g < 4; ++g) { float hv[4];
#pragma unroll
                        for (int p2 = 0; p2 < 4; ++p2) { const float gv = acc[j][0][4 * g + p2], uv = acc[j][1][4 * g + p2]; hv[p2] = gv / (1.f + __expf(-gv)) * uv; }
                        v2u w; w.x = pkbf(hv[0], hv[1]); w.y = pkbf(hv[2], hv[3]); *(v2u*)(Out + (size_t)pair * FF + colbase + 32 * wc + 8 * g + 4 * h) = w; }
                } else { const float gt = gate[pair];
#pragma unroll
                    for (int nb = 0; nb < 2; ++nb)
#pragma unroll
                        for (int g = 0; g < 4; ++g) { v2u w; w.x = pkbf(acc[j][nb][4 * g] * gt, acc[j][nb][4 * g + 1] * gt); w.y = pkbf(acc[j][nb][4 * g + 2] * gt, acc[j][nb][4 * g + 3] * gt);
                            *(v2u*)(Out + (size_t)pair * D + colbase + 128 * nb + 32 * wc + 8 * g + 4 * h) = w; } } } }
    }
}

template <int MODE> __device__ __forceinline__ int moe_expert(int u) { const int x8 = u & 7, y = u >> 3; return x8 * 8 + (MODE == 0 ? (y >> 2) : (y >> 3)); }
template <int MODE> __device__ __forceinline__ int moe_colbase(int u) { const int y = u >> 3; return MODE == 0 ? 128 * (y & 3) : 256 * (y & 7); }
__device__ __forceinline__ void moe_dma_b(LAS unsigned char* lds, const char* Wg0, const char* Wg1, int ldw, int tile, int stage, int wave, int lane) {
    int tq = tile; asm volatile("" : "+s"(tq));
    const unsigned blane = (unsigned)(((lane >> 5) * ldw + 4 * (lane & 31)) * 4);
    const unsigned st = 40960u + (unsigned)stage * 32768u + (unsigned)wave * 1024u; const size_t kro = ((size_t)tq * 32 + 2 * wave) * (size_t)ldw * 4;
    __builtin_amdgcn_global_load_lds((const unsigned*)(Wg0 + kro + blane), (LAS unsigned*)(lds + st), 16, 0, 2);
    __builtin_amdgcn_global_load_lds((const unsigned*)(Wg0 + kro + (size_t)ldw * 64 + blane), (LAS unsigned*)(lds + st + 8192), 16, 0, 2);
    __builtin_amdgcn_global_load_lds((const unsigned*)(Wg1 + kro + blane), (LAS unsigned*)(lds + st + 16384), 16, 0, 2);
    __builtin_amdgcn_global_load_lds((const unsigned*)(Wg1 + kro + (size_t)ldw * 64 + blane), (LAS unsigned*)(lds + st + 24576), 16, 0, 2);
}
template <int MODE> __device__ __forceinline__ void moe_wptr(const float* Wa, const float* Wb, int u, const char*& Wg0, const char*& Wg1) {
    const int e = moe_expert<MODE>(u), cb = moe_colbase<MODE>(u);
    if (MODE == 0) { Wg0 = (const char*)(Wa + (size_t)e * D * FF + cb); Wg1 = (const char*)(Wb + (size_t)e * D * FF + cb); }
    else { Wg0 = (const char*)(Wa + (size_t)e * FF * D + cb); Wg1 = Wg0 + 128 * 4; }
}
template <int MODE> __device__ __forceinline__ void moe_prefetch(LAS unsigned char* lds, const float* Wa, const float* Wb, int wave, int lane) {
    constexpr int NU = (MODE == 0) ? NE * 4 : NE * 8, ldw = (MODE == 0) ? FF : D;
    if ((int)blockIdx.x < NU) { const char* w0; const char* w1; moe_wptr<MODE>(Wa, Wb, (int)blockIdx.x, w0, w1); moe_dma_b(lds, w0, w1, ldw, 0, 0, wave, lane); moe_dma_b(lds, w0, w1, ldw, 1, 1, wave, lane); }
}
template <int MODE>
__device__ __forceinline__ void moe_stream_wg(LAS unsigned char* lds, const char* __restrict__ Ab, unsigned lda, int ashift, const float* __restrict__ Wa, const float* __restrict__ Wb,
                                              const int* __restrict__ elist, const int* __restrict__ ecnt, bf16* __restrict__ Out, const float* __restrict__ gate, int G, bool pre, int tid, int wave, int lane) {
    constexpr int NU = (MODE == 0) ? NE * 4 : NE * 8, K = (MODE == 0) ? D : FF, ldw = (MODE == 0) ? FF : D, nt = K / 32;
    const int wr = wave >> 2, wc = wave & 3, r = lane & 31, h = lane >> 5;
    const unsigned a_base = (unsigned)(wr * 2048 + r * 64), a_sw0 = (unsigned)(((h ^ ((r >> 2) & 3)) & 3) << 4), a_sw1 = (unsigned)((((2 + h) ^ ((r >> 2) & 3)) & 3) << 4);
    const unsigned b_base = (unsigned)((h * 8 * 128 + 32 * wc + r) * 4);
    int u = (int)blockIdx.x, base = 0, ne = 0; bool have = false;
    for (; u < NU; u += G) { ne = ecnt[moe_expert<MODE>(u) * 64]; if (ne > 0) { have = true; break; } }
    if (pre && !(have && u == (int)blockIdx.x)) { asm volatile("s_waitcnt vmcnt(0)" ::: "memory"); pre = false; }
    if (!pre) __syncthreads();
    if (!have) return;
    const char* Wg0; const char* Wg1; moe_wptr<MODE>(Wa, Wb, u, Wg0, Wg1);
    if (!pre) { moe_dma_b(lds, Wg0, Wg1, ldw, 0, 0, wave, lane); moe_dma_b(lds, Wg0, Wg1, ldw, 1, 1, wave, lane); }
    int ph = 0;
    unsigned aoff[3], naoff[3];
#define MW_AOFF(dst, lst, bs, nr) do { _Pragma("unroll") for (int i = 0; i < 3; ++i) { const int pc = (i < 2) ? (wave + 8 * i) : (16 + (wave & 3)); const int m = 16 * pc + (lane >> 2), mm = m < (nr) ? m : (nr) - 1; const int id = (lst)[(bs) + mm]; \
            dst[i] = (unsigned)(id >> ashift) * lda + (unsigned)(((lane & 3) ^ ((m >> 2) & 3)) * 16); } } while (0)
#define MW_DMAA(t, ao) do { int tq_ = (t); asm volatile("" : "+s"(tq_)); const unsigned st_ = (unsigned)(tq_ & 1) * 20480u; const char* ap_ = Ab + (size_t)tq_ * 64; \
            __builtin_amdgcn_global_load_lds((const unsigned*)(ap_ + ao[0]), (LAS unsigned*)(lds + st_ + wave * 1024), 16, 0, 0); \
            __builtin_amdgcn_global_load_lds((const unsigned*)(ap_ + ao[1]), (LAS unsigned*)(lds + st_ + (wave + 8) * 1024), 16, 0, 0); \
            __builtin_amdgcn_global_load_lds((const unsigned*)(ap_ + ao[2]), (LAS unsigned*)(lds + st_ + (16 + (wave & 3)) * 1024), 16, 0, 0); } while (0)
    { const int nr0 = ne < 320 ? ne : 320; const int* l0 = elist + (size_t)moe_expert<MODE>(u) * NTOK; MW_AOFF(aoff, l0, 0, nr0); }
    MW_DMAA(0, aoff);
    for (;;) {
        const int* list = elist + (size_t)moe_expert<MODE>(u) * NTOK; const int colbase = moe_colbase<MODE>(u);
        const int nrows = (ne - base) < 320 ? (ne - base) : 320, nblk = (nrows + 31) >> 5;
        int nu = u, nbase = base + 320, nne = ne; bool hn = true;
        if (nbase >= ne) { hn = false; for (nu = u + G; nu < NU; nu += G) { nne = ecnt[moe_expert<MODE>(nu) * 64]; if (nne > 0) { hn = true; nbase = 0; break; } } }
        const char* nW0 = Wg0; const char* nW1 = Wg1;
        if (hn) { moe_wptr<MODE>(Wa, Wb, nu, nW0, nW1); const int nnr = (nne - nbase) < 320 ? (nne - nbase) : 320; const int* nl = elist + (size_t)moe_expert<MODE>(nu) * NTOK; MW_AOFF(naoff, nl, nbase, nnr); }
        f32x16 acc[5][2];
#pragma unroll
        for (int j = 0; j < 5; ++j)
#pragma unroll
            for (int nb = 0; nb < 2; ++nb)
#pragma unroll
                for (int i = 0; i < 16; ++i) acc[j][nb][i] = 0.f;
        for (int t = 0; t < nt; ++t) {
            int tq = t; asm volatile("" : "+s"(tq));
            const int sb = (ph + tq) % 3;
            LAS unsigned char* Bs = lds + 40960 + sb * 32768; LAS unsigned char* As = lds + (tq & 1) * 20480;
            if (t > 0 && (t + 1 < nt || hn)) asm volatile("s_waitcnt vmcnt(4)" ::: "memory"); else asm volatile("s_waitcnt vmcnt(0)" ::: "memory");
            __builtin_amdgcn_s_barrier(); asm volatile("" ::: "memory");
            if (t + 1 < nt) MW_DMAA(t + 1, aoff); else if (hn) MW_DMAA(0, naoff);
            if (t + 2 < nt) moe_dma_b(lds, Wg0, Wg1, ldw, t + 2, (ph + t + 2) % 3, wave, lane); else if (hn) moe_dma_b(lds, nW0, nW1, ldw, t + 2 - nt, (ph + t + 2) % 3, wave, lane);
            const LAS unsigned char* Ar = As + a_base; const LAS float* Br = (const LAS float*)(Bs + b_base);
#pragma unroll
            for (int ks = 0; ks < 2; ++ks) {
                bf16x8 Bf[2];
#pragma unroll
                for (int nb = 0; nb < 2; ++nb) { const LAS float* bp = Br + nb * 4096 + ks * 2048;
                    v4u w; w.x = pkbf(bp[0], bp[128]); w.y = pkbf(bp[256], bp[384]); w.z = pkbf(bp[512], bp[640]); w.w = pkbf(bp[768], bp[896]); Bf[nb] = __builtin_bit_cast(bf16x8, w); }
#pragma unroll
                for (int j = 0; j < 5; ++j) { const int mb = wr + 2 * j;
                    if (mb < nblk) { const bf16x8 Af = *(const LAS bf16x8*)(Ar + (ks ? a_sw1 : a_sw0) + j * 4096);
                        acc[j][0] = __builtin_amdgcn_mfma_f32_32x32x16_bf16(Bf[0], Af, acc[j][0], 0, 0, 0); acc[j][1] = __builtin_amdgcn_mfma_f32_32x32x16_bf16(Bf[1], Af, acc[j][1], 0, 0, 0); } }
            }
        }
#pragma unroll
        for (int j = 0; j < 5; ++j) { const int mb = wr + 2 * j, m = 32 * mb + r;
            if (mb < nblk) { const bool live = m < nrows; const int pair = list[base + (live ? m : nrows - 1)];
                if (MODE == 0) { unsigned w[4][2];
#pragma unroll
                    for (int g = 0; g < 4; ++g) { float hv[4];
#pragma unroll
                        for (int p2 = 0; p2 < 4; ++p2) { const float gv = acc[j][0][4 * g + p2], uv = acc[j][1][4 * g + p2]; hv[p2] = gv / (1.f + __expf(-gv)) * uv; }
                        w[g][0] = pkbf(hv[0], hv[1]); w[g][1] = pkbf(hv[2], hv[3]); }
                    const v2u s0 = __builtin_amdgcn_permlane32_swap(w[0][0], w[1][0], false, false), s1 = __builtin_amdgcn_permlane32_swap(w[0][1], w[1][1], false, false);
                    const v2u s2 = __builtin_amdgcn_permlane32_swap(w[2][0], w[3][0], false, false), s3 = __builtin_amdgcn_permlane32_swap(w[2][1], w[3][1], false, false);
                    if (live) { bf16* op = Out + (size_t)pair * FF + colbase + 32 * wc + 8 * h; *(v4u*)op = (v4u){s0.x, s1.x, s0.y, s1.y}; *(v4u*)(op + 16) = (v4u){s2.x, s3.x, s2.y, s3.y}; }
                } else { const float gt = gate[pair];
#pragma unroll
                    for (int nb = 0; nb < 2; ++nb) { unsigned w[4][2];
#pragma unroll
                        for (int g = 0; g < 4; ++g) { w[g][0] = pkbf(acc[j][nb][4 * g] * gt, acc[j][nb][4 * g + 1] * gt); w[g][1] = pkbf(acc[j][nb][4 * g + 2] * gt, acc[j][nb][4 * g + 3] * gt); }
                        const v2u s0 = __builtin_amdgcn_permlane32_swap(w[0][0], w[1][0], false, false), s1 = __builtin_amdgcn_permlane32_swap(w[0][1], w[1][1], false, false);
                        const v2u s2 = __builtin_amdgcn_permlane32_swap(w[2][0], w[3][0], false, false), s3 = __builtin_amdgcn_permlane32_swap(w[2][1], w[3][1], false, false);
                        if (live) { bf16* op = Out + (size_t)pair * D + colbase + 128 * nb + 32 * wc + 8 * h; *(v4u*)op = (v4u){s0.x, s1.x, s0.y, s1.y}; *(v4u*)(op + 16) = (v4u){s2.x, s3.x, s2.y, s3.y}; } } } } }
        if (!hn) break;
        u = nu; base = nbase; ne = nne; Wg0 = nW0; Wg1 = nW1; ph = (ph + nt) % 3;
#pragma unroll
        for (int i = 0; i < 3; ++i) aoff[i] = naoff[i];
    }
#undef MW_AOFF
#undef MW_DMAA
}

__device__ __forceinline__ float softplus_f(float z) { return fmaxf(z, 0.f) + log1pf(__expf(-fabsf(z))); }
__device__ __forceinline__ void tr_read2(unsigned a0, unsigned a1, s16x4& r0, s16x4& r1) {
    asm volatile("ds_read_b64_tr_b16 %0, %2\n\tds_read_b64_tr_b16 %1, %3\n\ts_waitcnt lgkmcnt(0)" : "=&v"(r0), "=&v"(r1) : "v"(a0), "v"(a1) : "memory");
}
__device__ __forceinline__ void gla_stage_v(LAS unsigned char* vt, const bf16* __restrict__ proj, size_t row0, int hd, int tid) {
#pragma unroll
    for (int i = 0; i < 4; ++i) { const int id = i * 512 + tid, row = id >> 5, ch = id & 31;
        const v4u x = *(const v4u*)(proj + (row0 + row) * PROJP + C_VG + hd * GDV + ch * 8);
        *(LAS v4u*)(vt + (ch >> 4) * 16384 + offb(row, ch & 15)) = x; }
}
__device__ __forceinline__ void gla_pass1_unit(LAS unsigned char* sm, const bf16* __restrict__ proj, const float* __restrict__ alr, const float* __restrict__ wg, const float* __restrict__ bg,
                                               bf16* __restrict__ qdg, bf16* __restrict__ kig, float* __restrict__ elg, bf16* __restrict__ Ug, int unit, int tid, int wave, int lane) {
    LAS unsigned char* vt = sm; LAS unsigned char* kit = sm + 32768; LAS float* ptot = (LAS float*)(sm + 49152);
    const int c = unit & 31, hd = (unit >> 5) & 3, b = unit >> 7;
    const size_t row0 = (size_t)b * SEQ + c * CHUNK;
    const int j = tid & 127, part = tid >> 7;
    __syncthreads();
    gla_stage_v(vt, proj, row0, hd, tid);
    LAS float* alds = ptot + 512;
    if (tid < 256) *(LAS f32x4*)(alds + tid * 4) = *(const f32x4*)(alr + row0 * GRANK + tid * 4);
    float wgr[GRANK];
#pragma unroll
    for (int r = 0; r < GRANK; ++r) wgr[r] = wg[r * 512 + hd * GDK + j];
    const float bj = bg[hd * GDK + j];
    __syncthreads();
    float cl[16]; float run = 0.f;
#pragma unroll
    for (int tt = 0; tt < 16; ++tt) { const LAS f32x4* ap = (const LAS f32x4*)(alds + (part * 16 + tt) * GRANK); const f32x4 a0 = ap[0], a1 = ap[1], a2 = ap[2], a3 = ap[3];
        float sacc = bj + ((a0[0] * wgr[0] + a0[1] * wgr[1]) + (a0[2] * wgr[2] + a0[3] * wgr[3])) + ((a1[0] * wgr[4] + a1[1] * wgr[5]) + (a1[2] * wgr[6] + a1[3] * wgr[7]))
                   + ((a2[0] * wgr[8] + a2[1] * wgr[9]) + (a2[2] * wgr[10] + a2[3] * wgr[11])) + ((a3[0] * wgr[12] + a3[1] * wgr[13]) + (a3[2] * wgr[14] + a3[3] * wgr[15]));
        run -= (fmaxf(-sacc, 0.f) + __logf(1.0f + __expf(-fabsf(sacc)))) * (1.0f / 16.0f); cl[tt] = run; }
    ptot[part * 128 + j] = run;
    __syncthreads();
    const float prefix = (part > 0 ? ptot[j] : 0.f) + (part > 1 ? ptot[128 + j] : 0.f) + (part > 2 ? ptot[256 + j] : 0.f);
    LAS float* cumt = alds + 1024;
#pragma unroll
    for (int tt = 0; tt < 16; ++tt) cumt[(part * 16 + tt) * 128 + j] = prefix + cl[tt];
    if (part == 3) elg[(size_t)unit * 128 + j] = __expf(prefix + run);
    __syncthreads();
#pragma unroll
    for (int i = 0; i < 2; ++i) { const int id = i * 512 + tid, t = id >> 4, cch = id & 15;
        const v4u q8 = *(const v4u*)(proj + (row0 + t) * PROJP + C_QG + hd * GDK + cch * 8), k8 = *(const v4u*)(proj + (row0 + t) * PROJP + C_KG + hd * GDK + cch * 8);
        const f32x4 c0 = *(const LAS f32x4*)(cumt + t * 128 + cch * 8), c1 = *(const LAS f32x4*)(cumt + t * 128 + cch * 8 + 4);
        v4u qo, ko;
#pragma unroll
        for (int e2 = 0; e2 < 4; ++e2) { const float ca = e2 < 2 ? c0[2 * e2] : c1[2 * e2 - 4], cb = e2 < 2 ? c0[2 * e2 + 1] : c1[2 * e2 - 3];
            const float ea = __expf(ca), eb = __expf(cb), ia = __builtin_amdgcn_rcpf(ea), ib = __builtin_amdgcn_rcpf(eb);
            const float qa = __uint_as_float(q8[e2] << 16), qb = __uint_as_float(q8[e2] & 0xffff0000u), ka = __uint_as_float(k8[e2] << 16), kb2 = __uint_as_float(k8[e2] & 0xffff0000u);
            qo[e2] = pkbf(qa * 0.08838834764831845f * ea, qb * 0.08838834764831845f * eb); ko[e2] = pkbf(ka * ia, kb2 * ib); }
        const size_t gi = (row0 + t) * 512 + hd * GDK + cch * 8;
        *(v4u*)(qdg + gi) = qo; *(v4u*)(kig + gi) = ko;
        *(LAS v4u*)(kit + offb(t, cch)) = ko; }
    __syncthreads();
    const unsigned vbase = (unsigned)(size_t)vt + (wave >> 2) * 16384, kbase = (unsigned)(size_t)kit;
    const unsigned h = lane >> 5, blk = (lane >> 4) & 1, q4 = (lane & 15) >> 2, p4 = lane & 3;
    f32x16 U[4];
#pragma unroll
    for (int db = 0; db < 4; ++db)
#pragma unroll
        for (int i = 0; i < 16; ++i) U[db][i] = 0.f;
#pragma unroll
    for (int ks = 0; ks < 4; ++ks) {
        const unsigned r0 = 16 * ks + 8 * h + q4, r1 = r0 + 4, cc = 2 * blk + (p4 >> 1), bo = 8 * (p4 & 1);
        s16x4 a0, a1; tr_read2(vbase + offb(r0, 4 * (wave & 3) + cc) + bo, vbase + offb(r1, 4 * (wave & 3) + cc) + bo, a0, a1);
        const bf16x8 Af = __builtin_shufflevector(a0, a1, 0, 1, 2, 3, 4, 5, 6, 7);
#pragma unroll
        for (int db = 0; db < 4; ++db) { s16x4 b0, b1; tr_read2(kbase + offb(r0, 4 * db + cc) + bo, kbase + offb(r1, 4 * db + cc) + bo, b0, b1);
            U[db] = __builtin_amdgcn_mfma_f32_32x32x16_bf16(Af, __builtin_shufflevector(b0, b1, 0, 1, 2, 3, 4, 5, 6, 7), U[db], 0, 0, 0); }
    }
    bf16* up = Ug + (size_t)unit * 32768;
#pragma unroll
    for (int db = 0; db < 4; ++db)
#pragma unroll
        for (int i = 0; i < 16; ++i) up[(size_t)(32 * wave + (i & 3) + 8 * (i >> 2) + 4 * h) * 128 + 32 * db + (lane & 31)] = f2bf(U[db][i]);
}
__device__ __forceinline__ void gla_pass3_pair(LAS unsigned char* sm, const bf16* __restrict__ proj, const bf16* __restrict__ qdg, const bf16* __restrict__ kig, const bf16* __restrict__ Sg,
                                               const float* __restrict__ gain, const float* __restrict__ br, bf16* __restrict__ cat, int unit0, int unit1, int tid, int wave, int lane) {
    LAS float* nt = (LAS float*)(sm + 65536);
    const int ug = wave >> 2, gwv = wave & 3, unit = ug ? unit1 : unit0;
    const int c = unit & 31, hd = (unit >> 5) & 3, b = unit >> 7;
    const size_t row0 = (size_t)b * SEQ + c * CHUNK;
    __syncthreads();
#pragma unroll
    for (int i = 0; i < 8; ++i) { const int id = i * 512 + tid, tl = id >> 11, rem = id & 2047, row = rem >> 5, ch = rem & 31; const int us = tl ? unit1 : unit0;
        const size_t r0s = (size_t)(us >> 7) * SEQ + (us & 31) * CHUNK; const int hs = (us >> 5) & 3;
        const v4u x = *(const v4u*)(proj + (r0s + row) * PROJP + C_VG + hs * GDV + ch * 8);
        *(LAS v4u*)(sm + tl * 32768 + (ch >> 4) * 16384 + offb(row, ch & 15)) = x; }
    LAS unsigned char* vt = sm + ug * 32768;
    const int tb = gwv & 1, dq2 = gwv >> 1, r = lane & 31, h = lane >> 5, t = 32 * tb + r;
    bf16x8 Bq[8];
#pragma unroll
    for (int ks = 0; ks < 8; ++ks) Bq[ks] = *(const bf16x8*)(qdg + (row0 + t) * 512 + hd * GDK + 16 * ks + 8 * h);
    f32x16 O[4];
#pragma unroll
    for (int dvb = 0; dvb < 4; ++dvb)
#pragma unroll
        for (int i = 0; i < 16; ++i) O[dvb][i] = 0.f;
    const bf16* Sp = Sg + (size_t)unit * 32768;
    bf16x8 Kf0[8];
#pragma unroll
    for (int ks = 0; ks < 8; ++ks) Kf0[ks] = *(const bf16x8*)(kig + (row0 + r) * 512 + hd * GDK + 16 * ks + 8 * h);
#pragma unroll
    for (int dvb = 0; dvb < 4; ++dvb)
#pragma unroll
        for (int ks = 0; ks < 8; ++ks) { const bf16x8 Sf = *(const bf16x8*)(Sp + (size_t)(32 * (4 * dq2 + dvb) + r) * 128 + 16 * ks + 8 * h);
            O[dvb] = __builtin_amdgcn_mfma_f32_32x32x16_bf16(Sf, Bq[ks], O[dvb], 0, 0, 0); }
    __syncthreads();
    const unsigned blk = (lane >> 4) & 1, q4 = (lane & 15) >> 2, p4 = lane & 3;
    v2u rgp[4][4];
#pragma unroll
    for (int dvb = 0; dvb < 4; ++dvb)
#pragma unroll
        for (int g = 0; g < 4; ++g) rgp[dvb][g] = *(const v2u*)(proj + (row0 + t) * PROJP + C_RG + hd * GDV + 32 * (4 * dq2 + dvb) + 8 * g + 4 * h);
    for (int sb = 0; sb <= tb; ++sb) {
        f32x16 ST;
#pragma unroll
        for (int i = 0; i < 16; ++i) ST[i] = 0.f;
#pragma unroll
        for (int ks = 0; ks < 8; ++ks) { const bf16x8 Kf = (sb == 0) ? Kf0[ks] : *(const bf16x8*)(kig + (row0 + 32 * sb + r) * 512 + hd * GDK + 16 * ks + 8 * h);
            ST = __builtin_amdgcn_mfma_f32_32x32x16_bf16(Kf, Bq[ks], ST, 0, 0, 0); }
        const bool diag = (sb == tb);
        float w[16];
#pragma unroll
        for (int i = 0; i < 16; ++i) { const int sl = (i & 3) + 8 * (i >> 2) + 4 * h; w[i] = (!diag || sl <= r) ? ST[i] : 0.f; }
#pragma unroll
        for (int s2 = 0; s2 < 2; ++s2) {
            v4u wp; wp.x = pkbf(w[8 * s2], w[8 * s2 + 1]); wp.y = pkbf(w[8 * s2 + 2], w[8 * s2 + 3]); wp.z = pkbf(w[8 * s2 + 4], w[8 * s2 + 5]); wp.w = pkbf(w[8 * s2 + 6], w[8 * s2 + 7]);
            const bf16x8 Wf = __builtin_bit_cast(bf16x8, wp);
            const unsigned rb0 = 32 * sb + 16 * s2 + 4 * h + q4, rb1 = rb0 + 8, cb = 2 * blk + (p4 >> 1), bo = 8 * (p4 & 1);
            const unsigned base = (unsigned)(size_t)vt + dq2 * 16384 + bo;
            s16x4 v0a, v0b, v1a, v1b, v2a, v2b, v3a, v3b;
            tr_read8(base + offb(rb0, cb), base + offb(rb1, cb), base + offb(rb0, 4 + cb), base + offb(rb1, 4 + cb), base + offb(rb0, 8 + cb), base + offb(rb1, 8 + cb), base + offb(rb0, 12 + cb), base + offb(rb1, 12 + cb),
                     v0a, v0b, v1a, v1b, v2a, v2b, v3a, v3b);
            O[0] = __builtin_amdgcn_mfma_f32_32x32x16_bf16(__builtin_shufflevector(v0a, v0b, 0, 1, 2, 3, 4, 5, 6, 7), Wf, O[0], 0, 0, 0);
            O[1] = __builtin_amdgcn_mfma_f32_32x32x16_bf16(__builtin_shufflevector(v1a, v1b, 0, 1, 2, 3, 4, 5, 6, 7), Wf, O[1], 0, 0, 0);
            O[2] = __builtin_amdgcn_mfma_f32_32x32x16_bf16(__builtin_shufflevector(v2a, v2b, 0, 1, 2, 3, 4, 5, 6, 7), Wf, O[2], 0, 0, 0);
            O[3] = __builtin_amdgcn_mfma_f32_32x32x16_bf16(__builtin_shufflevector(v3a, v3b, 0, 1, 2, 3, 4, 5, 6, 7), Wf, O[3], 0, 0, 0);
        }
    }
    float ss = 0.f;
#pragma unroll
    for (int dvb = 0; dvb < 4; ++dvb)
#pragma unroll
        for (int i = 0; i < 16; ++i) ss += O[dvb][i] * O[dvb][i];
    ss += __shfl_xor(ss, 32);
    if (h == 0) nt[(ug * 64 + t) * 2 + dq2] = ss;
    __syncthreads();
    const float rs = rsqrtf((nt[(ug * 64 + t) * 2] + nt[(ug * 64 + t) * 2 + 1]) * (1.0f / GDV) + EPS);
#pragma unroll
    for (int dvb = 0; dvb < 4; ++dvb) { unsigned w[4][2];
#pragma unroll
        for (int g = 0; g < 4; ++g) { const int cidx = hd * GDV + 32 * (4 * dq2 + dvb) + 8 * g + 4 * h;
            const v2u rg = rgp[dvb][g]; const f32x4 gv = *(const f32x4*)(gain + cidx), bv = *(const f32x4*)(br + cidx);
            const float rr[4] = {__uint_as_float(rg.x << 16) + bv[0], __uint_as_float(rg.x & 0xffff0000u) + bv[1], __uint_as_float(rg.y << 16) + bv[2], __uint_as_float(rg.y & 0xffff0000u) + bv[3]};
            float y[4];
#pragma unroll
            for (int i = 0; i < 4; ++i) y[i] = O[dvb][4 * g + i] * rs * gv[i] * (rr[i] / (1.f + __expf(-rr[i])));
            w[g][0] = pkbf(y[0], y[1]); w[g][1] = pkbf(y[2], y[3]); }
        const v2u s0 = __builtin_amdgcn_permlane32_swap(w[0][0], w[1][0], false, false), s1 = __builtin_amdgcn_permlane32_swap(w[0][1], w[1][1], false, false);
        const v2u s2 = __builtin_amdgcn_permlane32_swap(w[2][0], w[3][0], false, false), s3 = __builtin_amdgcn_permlane32_swap(w[2][1], w[3][1], false, false);
        bf16* op = cat + (row0 + t) * D + 1024 + hd * GDV + 32 * (4 * dq2 + dvb) + 8 * h;
        *(v4u*)op = (v4u){s0.x, s1.x, s0.y, s1.y}; *(v4u*)(op + 16) = (v4u){s2.x, s3.x, s2.y, s3.y}; }
}

__device__ __forceinline__ void proj_tail_item(LAS unsigned char* sm, const bf16* __restrict__ h0, const bf16* __restrict__ WinT, bf16* __restrict__ proj, int item, int tid, int wave, int lane) {
    LAS float* red = (LAS float*)sm;
    const int fr = lane & 15, kg = lane >> 4; const size_t row0 = (size_t)item * 64;
    f32x4 acc[4];
#pragma unroll
    for (int mt = 0; mt < 4; ++mt) acc[mt] = (f32x4){0.f, 0.f, 0.f, 0.f};
    __syncthreads();
#pragma unroll
    for (int ks = 0; ks < 8; ++ks) { const int k0 = 256 * wave + 32 * ks + 8 * kg;
        const bf16x8 Bf = *(const bf16x8*)(WinT + (size_t)(6144 + fr) * D + k0);
#pragma unroll
        for (int mt = 0; mt < 4; ++mt) { const bf16x8 Af = *(const bf16x8*)(h0 + (row0 + 16 * mt + fr) * D + k0); acc[mt] = __builtin_amdgcn_mfma_f32_16x16x32_bf16(Af, Bf, acc[mt], 0, 0, 0); } }
#pragma unroll
    for (int mt = 0; mt < 4; ++mt)
#pragma unroll
        for (int jj = 0; jj < 4; ++jj) red[(wave * 64 + 16 * mt + 4 * kg + jj) * 16 + fr] = acc[mt][jj];
    __syncthreads();
#pragma unroll
    for (int i = 0; i < 2; ++i) { const int o = i * 512 + tid; float a = 0.f;
#pragma unroll
        for (int w8 = 0; w8 < 8; ++w8) a += red[w8 * 1024 + o];
        proj[(row0 + (o >> 4)) * PROJP + 6144 + (o & 15)] = f2bf(a); }
}

struct Args { const float* in[24]; float* out; unsigned char* ws; int ph_lo, ph_hi; };
__global__ void __launch_bounds__(NWAVES * 64, 2) mk_fwd(Args args) {
    extern __shared__ __attribute__((aligned(16))) unsigned char lds[];
    Frame F;
    F.lds = (LAS unsigned char*)lds; F.MISC = (volatile LAS unsigned*)(F.lds + MISC_OFF);
    F.tid = threadIdx.x; F.lane = F.tid & 63; F.wave = __builtin_amdgcn_readfirstlane(F.tid >> 6);
    F.G = gridDim.x; { const int bx = blockIdx.x; F.vcu = (F.G % 8 == 0) ? (bx % 8) * (F.G / 8) + bx / 8 : bx; }
    F.ws = args.ws; F.ctl = (unsigned*)(args.ws + WS_CTL);
    for (int u = F.tid; u < (LDS_BYTES - LDSCTL_OFF) / 4; u += NWAVES * 64) ((LAS unsigned*)(F.lds + LDSCTL_OFF))[u] = 0u;
    __syncthreads();
    const int lo = args.ph_lo, hi = args.ph_hi;
    const bool multi = (hi - lo) > 1;
    XcdBarrier bar; bar.bar = F.ctl + CW_BAR; bar.x = 0; bar.st = nullptr;
    if (multi) bar = xcd_barrier_post(F.ctl + CW_BAR, F.MISC + 8);
#ifndef DUP_PHASE
#define DUP_PHASE -1
#endif
#define IN(k) (lo <= (k) && (k) < hi)
#define REP(k) for (int rep_ = 0; rep_ < ((DUP_PHASE) == (k) ? 2 : 1); ++rep_)
#define SEAM(k) do { if (IN(k) && IN((k) + 1)) xcd_barrier(bar); } while (0)
    const float* const* in = args.in;
    unsigned char* ws = args.ws;
    bf16* WinT = (bf16*)(ws + WS_WIN); bf16* WoutT = (bf16*)(ws + WS_WOUT); bf16* WxqT = (bf16*)(ws + WS_WXQ); bf16* WxkvT = (bf16*)(ws + WS_WXKV); bf16* WxoT = (bf16*)(ws + WS_WXO);
    bf16* h0 = (bf16*)(ws + WS_H0); bf16* hm = (bf16*)(ws + WS_HM); bf16* projb = (bf16*)(ws + WS_PROJ); float* alr = (float*)(ws + WS_ALR);
    bf16* KVb = (bf16*)(ws + WS_KV); bf16* MKT = (bf16*)(ws + WS_MKT); bf16* NVT = (bf16*)(ws + WS_NVT);
    bf16* catb = (bf16*)(ws + WS_CAT); float* x1 = (float*)(ws + WS_X1); bf16* x1b = (bf16*)(ws + WS_X1B); bf16* qx = (bf16*)(ws + WS_QX); bf16* oxb = (bf16*)(ws + WS_OX); bf16* x2b = (bf16*)(ws + WS_X2);
    bf16* Pb = (bf16*)(ws + WS_PB);
    bf16* hf = (bf16*)(ws + WS_HF); bf16* Hb = (bf16*)(ws + WS_HB); bf16* Yb = (bf16*)(ws + WS_YB);
    bf16* WrHi = (bf16*)(ws + WS_WR); bf16* WrLo = (bf16*)(ws + WS_WR + 512 * 1024); int* elist = (int*)(ws + WS_LIST); float* gatev = (float*)(ws + WS_GATE); int* ecnt = (int*)(F.ctl + CW_CNT);
    float* rowsq1 = (float*)(F.ctl + CW_ROWSQ1); float* rowsq2 = (float*)(F.ctl + CW_ROWSQ2);

    if (IN(0)) REP(0) {
        LAS float* scr = (LAS float*)(F.lds + RING_OFF + F.wave * 18432);
        const int gw = F.vcu * NWAVES + F.wave, NGW = F.G * NWAVES;
        constexpr int KB = D / 64;
        constexpr int I_IN = KB * ((PROJ + 63) / 64), I_KV = KB * (2 * D / 64);
        constexpr int NITEMS = I_IN + I_KV;
        for (int it = gw; it < NITEMS; it += NGW) {
            if (it < I_IN) p0_transpose_item(in[3], D, PROJ, PROJ, nullptr, WinT, 0, scr, it, F.lane);
            else p0_transpose_item(in[13], D, 2 * D, 2 * D, nullptr, WxkvT, 0, scr, it - I_IN, F.lane);
        }
        { const size_t z0 = (size_t)(((PROJ + 63) / 64) * 64) * D, z1 = (size_t)PROJP * D; v4u zz = {0u, 0u, 0u, 0u};
          for (size_t i = z0 / 8 + (size_t)blockIdx.x * 512 + F.tid; i < z1 / 8; i += (size_t)F.G * 512) ((v4u*)WinT)[i] = zz; }
        for (int i = blockIdx.x * 512 + F.tid; i < 80 * D; i += F.G * 512) { const int n = i / D, k = i % D; const float v = n < 8 ? in[16][k * 8 + n] : (n < 72 ? in[18][k * 64 + n - 8] : 0.f);
            const int j = ((((k >> 5) * 5 + (n >> 4)) * 64) + ((k & 31) >> 3) * 16 + (n & 15)) * 8 + (k & 7);
            const unsigned short hi = f2bf(v); WrHi[j] = hi; WrLo[j] = f2bf(v - bf2f(hi)); }
        for (int m = gw; m < NTOK; m += NGW) rms_row_to_bf16(in[0] + (size_t)m * D, in[2], h0 + (size_t)m * D, F.lane);
        for (int m = gw; m < NMEM; m += NGW) rms_row_to_bf16(in[1] + (size_t)m * D, in[11], hm + (size_t)m * D, F.lane);
    }
    SEAM(0);
    if (IN(1)) REP(1) {
        pg8::DenseSched S{(const char*)h0, (const char*)WinT, D * 2, D * 2, D, NTOK / 256, 24, F.G, (int)blockIdx.x};
        EpiProj E{projb, alr};
        pg8::gemm_phase<EpiProj, pg8::DenseSched, true>(F.lds + RING_OFF, S, E);
    }
    SEAM(1);
    if (IN(2)) REP(2) {
        { pg8::DenseSched S{(const char*)hm, (const char*)WxkvT, D * 2, D * 2, D, NMEM / 256, 2 * D / 256, F.G, (int)blockIdx.x};
          EpiBf16 E{KVb, 2 * D};
          pg8::gemm_phase<EpiBf16, pg8::DenseSched, true>(F.lds + RING_OFF, S, E); }
        { const int first = (F.G > 64 + 32) ? 64 : 0, nl = F.G - first, li = (int)blockIdx.x - first;
          if (li >= 0) { LAS float* scr = (LAS float*)(F.lds + RING_OFF + F.wave * 18432);
              constexpr int I_SQ = (D / 64) * (D / 64);
              for (int it = li * NWAVES + F.wave; it < 2 * I_SQ; it += nl * NWAVES) {
                  if (it < I_SQ) p0_transpose_item(in[9], D, D, D, nullptr, WoutT, 0, scr, it, F.lane);
                  else p0_transpose_item(in[14], D, D, D, nullptr, WxoT, 0, scr, it - I_SQ, F.lane); }
              for (int i = li * 512 + F.tid; i < D * D / 4; i += nl * 512) { const f32x4 v = ((const f32x4*)in[12])[i]; const float g = in[10][i / (D / 4)]; v2u o; o.x = pkbf(v[0] * g, v[1] * g); o.y = pkbf(v[2] * g, v[3] * g); ((v2u*)WxqT)[i] = o; } } }
        for (;;) {
            if (F.tid == 0) F.MISC[20] = (unsigned)__hip_atomic_fetch_add(F.ctl + CW_Q + 128, 1u, __ATOMIC_RELAXED, __HIP_MEMORY_SCOPE_AGENT);
            __syncthreads();
            const int item = (int)F.MISC[20];
            __syncthreads();
            if (item >= NTOK / 64) break;
            proj_tail_item(F.lds + RING_OFF, h0, WinT, projb, item, F.tid, F.wave, F.lane);
        }
        for (;;) {
            if (F.tid == 0) F.MISC[20] = (unsigned)__hip_atomic_fetch_add(F.ctl + CW_Q, 1u, __ATOMIC_RELAXED, __HIP_MEMORY_SCOPE_AGENT);
            __syncthreads();
            const int item = (int)F.MISC[20];
            __syncthreads();
            if (item >= 512) break;
            gla_pass1_unit(F.lds + RING_OFF, projb, alr, in[4], in[5], (bf16*)(ws + WS_GQD), (bf16*)(ws + WS_GKI), (float*)(ws + WS_GEL), (bf16*)(ws + WS_GU), item, F.tid, F.wave, F.lane);
        }
        for (;;) {
            if (F.tid == 0) F.MISC[20] = (unsigned)__hip_atomic_fetch_add(F.ctl + CW_Q + 64, 1u, __ATOMIC_RELAXED, __HIP_MEMORY_SCOPE_AGENT);
            __syncthreads();
            const int item = (int)F.MISC[20];
            __syncthreads();
            if (item >= BATCH * SBH * (SEQ / 32) / NWAVES) break;
            sb_wg_unit(F.lds + RING_OFF, projb, in[7], catb, item, F.wave, F.lane);
        }
    }
    SEAM(2);
    if (IN(3)) REP(3) {
        { MktSched S{(const char*)KVb, (const char*)WxqT, D * 2, XD, F.G, (int)blockIdx.x}; EpiBf16 E{MKT, D};
          pg8::gemm_phase<EpiBf16, MktSched, true>(F.lds + RING_OFF, S, E); }
        { NvtSched S{(const char*)WxoT, (const char*)KVb, 2 * D * 2, XD, F.G, ((int)blockIdx.x + F.G - 128) % F.G}; EpiBf16 E{NVT, 1024};
          pg8::gemm_phase<EpiBf16, NvtSched, true>(F.lds + RING_OFF, S, E); }
        const bf16* Ug = (const bf16*)(ws + WS_GU); const float* elg = (const float*)(ws + WS_GEL); bf16* Sg = (bf16*)(ws + WS_GS);
        for (int g = blockIdx.x * 512 + F.tid; g < BATCH * GH * 8192; g += F.G * 512) { const int bh = g >> 13, idx = g & 8191, dk = (idx & 31) * 4;
            f32x4 S4 = {0.f, 0.f, 0.f, 0.f};
#pragma unroll 8
            for (int c = 0; c < 32; ++c) { const size_t u = (size_t)bh * 32 + c; const v2u ub = __builtin_nontemporal_load((const v2u*)(Ug + u * 32768 + (size_t)idx * 4)); const f32x4 u4 = {__uint_as_float(ub.x << 16), __uint_as_float(ub.x & 0xffff0000u), __uint_as_float(ub.y << 16), __uint_as_float(ub.y & 0xffff0000u)}, e4 = *(const f32x4*)(elg + u * 128 + dk);
                v2u o; o.x = pkbf(S4[0], S4[1]); o.y = pkbf(S4[2], S4[3]); *(v2u*)(Sg + u * 32768 + (size_t)idx * 4) = o;
                S4 = (S4 + u4) * e4; } }
    }
    SEAM(3);
    if (IN(4)) REP(4) {
        for (int unit = blockIdx.x; unit < 512; unit += 2 * F.G)
            gla_pass3_pair(F.lds + RING_OFF, projb, (const bf16*)(ws + WS_GQD), (const bf16*)(ws + WS_GKI), (const bf16*)(ws + WS_GS), in[8], in[6], catb, unit, (unit + F.G < 512) ? unit + F.G : unit, F.tid, F.wave, F.lane);
    }
    SEAM(4);
    if (IN(5)) REP(5) {
        pg8::DenseSched S{(const char*)catb, (const char*)WoutT, D * 2, D * 2, D, NTOK / 256, D / 256, F.G, (int)blockIdx.x};
        EpiResid E{in[0], nullptr, nullptr, x1b, rowsq1};
        pg8::gemm_phase<EpiResid, pg8::DenseSched, false>(F.lds + RING_OFF, S, E);
    }
    SEAM(5);
    if (IN(6)) REP(6) {
        EpiSoftmax128 E{Pb, (LAS float*)(F.lds + LDSCTL_OFF + 1024), rowsq1};
        for (int c = blockIdx.x; c < 256; c += F.G) { const int hp = 8 * (c & 7) + (c >> 5), h = (c >> 3) & 3, b = hp >> 4;
            pg8::Unit u; u.pm = hp; u.pn = h; u.z = c; u.mv = 128; u.A = (const char*)x1b + (size_t)hp * 128 * D * 2; u.B = (const char*)MKT + (size_t)(b * 1024 + h * 256) * D * 2;
            pg8::gemm128_unit<EpiSoftmax128>(F.lds + RING_OFF, u.A, D * 2, u.B, D * 2, D, E, u); }
    }
    SEAM(6);
    if (IN(7)) REP(7) {
        XOutSched S{(const char*)Pb, (const char*)NVT, 1024 * 2, 1024, F.G, (int)blockIdx.x};
        EpiResid E{nullptr, x1b, nullptr, x2b, rowsq2};
        pg8::gemm_phase<EpiResid, XOutSched, false>(F.lds + RING_OFF, S, E);
    }
    SEAM(7);
    if (IN(8)) REP(8) {
        LAS float* red = (LAS float*)(F.lds + RING_OFF);
        LAS float* lg = (LAS float*)(F.lds + RING_OFF + 81920);
        const int kg = F.lane >> 4, fr = F.lane & 15;
        for (int tile = blockIdx.x; tile < NTOK / 32; tile += F.G) {
            const int row0 = tile * 32;
            f32x4 racc[2][5];
#pragma unroll
            for (int rt = 0; rt < 2; ++rt)
#pragma unroll
                for (int nt = 0; nt < 5; ++nt) racc[rt][nt] = (f32x4){0.f, 0.f, 0.f, 0.f};
            float rs[2];
#pragma unroll
            for (int rt = 0; rt < 2; ++rt) rs[rt] = rsqrtf(rowsq2[row0 + 16 * rt + fr] * (1.0f / D) + EPS);
            for (int kh = 0; kh < 4; ++kh) {
                v4u xa[2][2];
#pragma unroll
                for (int k4 = 0; k4 < 2; ++k4)
#pragma unroll
                    for (int rt = 0; rt < 2; ++rt) { const size_t ro = (size_t)(row0 + 16 * rt + fr) * D + 256 * F.wave + 32 * (2 * kh + k4) + 8 * kg; xa[k4][rt] = __builtin_nontemporal_load((const v4u*)(x2b + ro)); }
#pragma unroll
                for (int k4 = 0; k4 < 2; ++k4) {
                    const int k0 = 256 * F.wave + 32 * (2 * kh + k4) + 8 * kg;
                    const f32x4 g0 = *(const f32x4*)(in[15] + k0), g1 = *(const f32x4*)(in[15] + k0 + 4);
                    bf16x8 Ahi[2], Alo[2];
#pragma unroll
                    for (int rt = 0; rt < 2; ++rt) { const size_t ro = (size_t)(row0 + 16 * rt + fr) * D + k0; const v4u xb = xa[k4][rt]; const f32x4 a0 = {__uint_as_float(xb.x << 16), __uint_as_float(xb.x & 0xffff0000u), __uint_as_float(xb.y << 16), __uint_as_float(xb.y & 0xffff0000u)}, a1 = {__uint_as_float(xb.z << 16), __uint_as_float(xb.z & 0xffff0000u), __uint_as_float(xb.w << 16), __uint_as_float(xb.w & 0xffff0000u)};
                        float v[8]; v[0] = a0[0] * rs[rt] * g0[0]; v[1] = a0[1] * rs[rt] * g0[1]; v[2] = a0[2] * rs[rt] * g0[2]; v[3] = a0[3] * rs[rt] * g0[3];
                        v[4] = a1[0] * rs[rt] * g1[0]; v[5] = a1[1] * rs[rt] * g1[1]; v[6] = a1[2] * rs[rt] * g1[2]; v[7] = a1[3] * rs[rt] * g1[3];
                        v4u hp, lp;
#pragma unroll
                        for (int j = 0; j < 4; ++j) { const unsigned hpk = pkbf(v[2 * j], v[2 * j + 1]); hp[j] = hpk; lp[j] = pkbf(v[2 * j] - __uint_as_float(hpk << 16), v[2 * j + 1] - __uint_as_float(hpk & 0xffff0000u)); }
                        *(v4u*)(hf + ro) = hp; Ahi[rt] = __builtin_bit_cast(bf16x8, hp); Alo[rt] = __builtin_bit_cast(bf16x8, lp); }
#pragma unroll
                    for (int nt = 0; nt < 5; ++nt) { const size_t bo = (size_t)((((8 * F.wave + 2 * kh + k4) * 5 + nt) * 64 + F.lane) * 8); const bf16x8 Bh = *(const bf16x8*)(WrHi + bo), Bl = *(const bf16x8*)(WrLo + bo);
#pragma unroll
                        for (int rt = 0; rt < 2; ++rt) { racc[rt][nt] = __builtin_amdgcn_mfma_f32_16x16x32_bf16(Ahi[rt], Bh, racc[rt][nt], 0, 0, 0);
                            racc[rt][nt] = __builtin_amdgcn_mfma_f32_16x16x32_bf16(Alo[rt], Bh, racc[rt][nt], 0, 0, 0); racc[rt][nt] = __builtin_amdgcn_mfma_f32_16x16x32_bf16(Ahi[rt], Bl, racc[rt][nt], 0, 0, 0); } }
                }
            }
#pragma unroll
            for (int rt = 0; rt < 2; ++rt)
#pragma unroll
                for (int nt = 0; nt < 5; ++nt)
#pragma unroll
                    for (int j = 0; j < 4; ++j) red[(F.wave * 32 + 16 * rt + 4 * kg + j) * 80 + 16 * nt + fr] = racc[rt][nt][j];
            __syncthreads();
            for (int o = F.tid; o < 32 * 80; o += 512) { float a = 0.f;
#pragma unroll
                for (int w8 = 0; w8 < 8; ++w8) a += red[w8 * 2560 + o]; lg[o] = a; }
            __syncthreads();
            if (F.tid < 32) { const int tkn = row0 + F.tid; const LAS float* l = lg + F.tid * 80;
                int g = 0; float mg = l[0] + in[17][0];
                for (int i = 1; i < 8; ++i) { const float v = l[i] + in[17][i]; if (v > mg) { mg = v; g = i; } }
                float sg = 0.f; for (int i = 0; i < 8; ++i) sg += __expf(l[i] + in[17][i] - mg);
                const float ptop = 1.f / sg;
                int i1 = 0; float m1 = l[8 + g * 8] + in[19][g * 8];
                for (int i = 1; i < 8; ++i) { const float v = l[8 + g * 8 + i] + in[19][g * 8 + i]; if (v > m1) { m1 = v; i1 = i; } }
                int i2 = 0; float m2 = -3.4e38f;
                for (int i = 0; i < 8; ++i) { const float v = l[8 + g * 8 + i] + in[19][g * 8 + i]; if (i != i1 && v > m2) { m2 = v; i2 = i; } }
                const float rr = __expf(m2 - m1), w1 = 1.f / (1.f + rr), w2 = rr / (1.f + rr);
                const int e1 = g * 8 + i1, e2 = g * 8 + i2;
                const int s1 = atomicAdd(&ecnt[e1 * 64], 1), s2 = atomicAdd(&ecnt[e2 * 64], 1);
                elist[(size_t)e1 * NTOK + s1] = tkn * 2; gatev[tkn * 2] = ptop * w1;
                elist[(size_t)e2 * NTOK + s2] = tkn * 2 + 1; gatev[tkn * 2 + 1] = ptop * w2; }
            __syncthreads();
        }
    }
    const bool pre9 = IN(8) && IN(9), pre10 = IN(9) && IN(10);
    if (pre9) xcd_barrier_pf(bar, [&]() { moe_prefetch<0>(F.lds + RING_OFF, in[20], in[21], F.wave, F.lane); });
    if (IN(9)) REP(9) {
        moe_stream_wg<0>(F.lds + RING_OFF, (const char*)hf, D * 2, 1, in[20], in[21], elist, ecnt, Hb, nullptr, F.G, pre9 && rep_ == 0, F.tid, F.wave, F.lane);
    }
    if (pre10) xcd_barrier_pf(bar, [&]() { moe_prefetch<1>(F.lds + RING_OFF, in[22], nullptr, F.wave, F.lane); });
    if (IN(10)) REP(10) {
        moe_stream_wg<1>(F.lds + RING_OFF, (const char*)Hb, FF * 2, 0, in[22], nullptr, elist, ecnt, Yb, gatev, F.G, pre10 && rep_ == 0, F.tid, F.wave, F.lane);
    }
    SEAM(10);
    if (IN(11)) REP(11) {
        const int gw = F.vcu * NWAVES + F.wave, NGW = F.G * NWAVES;
        v2u ra[8], rb[8], rx[8];
#define P11_LOAD(m_, A_, B_, X_) do { const v2u* xr_ = (const v2u*)(x2b + (size_t)(m_) * D) + F.lane; const v2u* y0_ = (const v2u*)(Yb + (size_t)(2 * (m_)) * D) + F.lane; const v2u* y1_ = (const v2u*)(Yb + (size_t)(2 * (m_) + 1) * D) + F.lane; \
            _Pragma("unroll") for (int j = 0; j < 8; ++j) { A_[j] = __builtin_nontemporal_load(y0_ + 64 * j); B_[j] = __builtin_nontemporal_load(y1_ + 64 * j); X_[j] = __builtin_nontemporal_load(xr_ + 64 * j); } } while (0)
        if (gw < NTOK) P11_LOAD(gw, ra, rb, rx);
        for (int m = gw; m < NTOK; m += NGW) {
            v2u na[8], nb2[8], nx[8];
            const int mn = (m + NGW < NTOK) ? m + NGW : m;
            P11_LOAD(mn, na, nb2, nx);
            f32x4 v[8]; float ssq = 0.f;
#pragma unroll
            for (int j = 0; j < 8; ++j) { const v2u a = ra[j], b2 = rb[j], xx = rx[j]; f32x4 t4;
                t4[0] = __uint_as_float(xx.x << 16) + __uint_as_float(a.x << 16) + __uint_as_float(b2.x << 16); t4[1] = __uint_as_float(xx.x & 0xffff0000u) + __uint_as_float(a.x & 0xffff0000u) + __uint_as_float(b2.x & 0xffff0000u);
                t4[2] = __uint_as_float(xx.y << 16) + __uint_as_float(a.y << 16) + __uint_as_float(b2.y << 16); t4[3] = __uint_as_float(xx.y & 0xffff0000u) + __uint_as_float(a.y & 0xffff0000u) + __uint_as_float(b2.y & 0xffff0000u);
                v[j] = t4; ssq += (t4[0] * t4[0] + t4[1] * t4[1]) + (t4[2] * t4[2] + t4[3] * t4[3]); }
            const float rstd = rsqrtf(wave_sum(ssq) * (1.f / D) + EPS);
            f32x4* o4 = (f32x4*)(args.out + (size_t)m * D) + F.lane;
#pragma unroll
            for (int j = 0; j < 8; ++j) { const f32x4 g = ((const f32x4*)in[23])[64 * j + F.lane]; __builtin_nontemporal_store(v[j] * rstd * g, o4 + 64 * j); }
#pragma unroll
            for (int j = 0; j < 8; ++j) { ra[j] = na[j]; rb[j] = nb2[j]; rx[j] = nx[j]; }
        }
#undef P11_LOAD
    }
#undef IN
#undef SEAM
}


extern "C" void kernel_launch(void* const* d_in, const int* in_sizes, int n_in, void* d_out, int out_size, void* d_ws, size_t ws_size, hipStream_t stream) {
    static int grid = 0;
    if (!grid) {
        if (WS_NEW_END > ws_size || n_in != 24) { fprintf(stderr, "kernel_launch: workspace too small (%zu < %zu) or n_in %d != 24\n", ws_size, (size_t)WS_NEW_END, n_in); grid = -1; return; }
        (void)hipFuncSetAttribute((const void*)mk_fwd, hipFuncAttributeMaxDynamicSharedMemorySize, LDS_BYTES);
        int dev = 0, cus = 0, per_cu = 0; (void)hipGetDevice(&dev); (void)hipDeviceGetAttribute(&cus, hipDeviceAttributeMultiprocessorCount, dev);
        (void)hipOccupancyMaxActiveBlocksPerMultiprocessor(&per_cu, (const void*)mk_fwd, NWAVES * 64, LDS_BYTES);
        (void)hipGetLastError();
        grid = cus > 0 ? cus : 256;
        if (per_cu < 1) fprintf(stderr, "kernel_launch: occupancy query reports %d workgroups per CU\n", per_cu);
    }
    if (grid < 0) return;
    (void)hipMemsetAsync((char*)d_ws + WS_CTL, 0, CTL_ZERO_BYTES, stream);
    Args a{};
    for (int i = 0; i < 24; ++i) a.in[i] = (const float*)d_in[i];
    a.out = (float*)d_out; a.ws = (unsigned char*)d_ws; a.ph_lo = 0; a.ph_hi = 12;
#if defined(EXP_LO)
    a.ph_hi = EXP_HI + 1;
    hipLaunchKernelGGL(mk_fwd, dim3(grid), dim3(NWAVES * 64), LDS_BYTES, stream, a);
    (void)hipMemsetAsync((char*)d_ws + WS_CTL + CW_BAR * 4, 0, XCD_BAR_WORDS * 4, stream);
    if (EXP_LO <= 2 && 2 <= EXP_HI) (void)hipMemsetAsync((char*)d_ws + WS_CTL + CW_Q * 4, 0, 1024, stream);
    if (EXP_LO <= 5 && 5 <= EXP_HI) (void)hipMemsetAsync((char*)d_ws + WS_CTL + CW_ROWSQ1 * 4, 0, NTOK * 4, stream);
    if (EXP_LO <= 7 && 7 <= EXP_HI) (void)hipMemsetAsync((char*)d_ws + WS_CTL + CW_ROWSQ2 * 4, 0, NTOK * 4, stream);
    if (EXP_LO <= 8 && 8 <= EXP_HI) (void)hipMemsetAsync((char*)d_ws + WS_CTL + CW_CNT * 4, 0, NE * 256, stream);
    a.ph_lo = EXP_LO; a.ph_hi = 12;
#endif
    hipLaunchKernelGGL(mk_fwd, dim3(grid), dim3(NWAVES * 64), LDS_BYTES, stream, a);
}
```

```cpp
#include <hip/hip_runtime.h>
#include <cstdio>
#include <cstdint>

constexpr int D = 2048, BATCH = 4, SEQ = 2048, NTOK = BATCH * SEQ;
constexpr int MEM = 256, NMEM = BATCH * MEM;
constexpr int PROJ = 6160;
constexpr int C_QSB = 0, C_KSB = 1024, C_VSB = 2048, C_QG = 3072, C_KG = 3584, C_VG = 4096, C_ALR = 5120, C_RG = 5136;
constexpr int SBH = 8, SBD = 128, GH = 4, GDK = 128, GDV = 256, GRANK = 16, CHUNK = 64;
constexpr int XH = 4, XD = 512;
constexpr int NG = 8, EPG = 8, NE = 64, FF = 512, NPAIR = NTOK * 2;
constexpr float EPS = 1e-6f;

typedef short bf16x8 __attribute__((ext_vector_type(8)));
typedef float f32x4 __attribute__((ext_vector_type(4)));

__device__ __forceinline__ unsigned short f2bf(float f) { unsigned u = __float_as_uint(f); u += 0x7fffu + ((u >> 16) & 1u); return (unsigned short)(u >> 16); }

namespace pg8 {
#define PG8_LAS __attribute__((address_space(3)))
typedef unsigned short bf16_t;
typedef unsigned u32x4 __attribute__((ext_vector_type(4)));
typedef unsigned u32x2 __attribute__((ext_vector_type(2)));
constexpr int BM = 256, BK = 64, HALF = 128, HTB = HALF * BK * 2, STAGE_BYTES = 8 * HTB, NXCD = 8, WGM = 8;
__host__ __device__ __forceinline__ int lds_byte(int r, int c) { const int st = (r >> 4) * 2 + (c >> 5), rr = r & 15, cc = c & 31, ob = rr * 64 + cc * 2; return st * 1024 + (ob ^ (((ob >> 9) & 1) << 5)); }
__host__ __device__ __forceinline__ void stage_rc(int b, int& R, int& C) { const int st = b / 1024, sb = b % 1024, swz = sb ^ (((sb >> 9) & 1) << 5); R = (st >> 1) * 16 + swz / 64; C = (st & 1) * 32 + (swz % 64) / 2; }
__host__ __device__ __forceinline__ int perm32(int rho) { const int n = rho >> 4, i = rho & 15; return 8 * (i >> 2) + 4 * n + (i & 3); }
__device__ __forceinline__ unsigned cvt_pk_bf16(float lo, float hi) { unsigned r; asm volatile("v_cvt_pk_bf16_f32 %0, %1, %2" : "=v"(r) : "v"(lo), "v"(hi)); return r; }

struct Unit { const char* A; const char* B; int pm, pn, z, mv; };

__device__ __forceinline__ void tile_order(int L, int nM, int nN, int& pm, int& pn) {
    const int nwg = nM * nN; int wgid = L;
    { const int q = nwg / NXCD, r = nwg % NXCD, xcd = wgid % NXCD, off = wgid / NXCD; wgid = (xcd < r ? xcd * (q + 1) : r * (q + 1) + (xcd - r) * q) + off; }
    const int nig = WGM * nN, gid = wgid / nig, fm = gid * WGM, gsz = (nM - fm) < WGM ? (nM - fm) : WGM;
    pm = fm + ((wgid % nig) % gsz); pn = (wgid % nig) / gsz;
}
struct DenseSched {
    const char* A; const char* Bt; unsigned lda, ldb; int K, nM, nN, G, c;
    __device__ __forceinline__ bool next(int i, Unit& u) const { const long L = (long)i * G + c; if (c < 0 || L >= (long)nM * nN) return false; int pm, pn; tile_order((int)L, nM, nN, pm, pn);
        u.pm = pm; u.pn = pn; u.z = 0; u.mv = 256; u.A = A + (size_t)pm * 256 * lda; u.B = Bt + (size_t)pn * 256 * ldb; return true; }
    __device__ __forceinline__ unsigned arow(const Unit&, int r) const { return (unsigned)r * lda; }
    __device__ __forceinline__ void a_ready(const Unit&) const {}
    __device__ __forceinline__ void done(const Unit&) const {}
};

struct ColTileSched {
    const char* A; const char* Bt; unsigned lda, ldb; int K, nM, pn, G, c;
    __device__ __forceinline__ bool next(int i, Unit& u) const { const long L = (long)i * G + c; if (c < 0 || L >= nM) return false;
        u.pm = (int)L; u.pn = pn; u.z = 0; u.mv = 256; u.A = A + (size_t)L * 256 * lda; u.B = Bt + (size_t)pn * 256 * ldb; return true; }
    __device__ __forceinline__ unsigned arow(const Unit&, int r) const { return (unsigned)r * lda; }
    __device__ __forceinline__ void a_ready(const Unit&) const {}
    __device__ __forceinline__ void done(const Unit&) const {}
};

template <class Epi, class Sched, bool ALIGN_EPI>
__device__ __forceinline__ void gemm_phase(PG8_LAS unsigned char* lds, const Sched& S, const Epi& E) {
    const int tid = threadIdx.x, wid = __builtin_amdgcn_readfirstlane(tid >> 6), lane = tid & 63, wr = wid >> 2, wc = wid & 3, fr = lane & 15, fq = lane >> 4;
    const int nt = S.K / BK;
    int R0, C0, R1, C1; stage_rc(tid * 16, R0, C0); stage_rc(tid * 16 + 8192, R1, C1);
    const int Rb0 = Epi::PERM ? ((R0 & ~31) + perm32(R0 & 31)) : R0, Rb1 = Epi::PERM ? ((R1 & ~31) + perm32(R1 & 31)) : R1;
    const unsigned ldb = S.ldb;
    const unsigned vB0 = (unsigned)Rb0 * ldb + (unsigned)C0 * 2u, vB1 = (unsigned)Rb1 * ldb + (unsigned)C1 * 2u;
    const size_t kstep = (size_t)(BK * 2);
    const size_t hstepB = (size_t)HALF * ldb;
    const unsigned ldsw = (unsigned)wid * 1024u;
    const int aoff = lds_byte(wr * 64 + fr, fq * 8), boff = lds_byte(wc * 32 + fr, fq * 8);
#define PG8_SA(b, h) (((b) * 2 + (h)) * HTB)
#define PG8_SB(b, h) ((4 + (b) * 2 + (h)) * HTB)
#define PG8_STG(bufoff, gbase, v0, v1) do { \
        __builtin_amdgcn_global_load_lds((const unsigned*)((const char*)(gbase) + (v0)), (PG8_LAS unsigned*)(lds + (bufoff) + ldsw), 16, 0, 0); \
        __builtin_amdgcn_global_load_lds((const unsigned*)((const char*)(gbase) + (v1)), (PG8_LAS unsigned*)(lds + (bufoff) + ldsw + 8192), 16, 0, 0); } while (0)
#define PG8_STGB(bufoff, gbase) PG8_STG(bufoff, gbase, vB0, vB1)
#define PG8_LDA(dst, b, h) do { _Pragma("unroll") for (int m = 0; m < 4; ++m) _Pragma("unroll") for (int k = 0; k < 2; ++k) dst[m][k] = *(const PG8_LAS bf16x8*)(lds + PG8_SA(b, h) + aoff + m * 2048 + k * 1024); } while (0)
#define PG8_LDB(dst, b, h) do { _Pragma("unroll") for (int n = 0; n < 2; ++n) _Pragma("unroll") for (int k = 0; k < 2; ++k) dst[n][k] = *(const PG8_LAS bf16x8*)(lds + PG8_SB(b, h) + boff + n * 2048 + k * 1024); } while (0)
#define PG8_MMA(ai, bj, At, Bt) do { __builtin_amdgcn_s_setprio(1); _Pragma("unroll") for (int m = 0; m < 4; ++m) _Pragma("unroll") for (int n = 0; n < 2; ++n) _Pragma("unroll") for (int k = 0; k < 2; ++k) \
        acc[ai][bj][m][n] = __builtin_amdgcn_mfma_f32_16x16x32_bf16(Bt[n][k], At[m][k], acc[ai][bj][m][n], 0, 0, 0); __builtin_amdgcn_s_setprio(0); } while (0)
#define PG8_WAIT_V(n) asm volatile("s_waitcnt vmcnt(" #n ")" ::: "memory")
#define PG8_WAIT_L(n) asm volatile("s_waitcnt lgkmcnt(" #n ")" ::: "memory")
#define PG8_BAR __builtin_amdgcn_s_barrier()
#define PG8_SCHED __builtin_amdgcn_sched_barrier(0)
#define PG8_OFFS(u, o00, o01, o10, o11) do { o00 = S.arow(u, R0) + (unsigned)C0 * 2u; o01 = S.arow(u, R1) + (unsigned)C1 * 2u; o10 = S.arow(u, HALF + R0) + (unsigned)C0 * 2u; o11 = S.arow(u, HALF + R1) + (unsigned)C1 * 2u; } while (0)
    Unit cur, nxt; int ui = 0;
    if (!S.next(0, cur)) return;
    f32x4 acc[2][2][4][2];
#pragma unroll
    for (int a = 0; a < 2; ++a)
#pragma unroll
        for (int b = 0; b < 2; ++b)
#pragma unroll
            for (int m = 0; m < 4; ++m)
#pragma unroll
                for (int n = 0; n < 2; ++n) acc[a][b][m][n] = (f32x4){0.f, 0.f, 0.f, 0.f};
    bf16x8 At[4][2], B0[2][2], B1[2][2];
    const char* cA = cur.A; const char* cB = cur.B;
    unsigned c00, c01, c10, c11; PG8_OFFS(cur, c00, c01, c10, c11);
    S.a_ready(cur);
    PG8_STGB(PG8_SB(0, 0), cB); PG8_STGB(PG8_SB(0, 1), cB + hstepB); PG8_STG(PG8_SA(0, 0), cA, c00, c01); PG8_STG(PG8_SA(0, 1), cA, c10, c11);
    if (wr == 1) PG8_BAR;
    PG8_WAIT_V(2); PG8_BAR;
    PG8_STGB(PG8_SB(1, 0), cB + kstep); PG8_STG(PG8_SA(1, 0), cA + kstep, c00, c01); PG8_STGB(PG8_SB(1, 1), cB + hstepB + kstep);
    PG8_WAIT_V(6); PG8_BAR;
    for (;;) {
        const bool has_next = S.next(ui + 1, nxt);
        const char* nA = has_next ? nxt.A : cA; const char* nB = has_next ? nxt.B : cB;
        unsigned n00 = c00, n01 = c01, n10 = c10, n11 = c11;
        if (has_next) PG8_OFFS(nxt, n00, n01, n10, n11);
        for (int t = 0; t < nt; t += 2) {
            const bool last = (t == nt - 2);
            const char* a1 = cA + (size_t)(t + 1) * kstep;
            const char* a2 = last ? nA : cA + (size_t)(t + 2) * kstep; const char* b2 = last ? nB : cB + (size_t)(t + 2) * kstep;
            const char* a3 = a2 + kstep; const char* b3 = b2 + kstep;
            const unsigned x00 = last ? n00 : c00, x01 = last ? n01 : c01, x10 = last ? n10 : c10, x11 = last ? n11 : c11;
            if (last && has_next) S.a_ready(nxt);
            PG8_LDB(B0, 0, 0); PG8_LDB(B1, 0, 1); PG8_SCHED; PG8_LDA(At, 0, 0); PG8_STG(PG8_SA(1, 1), a1, c10, c11);
            PG8_WAIT_V(8); PG8_WAIT_L(0); PG8_BAR; PG8_MMA(0, 0, At, B0); PG8_MMA(0, 1, At, B1); PG8_BAR; PG8_SCHED;
            PG8_LDA(At, 0, 1); PG8_STGB(PG8_SB(0, 0), b2); PG8_STGB(PG8_SB(0, 1), b2 + hstepB); PG8_STG(PG8_SA(0, 0), a2, x00, x01);
            PG8_WAIT_V(8); PG8_WAIT_L(0); PG8_BAR; PG8_MMA(1, 0, At, B0); PG8_MMA(1, 1, At, B1); PG8_BAR; PG8_SCHED;
            PG8_LDB(B0, 1, 0); PG8_LDB(B1, 1, 1); PG8_SCHED; PG8_LDA(At, 1, 0); PG8_STG(PG8_SA(0, 1), a2, x10, x11);
            PG8_WAIT_V(8); PG8_WAIT_L(0); PG8_BAR; PG8_MMA(0, 0, At, B0); PG8_MMA(0, 1, At, B1); PG8_BAR; PG8_SCHED;
            PG8_LDA(At, 1, 1); PG8_STGB(PG8_SB(1, 0), b3); PG8_STGB(PG8_SB(1, 1), b3 + hstepB); PG8_STG(PG8_SA(1, 0), a3, x00, x01);
            PG8_WAIT_V(8); PG8_WAIT_L(0); PG8_BAR; PG8_MMA(1, 0, At, B0); PG8_MMA(1, 1, At, B1); PG8_BAR; PG8_SCHED;
        }
        if constexpr (ALIGN_EPI) { if (wr == 0) PG8_BAR; }
        if constexpr (!Epi::AFTER_DRAIN) { E(acc, cur, wr, wc, fr, fq); S.done(cur); }
        if (!has_next) break;
#pragma unroll
        for (int a = 0; a < 2; ++a)
#pragma unroll
            for (int b = 0; b < 2; ++b)
#pragma unroll
                for (int m = 0; m < 4; ++m)
#pragma unroll
                    for (int n = 0; n < 2; ++n) acc[a][b][m][n] = (f32x4){0.f, 0.f, 0.f, 0.f};
        cur = nxt; cA = nA; cB = nB; c00 = n00; c01 = n01; c10 = n10; c11 = n11; ++ui;
        if constexpr (ALIGN_EPI) { if (wr == 1) PG8_BAR; }
    }
    PG8_WAIT_V(0);
    if constexpr (!ALIGN_EPI) { if (wr == 0) PG8_BAR; }
    PG8_BAR;
    if constexpr (Epi::AFTER_DRAIN) { E.fused(acc, cur, wr, wc, fr, fq, lds, wid, lane); S.done(cur); }
#undef PG8_SA
#undef PG8_SB
#undef PG8_STG
#undef PG8_STGB
#undef PG8_LDA
#undef PG8_LDB
#undef PG8_MMA
#undef PG8_WAIT_V
#undef PG8_WAIT_L
#undef PG8_BAR
#undef PG8_SCHED
#undef PG8_OFFS
}

template <class Epi>
__device__ __forceinline__ void gemm128_unit(PG8_LAS unsigned char* lds, const char* A, unsigned lda, const char* B, unsigned ldb, int K, const Epi& E, const Unit& u) {
    const int tid = threadIdx.x, wid = __builtin_amdgcn_readfirstlane(tid >> 6), lane = tid & 63, wr = wid >> 2, wc = wid & 3, fr = lane & 15, fq = lane >> 4;
    const int nt = K / BK;
    int R0, C0, R1, C1; stage_rc(tid * 16, R0, C0); stage_rc(tid * 16 + 8192, R1, C1);
    const int Rb0 = (R0 & ~31) + perm32(R0 & 31), Rb1 = (R1 & ~31) + perm32(R1 & 31);
    const unsigned vB0 = (unsigned)Rb0 * ldb + (unsigned)C0 * 2u, vB1 = (unsigned)Rb1 * ldb + (unsigned)C1 * 2u, vA0 = (unsigned)R0 * lda + (unsigned)C0 * 2u, vA1 = (unsigned)R1 * lda + (unsigned)C1 * 2u;
    const size_t hstepB = (size_t)HALF * ldb;
    const unsigned ldsw = (unsigned)wid * 1024u;
    const int aoff = lds_byte(wr * 64 + fr, fq * 8), boff = lds_byte(wc * 32 + fr, fq * 8);
    constexpr int STG3 = 3 * HTB;
#define G8_STG(off, gbase, v0, v1) do { \
        __builtin_amdgcn_global_load_lds((const unsigned*)((const char*)(gbase) + (v0)), (PG8_LAS unsigned*)(lds + (off) + ldsw), 16, 0, 0); \
        __builtin_amdgcn_global_load_lds((const unsigned*)((const char*)(gbase) + (v1)), (PG8_LAS unsigned*)(lds + (off) + ldsw + 8192), 16, 0, 0); } while (0)
#define G8_TILE(so, kt) do { const char* bb_ = B + (size_t)(kt) * (BK * 2); const char* aa_ = A + (size_t)(kt) * (BK * 2); \
        G8_STG((so), bb_, vB0, vB1); G8_STG((so) + HTB, bb_ + hstepB, vB0, vB1); G8_STG((so) + 2 * HTB, aa_, vA0, vA1); } while (0)
#define G8_MMA(bj, Bt) do { __builtin_amdgcn_s_setprio(1); _Pragma("unroll") for (int m = 0; m < 4; ++m) _Pragma("unroll") for (int n = 0; n < 2; ++n) _Pragma("unroll") for (int k = 0; k < 2; ++k) \
        acc[bj][m][n] = __builtin_amdgcn_mfma_f32_16x16x32_bf16(Bt[n][k], At[m][k], acc[bj][m][n], 0, 0, 0); __builtin_amdgcn_s_setprio(0); } while (0)
    f32x4 acc[2][4][2];
#pragma unroll
    for (int b = 0; b < 2; ++b)
#pragma unroll
        for (int m = 0; m < 4; ++m)
#pragma unroll
            for (int n = 0; n < 2; ++n) acc[b][m][n] = (f32x4){0.f, 0.f, 0.f, 0.f};
    bf16x8 At[4][2], B0[2][2], B1[2][2];
    typename Epi::Pre pre; E.prefetch(pre, u, wr, wc, fr, fq);
    G8_TILE(0, 0); G8_TILE(STG3, 1);
    asm volatile("s_waitcnt vmcnt(6)" ::: "memory"); __builtin_amdgcn_s_barrier();
    if (wr == 1) __builtin_amdgcn_s_barrier();
    int so = 0;
    for (int t = 0; t < nt; ++t) {
        const int s2 = (so >= STG3) ? so - STG3 : so + 2 * STG3;
        const int kt2 = (t + 2 < nt) ? t + 2 : 0;
        G8_TILE(s2, kt2);
#pragma unroll
        for (int n = 0; n < 2; ++n)
#pragma unroll
            for (int k = 0; k < 2; ++k) { B0[n][k] = *(const PG8_LAS bf16x8*)(lds + so + boff + n * 2048 + k * 1024); B1[n][k] = *(const PG8_LAS bf16x8*)(lds + so + HTB + boff + n * 2048 + k * 1024); }
#pragma unroll
        for (int m = 0; m < 4; ++m)
#pragma unroll
            for (int k = 0; k < 2; ++k) At[m][k] = *(const PG8_LAS bf16x8*)(lds + so + 2 * HTB + aoff + m * 2048 + k * 1024);
        asm volatile("s_waitcnt vmcnt(6)" ::: "memory"); asm volatile("s_waitcnt lgkmcnt(0)" ::: "memory"); __builtin_amdgcn_s_barrier();
        G8_MMA(0, B0); G8_MMA(1, B1);
        __builtin_amdgcn_s_barrier(); __builtin_amdgcn_sched_barrier(0);
        so = (so == 2 * STG3) ? 0 : so + STG3;
    }
    if (wr == 0) __builtin_amdgcn_s_barrier();
    E(acc, u, wr, wc, fr, fq, pre);
    asm volatile("s_waitcnt vmcnt(0)" ::: "memory"); __builtin_amdgcn_s_barrier();
#undef G8_STG
#undef G8_TILE
#undef G8_MMA
}
}

#define LAS __attribute__((address_space(3)))
typedef unsigned short bf16;
typedef unsigned v4u __attribute__((ext_vector_type(4)));
typedef unsigned v2u __attribute__((ext_vector_type(2)));
#define RLX_AGENT __ATOMIC_RELAXED, __HIP_MEMORY_SCOPE_AGENT
#define LDS_WAIT() asm volatile("s_waitcnt lgkmcnt(0)" ::: "memory")
#define VM_WAIT() asm volatile("s_waitcnt vmcnt(0)" ::: "memory")
__device__ __forceinline__ unsigned pk2(float lo, float hi) { return (unsigned)f2bf(lo) | ((unsigned)f2bf(hi) << 16); }
__device__ __forceinline__ float bf2f(unsigned short b) { return __uint_as_float(((unsigned)b) << 16); }

#define XB_TMO      128
#define XB_XCNT(j)  (256  + 64 * (j))
#define XB_XSUB(j)  (1280 + 64 * (j))
#define XB_XGEN(j)  (2304 + 64 * (j))
#define XB_TOP      3328
#define XB_TOPGEN   3392
#define XCD_BAR_WORDS 3456
#define XB_SPIN_CAP (1u << 18)
__device__ __forceinline__ unsigned xb_ld(unsigned* p)              { return __hip_atomic_load(p, __ATOMIC_RELAXED, __HIP_MEMORY_SCOPE_AGENT); }
__device__ __forceinline__ unsigned xb_add(unsigned* p, unsigned v) { return __hip_atomic_fetch_add(p, v, __ATOMIC_RELAXED, __HIP_MEMORY_SCOPE_AGENT); }
__device__ __forceinline__ unsigned xb_xcc_id() { return (unsigned)__builtin_amdgcn_s_getreg((3 << 11) | 20) & 0xFu; }
#define XB_SPIN(cond, bar) do { unsigned _sp = 0; while (cond) { __builtin_amdgcn_s_sleep(1); \
    if ((++_sp & 255u) == 0u) { if (xb_ld(&(bar)[XB_TMO])) break; if (_sp > XB_SPIN_CAP) { atomicAdd(&(bar)[XB_TMO], 1u); break; } } } } while (0)
struct XcdBarrier { unsigned* bar; unsigned x; volatile LAS unsigned* st; };
__device__ __forceinline__ XcdBarrier xcd_barrier_post(unsigned* bar, volatile LAS unsigned* st) {
    XcdBarrier b; b.bar = bar; b.x = xb_xcc_id(); b.st = st;
    if (threadIdx.x == 0) (void)xb_add(&bar[XB_XCNT(b.x)], 1u);
    return b;
}
__device__ __forceinline__ void xcd_barrier_complete(unsigned* bar, unsigned x, unsigned& nloc, unsigned& nx) {
    const unsigned G = gridDim.x * gridDim.y * gridDim.z;
    unsigned sum, cnt, mine, sp = 0u;
    for (;;) {
        sum = 0u; cnt = 0u; mine = 0u;
#pragma unroll
        for (unsigned j = 0; j < 16; ++j) { const unsigned c = xb_ld(&bar[XB_XCNT(j)]); sum += c; cnt += (c > 0u) ? 1u : 0u; mine = (j == x) ? c : mine; }
        if (sum == G) break;
        __builtin_amdgcn_s_sleep(1);
        if ((++sp & 255u) == 0u) { if (xb_ld(&bar[XB_TMO])) break; if (sp > XB_SPIN_CAP) { atomicAdd(&bar[XB_TMO], 1u); break; } }
    }
    nloc = mine > 0u ? mine : 1u; nx = cnt > 0u ? cnt : 1u;
}
__device__ __forceinline__ void xcd_barrier(const XcdBarrier& b) {
    asm volatile("s_waitcnt vmcnt(0)" ::: "memory");
    __syncthreads();
    if (threadIdx.x == 0) {
        unsigned* bar = b.bar;
        __builtin_amdgcn_s_waitcnt(0);
        unsigned nloc = b.st[0], nx = b.st[1];
        if (nloc == 0u) { xcd_barrier_complete(bar, b.x, nloc, nx); b.st[0] = nloc; b.st[1] = nx; }
        const unsigned old = xb_add(&bar[XB_XSUB(b.x)], 1u);
        const unsigned gen = old / nloc;
        if (old + 1u == (gen + 1u) * nloc) {
            __builtin_amdgcn_fence(__ATOMIC_RELEASE, "agent");
            asm volatile("s_waitcnt vmcnt(0)" ::: "memory");
            const unsigned og = xb_add(&bar[XB_TOP], 1u);
            const unsigned tg = og / nx;
            if (og + 1u == (tg + 1u) * nx) xb_add(&bar[XB_TOPGEN], 1u);
            else XB_SPIN(xb_ld(&bar[XB_TOPGEN]) == tg, bar);
            __builtin_amdgcn_fence(__ATOMIC_ACQUIRE, "agent");
            xb_add(&bar[XB_XGEN(b.x)], 1u);
            asm volatile("s_waitcnt vmcnt(0)" ::: "memory");
        } else {
            XB_SPIN(xb_ld(&bar[XB_XGEN(b.x)]) == gen, bar);
            __builtin_amdgcn_fence(__ATOMIC_ACQUIRE, "agent");
            asm volatile("s_waitcnt vmcnt(0)" ::: "memory");
        }
    }
    __syncthreads();
}

template <class PF>
__device__ __forceinline__ void xcd_barrier_pf(const XcdBarrier& b, const PF& pf) {
    asm volatile("s_waitcnt vmcnt(0)" ::: "memory");
    __syncthreads();
    if (threadIdx.x >= 64) pf();
    if (threadIdx.x == 0) {
        unsigned* bar = b.bar;
        __builtin_amdgcn_s_waitcnt(0);
        unsigned nloc = b.st[0], nx = b.st[1];
        if (nloc == 0u) { xcd_barrier_complete(bar, b.x, nloc, nx); b.st[0] = nloc; b.st[1] = nx; }
        const unsigned old = xb_add(&bar[XB_XSUB(b.x)], 1u);
        const unsigned gen = old / nloc;
        if (old + 1u == (gen + 1u) * nloc) {
            __builtin_amdgcn_fence(__ATOMIC_RELEASE, "agent");
            asm volatile("s_waitcnt vmcnt(0)" ::: "memory");
            const unsigned og = xb_add(&bar[XB_TOP], 1u);
            const unsigned tg = og / nx;
            if (og + 1u == (tg + 1u) * nx) xb_add(&bar[XB_TOPGEN], 1u);
            else XB_SPIN(xb_ld(&bar[XB_TOPGEN]) == tg, bar);
            __builtin_amdgcn_fence(__ATOMIC_ACQUIRE, "agent");
            xb_add(&bar[XB_XGEN(b.x)], 1u);
            asm volatile("s_waitcnt vmcnt(0)" ::: "memory");
        } else {
            XB_SPIN(xb_ld(&bar[XB_XGEN(b.x)]) == gen, bar);
            __builtin_amdgcn_fence(__ATOMIC_ACQUIRE, "agent");
            asm volatile("s_waitcnt vmcnt(0)" ::: "memory");
        }
    }
    if (threadIdx.x < 64) pf();
    __syncthreads();
}

constexpr size_t MiB = 1u << 20;
constexpr int PROJP = 6400;
constexpr size_t WS_CTL = 0, CTL_ZERO_BYTES = 1 * MiB;
constexpr int CW_BAR = 4096;
constexpr int CW_CNT = 16384;
constexpr int CW_Q = 24576;
constexpr int CW_ROWSQ1 = 32768, CW_ROWSQ2 = 32768 + 8192;
constexpr size_t WS_WIN = 2 * MiB;
constexpr size_t WS_WOUT = 28 * MiB;
constexpr size_t WS_WXQ = 36 * MiB;
constexpr size_t WS_WXKV = 44 * MiB;
constexpr size_t WS_WXO = 60 * MiB;
constexpr size_t WS_H0 = 68 * MiB;
constexpr size_t WS_HM = 100 * MiB;
constexpr size_t WS_PROJ = 104 * MiB;
constexpr size_t WS_ALR = 204 * MiB;
constexpr size_t WS_KV = 205 * MiB;
constexpr size_t WS_CAT = 214 * MiB;
constexpr size_t WS_X1 = 246 * MiB;
constexpr size_t WS_X1B = 310 * MiB;
constexpr size_t WS_QX = 342 * MiB;
constexpr size_t WS_OX = 374 * MiB;
constexpr size_t WS_X2 = 406 * MiB;
constexpr size_t WS_GU = WS_X1;
constexpr size_t WS_GS = WS_X1B;
constexpr size_t WS_GQD = WS_QX;
constexpr size_t WS_GKI = WS_QX + 8 * MiB;
constexpr size_t WS_GEL = WS_QX + 16 * MiB;
constexpr size_t WS_PB = WS_H0;
constexpr size_t WS_HF = 854 * MiB;
constexpr size_t WS_HB = 886 * MiB;
constexpr size_t WS_YB = 902 * MiB;
constexpr size_t WS_WR = 966 * MiB;
constexpr size_t WS_LIST = 967 * MiB;
constexpr size_t WS_GATE = 969 * MiB;
constexpr size_t WS_MKT = WS_OX;
constexpr size_t WS_NVT = WS_OX + 16 * MiB;
constexpr size_t WS_NEW_END = 970 * MiB;

constexpr int RING_OFF = 0, RING_BYTES = 147456;
constexpr int LDSCTL_OFF = RING_BYTES, MISC_OFF = LDSCTL_OFF + 320;
constexpr int LDS_BYTES = 163840;
constexpr int NWAVES = 8;

struct Frame {
    LAS unsigned char* lds; volatile LAS unsigned* MISC; unsigned* ctl;
    int tid, lane, wave, G, vcu;
    unsigned char* ws;
};

__device__ __forceinline__ void p0_transpose_item(const float* W, int K, int ldw, int ncols, const float* gain, bf16* WT, int row_off, LAS float* scr, int item, int lane) {
    const int nblk = (ncols + 63) / 64, kb = item / nblk, nb = item % nblk, k0 = 64 * kb, n0 = 64 * nb;
    const int lk = lane >> 4, ln = (lane & 15) * 4; const bool ok = (n0 + ln) < ncols;
    f32x4 v[16];
#pragma unroll
    for (int i = 0; i < 16; ++i) v[i] = ok ? __builtin_nontemporal_load((const f32x4*)(W + (size_t)(k0 + 4 * i + lk) * ldw + n0 + ln)) : (f32x4){0.f, 0.f, 0.f, 0.f};
#pragma unroll
    for (int i = 0; i < 16; ++i) { const int kk = 4 * i + lk; const float g = gain ? gain[k0 + kk] : 1.0f; LAS float* d = scr + kk * 65 + ln; d[0] = v[i][0] * g; d[1] = v[i][1] * g; d[2] = v[i][2] * g; d[3] = v[i][3] * g; }
    LDS_WAIT(); asm volatile("" ::: "memory");
    const int c = lane & 7;
#pragma unroll
    for (int j = 0; j < 8; ++j) { const int n = (lane >> 3) + 8 * j; const LAS float* sp = scr + (8 * c) * 65 + n;
        v4u o; o.x = pk2(sp[0 * 65], sp[1 * 65]); o.y = pk2(sp[2 * 65], sp[3 * 65]); o.z = pk2(sp[4 * 65], sp[5 * 65]); o.w = pk2(sp[6 * 65], sp[7 * 65]);
        *(v4u*)(WT + (size_t)(row_off + n0 + n) * K + k0 + 8 * c) = o; }
    LDS_WAIT(); asm volatile("" ::: "memory");
}
__device__ __forceinline__ float wave_sum(float v) {
#pragma unroll
    for (int o = 1; o < 64; o <<= 1) v += __shfl_xor(v, o);
    return v;
}
__device__ __forceinline__ void rms_row_to_bf16(const float* xrow, const float* gain, bf16* orow, int lane) {
    const f32x4* xr = (const f32x4*)xrow + lane; const f32x4* gr = (const f32x4*)gain + lane;
    f32x4 v[8]; float s = 0.f;
#pragma unroll
    for (int j = 0; j < 8; ++j) { v[j] = __builtin_nontemporal_load(xr + 64 * j); s += (v[j].x * v[j].x + v[j].y * v[j].y) + (v[j].z * v[j].z + v[j].w * v[j].w); }
    const float rstd = rsqrtf(wave_sum(s) * (1.f / D) + EPS);
    unsigned long long* o8 = (unsigned long long*)orow + lane;
#pragma unroll
    for (int j = 0; j < 8; ++j) { const f32x4 g = gr[64 * j]; o8[64 * j] = (unsigned long long)pk2(v[j].x * rstd * g.x, v[j].y * rstd * g.y) | ((unsigned long long)pk2(v[j].z * rstd * g.z, v[j].w * rstd * g.w) << 32); }
}

struct EpiBf16 {
    static constexpr bool PERM = true, AFTER_DRAIN = false;
    bf16* O; int ldc;
    __device__ __forceinline__ void operator()(const f32x4 (&acc)[2][2][4][2], const pg8::Unit& u, int wr, int wc, int fr, int fq) const {
        const int row0 = u.pm * 256 + wr * 64 + fr, col0 = u.pn * 256 + wc * 32 + 8 * fq;
#pragma unroll
        for (int ai = 0; ai < 2; ++ai)
#pragma unroll
            for (int m = 0; m < 4; ++m) { bf16* rowp = O + (size_t)(row0 + ai * 128 + m * 16) * ldc + col0;
#pragma unroll
                for (int bj = 0; bj < 2; ++bj) { const f32x4 v0 = acc[ai][bj][m][0], v1 = acc[ai][bj][m][1];
                    v4u w; w.x = pg8::cvt_pk_bf16(v0[0], v0[1]); w.y = pg8::cvt_pk_bf16(v0[2], v0[3]); w.z = pg8::cvt_pk_bf16(v1[0], v1[1]); w.w = pg8::cvt_pk_bf16(v1[2], v1[3]);
                    *(v4u*)(rowp + bj * 128) = w; } }
    }
};
struct EpiProj {
    static constexpr bool PERM = true, AFTER_DRAIN = false;
    bf16* O; float* alr;
    __device__ __forceinline__ void operator()(const f32x4 (&acc)[2][2][4][2], const pg8::Unit& u, int wr, int wc, int fr, int fq) const {
        const int row0 = u.pm * 256 + wr * 64 + fr, col0 = u.pn * 256 + wc * 32 + 8 * fq;
#pragma unroll
        for (int ai = 0; ai < 2; ++ai)
#pragma unroll
            for (int m = 0; m < 4; ++m) { const int row = row0 + ai * 128 + m * 16; bf16* rowp = O + (size_t)row * PROJP + col0;
#pragma unroll
                for (int bj = 0; bj < 2; ++bj) { const f32x4 v0 = acc[ai][bj][m][0], v1 = acc[ai][bj][m][1];
                    v4u w; w.x = pg8::cvt_pk_bf16(v0[0], v0[1]); w.y = pg8::cvt_pk_bf16(v0[2], v0[3]); w.z = pg8::cvt_pk_bf16(v1[0], v1[1]); w.w = pg8::cvt_pk_bf16(v1[2], v1[3]);
                    *(v4u*)(rowp + bj * 128) = w; }
                if (u.pn == C_ALR / 256 && wc == 0 && fq < 2) { float* ap = alr + (size_t)row * GRANK + 8 * fq; *(f32x4*)ap = acc[ai][0][m][0]; *(f32x4*)(ap + 4) = acc[ai][0][m][1]; } }
    }
};

struct EpiResid {
    static constexpr bool PERM = true, AFTER_DRAIN = false;
    const float* R; const bf16* Rb; float* O; bf16* Ob; float* rowsq;
    __device__ __forceinline__ void operator()(const f32x4 (&acc)[2][2][4][2], const pg8::Unit& u, int wr, int wc, int fr, int fq) const {
        const int row0 = u.pm * 256 + wr * 64 + fr, col0 = u.pn * 256 + wc * 32 + 8 * fq;
#pragma unroll
        for (int ai = 0; ai < 2; ++ai) {
            f32x4 rr[4][2][2];
#pragma unroll
            for (int m = 0; m < 4; ++m) { const size_t off = (size_t)(row0 + ai * 128 + m * 16) * D + col0;
#pragma unroll
                for (int bj = 0; bj < 2; ++bj) {
                    if (R) { rr[m][bj][0] = __builtin_nontemporal_load((const f32x4*)(R + off + bj * 128)); rr[m][bj][1] = __builtin_nontemporal_load((const f32x4*)(R + off + bj * 128 + 4)); }
                    else { const v4u rb = *(const v4u*)(Rb + off + bj * 128); rr[m][bj][0] = (f32x4){__uint_as_float(rb.x << 16), __uint_as_float(rb.x & 0xffff0000u), __uint_as_float(rb.y << 16), __uint_as_float(rb.y & 0xffff0000u)};
                        rr[m][bj][1] = (f32x4){__uint_as_float(rb.z << 16), __uint_as_float(rb.z & 0xffff0000u), __uint_as_float(rb.w << 16), __uint_as_float(rb.w & 0xffff0000u)}; } } }
#pragma unroll
            for (int m = 0; m < 4; ++m) { const int row = row0 + ai * 128 + m * 16; const size_t off = (size_t)row * D + col0; float ss = 0.f;
#pragma unroll
                for (int bj = 0; bj < 2; ++bj) { const f32x4 v0 = acc[ai][bj][m][0] + rr[m][bj][0], v1 = acc[ai][bj][m][1] + rr[m][bj][1];
                    if (O) { *(f32x4*)(O + off + bj * 128) = v0; *(f32x4*)(O + off + bj * 128 + 4) = v1; }
                    ss += (v0[0] * v0[0] + v0[1] * v0[1]) + (v0[2] * v0[2] + v0[3] * v0[3]) + (v1[0] * v1[0] + v1[1] * v1[1]) + (v1[2] * v1[2] + v1[3] * v1[3]);
                    if (Ob) { v4u w; w.x = pg8::cvt_pk_bf16(v0[0], v0[1]); w.y = pg8::cvt_pk_bf16(v0[2], v0[3]); w.z = pg8::cvt_pk_bf16(v1[0], v1[1]); w.w = pg8::cvt_pk_bf16(v1[2], v1[3]);
                        *(v4u*)(Ob + off + bj * 128) = w; } }
                ss += __shfl_xor(ss, 16); ss += __shfl_xor(ss, 32);
                if (fq == 0) atomicAdd(rowsq + row, ss); }
            asm volatile("" ::: "memory"); }
    }
};
struct EpiRowScaleBf16 {
    static constexpr bool PERM = true, AFTER_DRAIN = false;
    bf16* O; const float* rowsq;
    __device__ __forceinline__ void operator()(const f32x4 (&acc)[2][2][4][2], const pg8::Unit& u, int wr, int wc, int fr, int fq) const {
        const int row0 = u.pm * 256 + wr * 64 + fr, col0 = u.pn * 256 + wc * 32 + 8 * fq;
#pragma unroll
        for (int ai = 0; ai < 2; ++ai)
#pragma unroll
            for (int m = 0; m < 4; ++m) { const int row = row0 + ai * 128 + m * 16; const float rs = rsqrtf(rowsq[row] * (1.0f / D) + EPS); bf16* rowp = O + (size_t)row * D + col0;
#pragma unroll
                for (int bj = 0; bj < 2; ++bj) { const f32x4 v0 = acc[ai][bj][m][0] * rs, v1 = acc[ai][bj][m][1] * rs;
                    v4u w; w.x = pg8::cvt_pk_bf16(v0[0], v0[1]); w.y = pg8::cvt_pk_bf16(v0[2], v0[3]); w.z = pg8::cvt_pk_bf16(v1[0], v1[1]); w.w = pg8::cvt_pk_bf16(v1[2], v1[3]);
                    *(v4u*)(rowp + bj * 128) = w; } }
    }
};

typedef __bf16 bf16x2_t __attribute__((ext_vector_type(2)));
typedef float f32x2_t __attribute__((ext_vector_type(2)));
typedef float f32x16 __attribute__((ext_vector_type(16)));
typedef short s16x4 __attribute__((ext_vector_type(4)));
__device__ __forceinline__ unsigned pkbf(float a, float b) { f32x2_t f = {a, b}; bf16x2_t h = __builtin_convertvector(f, bf16x2_t); return __builtin_bit_cast(unsigned, h); }
__device__ __forceinline__ unsigned offb(unsigned row, unsigned ch) { return 256u * row + 16u * (ch ^ (((row & 3u) << 2) | ((row >> 2) & 3u))); }
__device__ __forceinline__ void tr_read8(unsigned a0, unsigned a1, unsigned a2, unsigned a3, unsigned a4, unsigned a5, unsigned a6, unsigned a7,
                                         s16x4& r0, s16x4& r1, s16x4& r2, s16x4& r3, s16x4& r4, s16x4& r5, s16x4& r6, s16x4& r7) {
    asm volatile("ds_read_b64_tr_b16 %0, %8\n\tds_read_b64_tr_b16 %1, %9\n\tds_read_b64_tr_b16 %2, %10\n\tds_read_b64_tr_b16 %3, %11\n\t"
                 "ds_read_b64_tr_b16 %4, %12\n\tds_read_b64_tr_b16 %5, %13\n\tds_read_b64_tr_b16 %6, %14\n\tds_read_b64_tr_b16 %7, %15\n\ts_waitcnt lgkmcnt(0)"
                 : "=&v"(r0), "=&v"(r1), "=&v"(r2), "=&v"(r3), "=&v"(r4), "=&v"(r5), "=&v"(r6), "=&v"(r7)
                 : "v"(a0), "v"(a1), "v"(a2), "v"(a3), "v"(a4), "v"(a5), "v"(a6), "v"(a7) : "memory");
}
__device__ __forceinline__ void sb_wave_unit(LAS unsigned char* wl, const bf16* __restrict__ proj, const float* __restrict__ gain, bf16* __restrict__ cat, int b, int hd, int qi, int lane) {
    const int r = lane & 31, h = lane >> 5, t = 32 * qi + r;
    const size_t rowq = (size_t)(b * SEQ + t) * PROJP;
    bf16x8 Bq[8];
#pragma unroll
    for (int ks = 0; ks < 8; ++ks) Bq[ks] = *(const bf16x8*)(proj + rowq + C_QSB + hd * SBD + 16 * ks + 8 * h);
    f32x16 O[4];
#pragma unroll
    for (int db = 0; db < 4; ++db)
#pragma unroll
        for (int i = 0; i < 16; ++i) O[db][i] = 0.f;
    float R = 1.0f;
    const unsigned lbase = (unsigned)(size_t)wl;
    const int srow = lane >> 4, sch = lane & 15;
    v4u sreg[8];
    { const bf16* src = proj + (size_t)(b * SEQ + 32 * qi + srow) * PROJP + hd * SBD + sch * 8 + C_KSB;
#pragma unroll
      for (int i = 0; i < 8; ++i) sreg[i] = *(const v4u*)(src + (size_t)(4 * i) * PROJP); }
    const unsigned blk = (lane >> 4) & 1, q4 = (lane & 15) >> 2, p4 = lane & 3;
    const float cexp = 0.08838834764831845f * 1.4426950408889634f;
    for (int kt = qi; kt >= 0; --kt) {
#pragma unroll
        for (int i = 0; i < 8; ++i) *(LAS v4u*)(wl + offb(4 * i + srow, sch)) = sreg[i];
        { const bf16* src = proj + (size_t)(b * SEQ + 32 * kt + srow) * PROJP + hd * SBD + sch * 8 + C_VSB;
#pragma unroll
          for (int i = 0; i < 8; ++i) sreg[i] = *(const v4u*)(src + (size_t)(4 * i) * PROJP); }
        asm volatile("s_waitcnt lgkmcnt(0)" ::: "memory");
        f32x16 S;
#pragma unroll
        for (int i = 0; i < 16; ++i) S[i] = 0.f;
#pragma unroll
        for (int ks = 0; ks < 8; ++ks) { const bf16x8 Kf = *(const LAS bf16x8*)(wl + offb(r, 2 * ks + h)); S = __builtin_amdgcn_mfma_f32_32x32x16_bf16(Kf, Bq[ks], S, 0, 0, 0); }
        float w[16], keep[16];
        const bool diag = (kt == qi);
#pragma unroll
        for (int i = 0; i < 16; ++i) { const int key = (i & 3) + 8 * (i >> 2) + 4 * h;
            const float e = __builtin_amdgcn_exp2f(fminf(S[i] * cexp, 115.f)); const float kp = __builtin_amdgcn_rcpf(1.f + e);
            const bool ok = !diag || key < r;
            keep[i] = ok ? kp : 1.f; w[i] = ok ? e * kp : 0.f; }
        float tot[4], oth[4], sf[16];
#pragma unroll
        for (int g = 0; g < 4; ++g) { sf[4 * g + 3] = 1.f; sf[4 * g + 2] = keep[4 * g + 3]; sf[4 * g + 1] = sf[4 * g + 2] * keep[4 * g + 2]; sf[4 * g] = sf[4 * g + 1] * keep[4 * g + 1]; tot[g] = sf[4 * g] * keep[4 * g]; }
#pragma unroll
        for (int g = 0; g < 4; ++g) oth[g] = __shfl_xor(tot[g], 32);
        float Cg[4]; Cg[3] = R; Cg[2] = Cg[3] * (tot[3] * oth[3]); Cg[1] = Cg[2] * (tot[2] * oth[2]); Cg[0] = Cg[1] * (tot[1] * oth[1]);
        R = Cg[0] * (tot[0] * oth[0]);
#pragma unroll
        for (int g = 0; g < 4; ++g) { const float E = h ? Cg[g] : Cg[g] * oth[g];
#pragma unroll
            for (int p = 0; p < 4; ++p) w[4 * g + p] = w[4 * g + p] * (sf[4 * g + p] * E); }
#pragma unroll
        for (int i = 0; i < 8; ++i) *(LAS v4u*)(wl + 8192 + offb(4 * i + srow, sch)) = sreg[i];
        if (kt > 0) { const bf16* src = proj + (size_t)(b * SEQ + 32 * (kt - 1) + srow) * PROJP + hd * SBD + sch * 8 + C_KSB;
#pragma unroll
            for (int i = 0; i < 8; ++i) sreg[i] = *(const v4u*)(src + (size_t)(4 * i) * PROJP); }
        asm volatile("s_waitcnt lgkmcnt(0)" ::: "memory");
#pragma unroll
        for (int s2 = 0; s2 < 2; ++s2) {
            v4u wp; wp.x = pkbf(w[8 * s2], w[8 * s2 + 1]); wp.y = pkbf(w[8 * s2 + 2], w[8 * s2 + 3]); wp.z = pkbf(w[8 * s2 + 4], w[8 * s2 + 5]); wp.w = pkbf(w[8 * s2 + 6], w[8 * s2 + 7]);
            const bf16x8 Wf = __builtin_bit_cast(bf16x8, wp);
            s16x4 v0a, v0b, v1a, v1b, v2a, v2b, v3a, v3b;
            const unsigned rb0 = 16 * s2 + 4 * h + q4, rb1 = rb0 + 8, cb = 2 * blk + (p4 >> 1), bo = lbase + 8192 + 8 * (p4 & 1);
            tr_read8(bo + offb(rb0, cb), bo + offb(rb1, cb), bo + offb(rb0, 4 + cb), bo + offb(rb1, 4 + cb), bo + offb(rb0, 8 + cb), bo + offb(rb1, 8 + cb), bo + offb(rb0, 12 + cb), bo + offb(rb1, 12 + cb),
                     v0a, v0b, v1a, v1b, v2a, v2b, v3a, v3b);
            O[0] = __builtin_amdgcn_mfma_f32_32x32x16_bf16(__builtin_shufflevector(v0a, v0b, 0, 1, 2, 3, 4, 5, 6, 7), Wf, O[0], 0, 0, 0);
            O[1] = __builtin_amdgcn_mfma_f32_32x32x16_bf16(__builtin_shufflevector(v1a, v1b, 0, 1, 2, 3, 4, 5, 6, 7), Wf, O[1], 0, 0, 0);
            O[2] = __builtin_amdgcn_mfma_f32_32x32x16_bf16(__builtin_shufflevector(v2a, v2b, 0, 1, 2, 3, 4, 5, 6, 7), Wf, O[2], 0, 0, 0);
            O[3] = __builtin_amdgcn_mfma_f32_32x32x16_bf16(__builtin_shufflevector(v3a, v3b, 0, 1, 2, 3, 4, 5, 6, 7), Wf, O[3], 0, 0, 0);
        }
        if (__all(R == 0.f)) break;
    }
    float ss = 0.f;
#pragma unroll
    for (int db = 0; db < 4; ++db)
#pragma unroll
        for (int i = 0; i < 16; ++i) ss += O[db][i] * O[db][i];
    ss += __shfl_xor(ss, 32);
    const float rs = rsqrtf(ss * (1.0f / SBD) + EPS);
    bf16* orow = cat + (size_t)(b * SEQ + t) * D + hd * SBD;
#pragma unroll
    for (int db = 0; db < 4; ++db)
#pragma unroll
        for (int g = 0; g < 4; ++g) { const int d = 32 * db + 8 * g + 4 * h; const f32x4 gv = *(const f32x4*)(gain + hd * SBD + d);
            v2u o; o.x = pkbf(O[db][4 * g] * rs * gv[0], O[db][4 * g + 1] * rs * gv[1]); o.y = pkbf(O[db][4 * g + 2] * rs * gv[2], O[db][4 * g + 3] * rs * gv[3]);
            *(v2u*)(orow + d) = o; }
}

__device__ __forceinline__ void sb_wg_unit(LAS unsigned char* sm0, const bf16* __restrict__ proj, const float* __restrict__ gain, bf16* __restrict__ cat, int item, int wave, int lane) {
    const int qg = (SEQ / 256 - 1) - item / (BATCH * SBH), bh = item % (BATCH * SBH), b = bh / SBH, hd = bh % SBH;
    LAS unsigned char* sm = sm0;
    LAS int* doneAt = (LAS int*)(sm0 + RING_BYTES + 8192);
    const int qi = 8 * qg + wave, r = lane & 31, h = lane >> 5, t = 32 * qi + r;
    const size_t rowq = (size_t)(b * SEQ + t) * PROJP;
    bf16x8 Bq[8];
#pragma unroll
    for (int ks = 0; ks < 8; ++ks) Bq[ks] = *(const bf16x8*)(proj + rowq + C_QSB + hd * SBD + 16 * ks + 8 * h);
    f32x16 O[4];
#pragma unroll
    for (int db = 0; db < 4; ++db)
#pragma unroll
        for (int i = 0; i < 16; ++i) O[db][i] = 0.f;
    float R = 1.0f; bool done = false;
    const int prow0 = 4 * wave + (lane >> 4); const unsigned sw0 = (unsigned)((((lane >> 4) & 3) << 2) | (wave & 3));
    const unsigned pch0 = (unsigned)(lane & 15) ^ sw0;
    const bf16* kv0 = proj + (size_t)(b * SEQ + prow0) * PROJP + hd * SBD;
    __syncthreads();
    if (lane == 0) doneAt[wave] = -1;
#define SBW_DMA(kt_) do { int kq_ = (kt_); asm volatile("" : "+s"(kq_)); const unsigned st_ = (unsigned)(kq_ % 9) * 16384u + (unsigned)wave * 1024u; const size_t ro_ = (size_t)(32 * kq_) * PROJP; \
        __builtin_amdgcn_global_load_lds((const unsigned*)(kv0 + ro_ + C_KSB + pch0 * 8), (LAS unsigned*)(sm + st_), 16, 0, 0); \
        __builtin_amdgcn_global_load_lds((const unsigned*)(kv0 + ro_ + C_VSB + pch0 * 8), (LAS unsigned*)(sm + st_ + 8192), 16, 0, 0); } while (0)
    const int ktop = 8 * qg + 7;
#pragma unroll
    for (int i = 0; i < 8; ++i) SBW_DMA(ktop - i);
    const unsigned blk = (lane >> 4) & 1, q4 = (lane & 15) >> 2, p4 = lane & 3;
    const float cexp = 0.08838834764831845f * 1.4426950408889634f;
    for (int s = 0; ; ++s) {
        asm volatile("s_waitcnt vmcnt(0) lgkmcnt(0)" ::: "memory");
        __builtin_amdgcn_s_barrier(); asm volatile("" ::: "memory");
        { int nd = 0;
#pragma unroll
          for (int w8 = 0; w8 < 8; ++w8) { const int da = doneAt[w8]; nd += (da >= 0 && da < s) ? 1 : 0; }
          if (nd == 8) break; }
        { const int knew = ktop - 8 - s; if (knew >= 0) SBW_DMA(knew); }
        const int kt = qi - s;
        if (!done) {
            int kq = kt; asm volatile("" : "+s"(kq));
            LAS unsigned char* Kt = sm + (kq % 9) * 16384; const unsigned vb = (unsigned)(size_t)Kt + 8192u;
            f32x16 S;
#pragma unroll
            for (int i = 0; i < 16; ++i) S[i] = 0.f;
#pragma unroll
            for (int ks = 0; ks < 8; ++ks) { const bf16x8 Kf = *(const LAS bf16x8*)(Kt + offb(r, 2 * ks + h)); S = __builtin_amdgcn_mfma_f32_32x32x16_bf16(Kf, Bq[ks], S, 0, 0, 0); }
            float w[16], keep[16];
            const bool diag = (s == 0);
#pragma unroll
            for (int i = 0; i < 16; ++i) { const int key = (i & 3) + 8 * (i >> 2) + 4 * h;
                const float e = __builtin_amdgcn_exp2f(fminf(S[i] * cexp, 115.f)); const float kp = __builtin_amdgcn_rcpf(1.f + e);
                const bool ok = !diag || key < r;
                keep[i] = ok ? kp : 1.f; w[i] = ok ? e * kp : 0.f; }
            float tot[4], oth[4], sf[16];
#pragma unroll
            for (int g = 0; g < 4; ++g) { sf[4 * g + 3] = 1.f; sf[4 * g + 2] = keep[4 * g + 3]; sf[4 * g + 1] = sf[4 * g + 2] * keep[4 * g + 2]; sf[4 * g] = sf[4 * g + 1] * keep[4 * g + 1]; tot[g] = sf[4 * g] * keep[4 * g]; }
#pragma unroll
            for (int g = 0; g < 4; ++g) oth[g] = __shfl_xor(tot[g], 32);
            float Cg[4]; Cg[3] = R; Cg[2] = Cg[3] * (tot[3] * oth[3]); Cg[1] = Cg[2] * (tot[2] * oth[2]); Cg[0] = Cg[1] * (tot[1] * oth[1]);
            R = Cg[0] * (tot[0] * oth[0]);
#pragma unroll
            for (int g = 0; g < 4; ++g) { const float E = h ? Cg[g] : Cg[g] * oth[g];
#pragma unroll
                for (int p = 0; p < 4; ++p) w[4 * g + p] = w[4 * g + p] * (sf[4 * g + p] * E); }
#pragma unroll
            for (int s2 = 0; s2 < 2; ++s2) {
                v4u wp; wp.x = pkbf(w[8 * s2], w[8 * s2 + 1]); wp.y = pkbf(w[8 * s2 + 2], w[8 * s2 + 3]); wp.z = pkbf(w[8 * s2 + 4], w[8 * s2 + 5]); wp.w = pkbf(w[8 * s2 + 6], w[8 * s2 + 7]);
                const bf16x8 Wf = __builtin_bit_cast(bf16x8, wp);
                s16x4 v0a, v0b, v1a, v1b, v2a, v2b, v3a, v3b;
                const unsigned rb0 = 16 * s2 + 4 * h + q4, rb1 = rb0 + 8, cb = 2 * blk + (p4 >> 1), bo = vb + 8 * (p4 & 1);
                tr_read8(bo + offb(rb0, cb), bo + offb(rb1, cb), bo + offb(rb0, 4 + cb), bo + offb(rb1, 4 + cb), bo + offb(rb0, 8 + cb), bo + offb(rb1, 8 + cb), bo + offb(rb0, 12 + cb), bo + offb(rb1, 12 + cb),
                         v0a, v0b, v1a, v1b, v2a, v2b, v3a, v3b);
                O[0] = __builtin_amdgcn_mfma_f32_32x32x16_bf16(__builtin_shufflevector(v0a, v0b, 0, 1, 2, 3, 4, 5, 6, 7), Wf, O[0], 0, 0, 0);
                O[1] = __builtin_amdgcn_mfma_f32_32x32x16_bf16(__builtin_shufflevector(v1a, v1b, 0, 1, 2, 3, 4, 5, 6, 7), Wf, O[1], 0, 0, 0);
                O[2] = __builtin_amdgcn_mfma_f32_32x32x16_bf16(__builtin_shufflevector(v2a, v2b, 0, 1, 2, 3, 4, 5, 6, 7), Wf, O[2], 0, 0, 0);
                O[3] = __builtin_amdgcn_mfma_f32_32x32x16_bf16(__builtin_shufflevector(v3a, v3b, 0, 1, 2, 3, 4, 5, 6, 7), Wf, O[3], 0, 0, 0);
            }
            if (__all(R < 5.0e-20f) || kt == 0) { done = true; if (lane == 0) doneAt[wave] = s; }
        }
    }
#undef SBW_DMA
    asm volatile("s_waitcnt vmcnt(0)" ::: "memory");
    float ss = 0.f;
#pragma unroll
    for (int db = 0; db < 4; ++db)
#pragma unroll
        for (int i = 0; i < 16; ++i) ss += O[db][i] * O[db][i];
    ss += __shfl_xor(ss, 32);
    const float rs = rsqrtf(ss * (1.0f / SBD) + EPS);
    bf16* orow = cat + (size_t)(b * SEQ + t) * D + hd * SBD;
#pragma unroll
    for (int db = 0; db < 4; ++db) { unsigned w[4][2];
#pragma unroll
        for (int g = 0; g < 4; ++g) { const int d = 32 * db + 8 * g + 4 * h; const f32x4 gv = *(const f32x4*)(gain + hd * SBD + d);
            w[g][0] = pkbf(O[db][4 * g] * rs * gv[0], O[db][4 * g + 1] * rs * gv[1]); w[g][1] = pkbf(O[db][4 * g + 2] * rs * gv[2], O[db][4 * g + 3] * rs * gv[3]); }
        const v2u s0 = __builtin_amdgcn_permlane32_swap(w[0][0], w[1][0], false, false), s1 = __builtin_amdgcn_permlane32_swap(w[0][1], w[1][1], false, false);
        const v2u s2 = __builtin_amdgcn_permlane32_swap(w[2][0], w[3][0], false, false), s3 = __builtin_amdgcn_permlane32_swap(w[2][1], w[3][1], false, false);
        *(v4u*)(orow + 32 * db + 8 * h) = (v4u){s0.x, s1.x, s0.y, s1.y}; *(v4u*)(orow + 32 * db + 16 + 8 * h) = (v4u){s2.x, s3.x, s2.y, s3.y}; }
}

struct MktSched { const char* KV; const char* WqN; unsigned ldb; int K, G, c;
    __device__ __forceinline__ bool next(int i, pg8::Unit& u) const { const int L = i * G + c; if (L >= 128) return false; const int b = L >> 5, h = (L >> 3) & 3, kt = L & 7;
        u.pm = b * 4 + h; u.pn = kt; u.z = L; u.mv = 256; u.A = KV + ((size_t)(b * MEM) * 2 * D + h * XD) * 2; u.B = WqN + ((size_t)(kt * 256) * D + h * XD) * 2; return true; }
    __device__ __forceinline__ unsigned arow(const pg8::Unit&, int r) const { return (unsigned)r * (2 * D * 2); }
    __device__ __forceinline__ void a_ready(const pg8::Unit&) const {}
    __device__ __forceinline__ void done(const pg8::Unit&) const {} };
struct NvtSched { const char* WoT; const char* KV; unsigned ldb; int K, G, c;
    __device__ __forceinline__ bool next(int i, pg8::Unit& u) const { const int L = i * G + c; if (L >= 128) return false; const int b = L >> 5, h = (L >> 3) & 3, nt = L & 7;
        u.pm = b * 8 + nt; u.pn = h; u.z = L; u.mv = 256; u.A = WoT + ((size_t)(nt * 256) * D + h * XD) * 2; u.B = KV + ((size_t)(b * MEM) * 2 * D + D + h * XD) * 2; return true; }
    __device__ __forceinline__ unsigned arow(const pg8::Unit&, int r) const { return (unsigned)r * (D * 2); }
    __device__ __forceinline__ void a_ready(const pg8::Unit&) const {}
    __device__ __forceinline__ void done(const pg8::Unit&) const {} };
struct XLogitSched { const char* X1; const char* MKT; unsigned ldb; int K, G, c;
    __device__ __forceinline__ bool next(int i, pg8::Unit& u) const { const int Lr = i * G + c; if (Lr >= 128) return false; const int rp = 4 * (Lr & 7) + (Lr >> 5), h = (Lr >> 3) & 3, L = rp * 4 + h, b = rp >> 3, qt = rp & 7;
        u.pm = b * 8 + qt; u.pn = h; u.z = L; u.mv = 256; u.A = X1 + (size_t)(b * SEQ + qt * 256) * D * 2; u.B = MKT + (size_t)(b * 1024 + h * 256) * D * 2; return true; }
    __device__ __forceinline__ unsigned arow(const pg8::Unit&, int r) const { return (unsigned)r * (D * 2); }
    __device__ __forceinline__ void a_ready(const pg8::Unit&) const {}
    __device__ __forceinline__ void done(const pg8::Unit&) const {} };
struct EpiSoftmaxP {
    static constexpr bool PERM = true, AFTER_DRAIN = false;
    bf16* P; LAS float* tab; const float* rowsq;
    __device__ __forceinline__ void operator()(const f32x4 (&acc)[2][2][4][2], const pg8::Unit& u, int wr, int wc, int fr, int fq) const {
        const float sc = 0.044194173824159216f * 1.4426950408889634f;
        LAS float* Tm = tab; LAS float* Ts = tab + 1024;
        float rsc[2][4];
#pragma unroll
        for (int ai = 0; ai < 2; ++ai)
#pragma unroll
            for (int m = 0; m < 4; ++m) { rsc[ai][m] = sc * rsqrtf(rowsq[u.pm * 256 + ai * 128 + wr * 64 + m * 16 + fr] * (1.0f / D) + EPS); float v = -3.0e38f;
#pragma unroll
                for (int bj = 0; bj < 2; ++bj)
#pragma unroll
                    for (int n = 0; n < 2; ++n) { const f32x4 a = acc[ai][bj][m][n]; v = fmaxf(v, fmaxf(fmaxf(a[0], a[1]), fmaxf(a[2], a[3]))); }
                v = fmaxf(v, __shfl_xor(v, 16)); v = fmaxf(v, __shfl_xor(v, 32));
                if (fq == 0) Tm[(ai * 128 + wr * 64 + m * 16 + fr) * 4 + wc] = v; }
        asm volatile("s_waitcnt lgkmcnt(0)" ::: "memory"); __builtin_amdgcn_s_barrier(); asm volatile("" ::: "memory");
        float e[2][2][4][2][4];
#pragma unroll
        for (int ai = 0; ai < 2; ++ai)
#pragma unroll
            for (int m = 0; m < 4; ++m) { const f32x4 t4 = *(const LAS f32x4*)(Tm + (ai * 128 + wr * 64 + m * 16 + fr) * 4); const float k2 = rsc[ai][m], mr = fmaxf(fmaxf(t4[0], t4[1]), fmaxf(t4[2], t4[3])) * k2; float sacc = 0.f;
#pragma unroll
                for (int bj = 0; bj < 2; ++bj)
#pragma unroll
                    for (int n = 0; n < 2; ++n)
#pragma unroll
                        for (int j = 0; j < 4; ++j) { const float x = __builtin_amdgcn_exp2f(acc[ai][bj][m][n][j] * k2 - mr); e[ai][bj][m][n][j] = x; sacc += x; }
                sacc += __shfl_xor(sacc, 16); sacc += __shfl_xor(sacc, 32);
                if (fq == 0) Ts[(ai * 128 + wr * 64 + m * 16 + fr) * 4 + wc] = sacc; }
        asm volatile("s_waitcnt lgkmcnt(0)" ::: "memory"); __builtin_amdgcn_s_barrier(); asm volatile("" ::: "memory");
        const int col0 = u.pn * 256 + wc * 32 + 8 * fq;
#pragma unroll
        for (int ai = 0; ai < 2; ++ai)
#pragma unroll
            for (int m = 0; m < 4; ++m) { const int rl = ai * 128 + wr * 64 + m * 16 + fr; const f32x4 t4 = *(const LAS f32x4*)(Ts + rl * 4); const float inv = 1.0f / ((t4[0] + t4[1]) + (t4[2] + t4[3]));
                bf16* rowp = P + (size_t)(u.pm * 256 + rl) * 1024 + col0;
#pragma unroll
                for (int bj = 0; bj < 2; ++bj) { v4u w; w.x = pkbf(e[ai][bj][m][0][0] * inv, e[ai][bj][m][0][1] * inv); w.y = pkbf(e[ai][bj][m][0][2] * inv, e[ai][bj][m][0][3] * inv);
                    w.z = pkbf(e[ai][bj][m][1][0] * inv, e[ai][bj][m][1][1] * inv); w.w = pkbf(e[ai][bj][m][1][2] * inv, e[ai][bj][m][1][3] * inv); *(v4u*)(rowp + bj * 128) = w; } }
    }
};
struct EpiSoftmax128 {
    bf16* P; LAS float* tab; const float* rowsq;
    struct Pre { float rq[4]; };
    __device__ __forceinline__ void prefetch(Pre& p, const pg8::Unit& u, int wr, int wc, int fr, int fq) const {
#pragma unroll
        for (int m = 0; m < 4; ++m) p.rq[m] = rowsq[u.pm * 128 + wr * 64 + m * 16 + fr]; }
    __device__ __forceinline__ void operator()(const f32x4 (&acc)[2][4][2], const pg8::Unit& u, int wr, int wc, int fr, int fq, const Pre& pre) const {
        const float sc = 0.044194173824159216f * 1.4426950408889634f;
        LAS float* Tm = tab; LAS float* Ts = tab + 512;
        float rsc[4];
#pragma unroll
        for (int m = 0; m < 4; ++m) { rsc[m] = sc * rsqrtf(pre.rq[m] * (1.0f / D) + EPS); float v = -3.0e38f;
#pragma unroll
            for (int bj = 0; bj < 2; ++bj)
#pragma unroll
                for (int n = 0; n < 2; ++n) { const f32x4 a = acc[bj][m][n]; v = fmaxf(v, fmaxf(fmaxf(a[0], a[1]), fmaxf(a[2], a[3]))); }
            v = fmaxf(v, __shfl_xor(v, 16)); v = fmaxf(v, __shfl_xor(v, 32));
            if (fq == 0) Tm[(wr * 64 + m * 16 + fr) * 4 + wc] = v; }
        asm volatile("s_waitcnt lgkmcnt(0)" ::: "memory"); __builtin_amdgcn_s_barrier(); asm volatile("" ::: "memory");
        float e[2][4][2][4];
#pragma unroll
        for (int m = 0; m < 4; ++m) { const f32x4 t4 = *(const LAS f32x4*)(Tm + (wr * 64 + m * 16 + fr) * 4); const float k2 = rsc[m], mr = fmaxf(fmaxf(t4[0], t4[1]), fmaxf(t4[2], t4[3])) * k2; float sacc = 0.f;
#pragma unroll
            for (int bj = 0; bj < 2; ++bj)
#pragma unroll
                for (int n = 0; n < 2; ++n)
#pragma unroll
                    for (int j = 0; j < 4; ++j) { const float x = __builtin_amdgcn_exp2f(acc[bj][m][n][j] * k2 - mr); e[bj][m][n][j] = x; sacc += x; }
            sacc += __shfl_xor(sacc, 16); sacc += __shfl_xor(sacc, 32);
            if (fq == 0) Ts[(wr * 64 + m * 16 + fr) * 4 + wc] = sacc; }
        asm volatile("s_waitcnt lgkmcnt(0)" ::: "memory"); __builtin_amdgcn_s_barrier(); asm volatile("" ::: "memory");
        const int col0 = u.pn * 256 + wc * 32 + 8 * fq;
#pragma unroll
        for (int m = 0; m < 4; ++m) { const int rl = wr * 64 + m * 16 + fr; const f32x4 t4 = *(const LAS f32x4*)(Ts + rl * 4); const float inv = 1.0f / ((t4[0] + t4[1]) + (t4[2] + t4[3]));
            bf16* rowp = P + (size_t)(u.pm * 128 + rl) * 1024 + col0;
#pragma unroll
            for (int bj = 0; bj < 2; ++bj) { v4u w; w.x = pkbf(e[bj][m][0][0] * inv, e[bj][m][0][1] * inv); w.y = pkbf(e[bj][m][0][2] * inv, e[bj][m][0][3] * inv);
                w.z = pkbf(e[bj][m][1][0] * inv, e[bj][m][1][1] * inv); w.w = pkbf(e[bj][m][1][2] * inv, e[bj][m][1][3] * inv); *(v4u*)(rowp + bj * 128) = w; } }
    }
};
struct XOutSched { const char* P; const char* NVT; unsigned ldb; int K, G, c;
    __device__ __forceinline__ bool next(int i, pg8::Unit& u) const { const int Lr = i * G + c; if (Lr >= 256) return false; const int rp = 4 * (Lr & 7) + (Lr >> 6), nt = (Lr >> 3) & 7, L = rp * 8 + nt, b = rp >> 3, qt = rp & 7;
        u.pm = b * 8 + qt; u.pn = nt; u.z = L; u.mv = 256; u.A = P + (size_t)(b * SEQ + qt * 256) * 1024 * 2; u.B = NVT + (size_t)(b * D + nt * 256) * 1024 * 2; return true; }
    __device__ __forceinline__ unsigned arow(const pg8::Unit&, int r) const { return (unsigned)r * (1024 * 2); }
    __device__ __forceinline__ void a_ready(const pg8::Unit&) const {}
    __device__ __forceinline__ void done(const pg8::Unit&) const {} };

template <int MODE>
__device__ __forceinline__ void moe_stream_unit(LAS unsigned char* lds, const char* __restrict__ Ab, unsigned lda, int ashift, const float* __restrict__ W0, const float* __restrict__ W1, int ldw, int K, int colbase,
                                                const int* __restrict__ list, int n_e, bf16* __restrict__ Out, const float* __restrict__ gate, int tid, int wave, int lane) {
    const int wr = wave >> 2, wc = wave & 3, r = lane & 31, h = lane >> 5;
    const int nt = K / 32;
    const unsigned blane = (unsigned)(((lane >> 5) * ldw + 4 * (lane & 31)) * 4);
    const char* Wg0 = (const char*)(W0 + colbase); const char* Wg1 = (MODE == 0) ? (const char*)(W1 + colbase) : (const char*)(W0 + colbase + 128);
    const unsigned a_base = (unsigned)(wr * 2048 + r * 64), a_sw0 = (unsigned)(((h ^ ((r >> 2) & 3)) & 3) << 4), a_sw1 = (unsigned)((((2 + h) ^ ((r >> 2) & 3)) & 3) << 4);
    const unsigned b_base = (unsigned)((h * 8 * 128 + 32 * wc + r) * 4);
    for (int base = 0; base < n_e; base += 320) {
        const int nrows = (n_e - base) < 320 ? (n_e - base) : 320, nblk = (nrows + 31) >> 5;
        __syncthreads();
        unsigned aoff[3];
#pragma unroll
        for (int i = 0; i < 3; ++i) { const int pc = (i < 2) ? (wave + 8 * i) : (16 + (wave & 3)); const int m = 16 * pc + (lane >> 2), mm = m < nrows ? m : nrows - 1; const int id = list[base + mm];
            aoff[i] = (unsigned)(id >> ashift) * lda + (unsigned)(((lane & 3) ^ ((m >> 2) & 3)) * 16); }
        f32x16 acc[5][2];
#pragma unroll
        for (int j = 0; j < 5; ++j)
#pragma unroll
            for (int nb = 0; nb < 2; ++nb)
#pragma unroll
                for (int i = 0; i < 16; ++i) acc[j][nb][i] = 0.f;
#define MS_DMAB(t) do { int tq_ = (t); asm volatile("" : "+s"(tq_)); const unsigned st_ = 40960u + (unsigned)(tq_ % 3) * 32768u + (unsigned)wave * 1024u; const size_t kro_ = ((size_t)tq_ * 32 + 2 * wave) * (size_t)ldw * 4; \
            __builtin_amdgcn_global_load_lds((const unsigned*)(Wg0 + kro_ + blane), (LAS unsigned*)(lds + st_), 16, 0, 2); \
            __builtin_amdgcn_global_load_lds((const unsigned*)(Wg0 + kro_ + (size_t)ldw * 64 + blane), (LAS unsigned*)(lds + st_ + 8192), 16, 0, 2); \
            __builtin_amdgcn_global_load_lds((const unsigned*)(Wg1 + kro_ + blane), (LAS unsigned*)(lds + st_ + 16384), 16, 0, 2); \
            __builtin_amdgcn_global_load_lds((const unsigned*)(Wg1 + kro_ + (size_t)ldw * 64 + blane), (LAS unsigned*)(lds + st_ + 24576), 16, 0, 2); } while (0)
#define MS_DMAA(t) do { int tq_ = (t); asm volatile("" : "+s"(tq_)); const unsigned st_ = (unsigned)(tq_ & 1) * 20480u; const char* ap_ = Ab + (size_t)tq_ * 64; \
            __builtin_amdgcn_global_load_lds((const unsigned*)(ap_ + aoff[0]), (LAS unsigned*)(lds + st_ + wave * 1024), 16, 0, 0); \
            __builtin_amdgcn_global_load_lds((const unsigned*)(ap_ + aoff[1]), (LAS unsigned*)(lds + st_ + (wave + 8) * 1024), 16, 0, 0); \
            __builtin_amdgcn_global_load_lds((const unsigned*)(ap_ + aoff[2]), (LAS unsigned*)(lds + st_ + (16 + (wave & 3)) * 1024), 16, 0, 0); } while (0)
        MS_DMAB(0); MS_DMAA(0); if (nt > 1) MS_DMAB(1);
        for (int t = 0; t < nt; ++t) {
            int tq = t; asm volatile("" : "+s"(tq));
            LAS unsigned char* Bs = lds + 40960 + (tq % 3) * 32768; LAS unsigned char* As = lds + (tq & 1) * 20480;
            if (t + 1 < nt) asm volatile("s_waitcnt vmcnt(4)" ::: "memory"); else asm volatile("s_waitcnt vmcnt(0)" ::: "memory");
            __builtin_amdgcn_s_barrier(); asm volatile("" ::: "memory");
            if (t + 1 < nt) MS_DMAA(t + 1);
            if (t + 2 < nt) MS_DMAB(t + 2);
            const LAS unsigned char* Ar = As + a_base; const LAS float* Br = (const LAS float*)(Bs + b_base);
#pragma unroll
            for (int ks = 0; ks < 2; ++ks) {
                bf16x8 Bf[2];
#pragma unroll
                for (int nb = 0; nb < 2; ++nb) { const LAS float* bp = Br + nb * 4096 + ks * 2048;
                    v4u w; w.x = pkbf(bp[0], bp[128]); w.y = pkbf(bp[256], bp[384]); w.z = pkbf(bp[512], bp[640]); w.w = pkbf(bp[768], bp[896]); Bf[nb] = __builtin_bit_cast(bf16x8, w); }
#pragma unroll
                for (int j = 0; j < 5; ++j) { const int mb = wr + 2 * j;
                    if (mb < nblk) { const bf16x8 Af = *(const LAS bf16x8*)(Ar + (ks ? a_sw1 : a_sw0) + j * 4096);
                        acc[j][0] = __builtin_amdgcn_mfma_f32_32x32x16_bf16(Bf[0], Af, acc[j][0], 0, 0, 0); acc[j][1] = __builtin_amdgcn_mfma_f32_32x32x16_bf16(Bf[1], Af, acc[j][1], 0, 0, 0); } }
            }
        }
#undef MS_DMAB
#undef MS_DMAA
#pragma unroll
        for (int j = 0; j < 5; ++j) { const int mb = wr + 2 * j, m = 32 * mb + r;
            if (mb < nblk && m < nrows) { const int pair = list[base + m];
                if (MODE == 0) {
#pragma unroll
                    for (int g = 0; g < 4; ++g) { float hv[4];
#pragma unroll
                        for (int p2 = 0; p2 < 4; ++p2) { const float gv = acc[j][0][4 * g + p2], uv = acc[j][1][4 * g + p2]; hv[p2] = gv / (1.f + __expf(-gv)) * uv; }
                        v2u w; w.x = pkbf(hv[0], hv[1]); w.y = pkbf(hv[2], hv[3]); *(v2u*)(Out + (size_t)pair * FF + colbase + 32 * wc + 8 * g + 4 * h) = w; }
                } else { const float gt = gate[pair];
#pragma unroll
                    for (int nb = 0; nb < 2; ++nb)
#pragma unroll
                        for (int g = 0; g < 4; ++g) { v2u w; w.x = pkbf(acc[j][nb][4 * g] * gt, acc[j][nb][4 * g + 1] * gt); w.y = pkbf(acc[j][nb][4 * g + 2] * gt, acc[j][nb][4 * g + 3] * gt);
                            *(v2u*)(Out + (size_t)pair * D + colbase + 128 * nb + 32 * wc + 8 * g + 4 * h) = w; } } } }
    }
}

template <int MODE> __device__ __forceinline__ int moe_expert(int u) { const int x8 = u & 7, y = u >> 3; return x8 * 8 + (MODE == 0 ? (y >> 2) : (y >> 3)); }
template <int MODE> __device__ __forceinline__ int moe_colbase(int u) { const int y = u >> 3; return MODE == 0 ? 128 * (y & 3) : 256 * (y & 7); }
__device__ __forceinline__ void moe_dma_b(LAS unsigned char* lds, const char* Wg0, const char* Wg1, int ldw, int tile, int stage, int wave, int lane) {
    int tq = tile; asm volatile("" : "+s"(tq));
    const unsigned blane = (unsigned)(((lane >> 5) * ldw + 4 * (lane & 31)) * 4);
    const unsigned st = 40960u + (unsigned)stage * 32768u + (unsigned)wave * 1024u; const size_t kro = ((size_t)tq * 32 + 2 * wave) * (size_t)ldw * 4;
    __builtin_amdgcn_global_load_lds((const unsigned*)(Wg0 + kro + blane), (LAS unsigned*)(lds + st), 16, 0, 2);
    __builtin_amdgcn_global_load_lds((const unsigned*)(Wg0 + kro + (size_t)ldw * 64 + blane), (LAS unsigned*)(lds + st + 8192), 16, 0, 2);
    __builtin_amdgcn_global_load_lds((const unsigned*)(Wg1 + kro + blane), (LAS unsigned*)(lds + st + 16384), 16, 0, 2);
    __builtin_amdgcn_global_load_lds((const unsigned*)(Wg1 + kro + (size_t)ldw * 64 + blane), (LAS unsigned*)(lds + st + 24576), 16, 0, 2);
}
template <int MODE> __device__ __forceinline__ void moe_wptr(const float* Wa, const float* Wb, int u, const char*& Wg0, const char*& Wg1) {
    const int e = moe_expert<MODE>(u), cb = moe_colbase<MODE>(u);
    if (MODE == 0) { Wg0 = (const char*)(Wa + (size_t)e * D * FF + cb); Wg1 = (const char*)(Wb + (size_t)e * D * FF + cb); }
    else { Wg0 = (const char*)(Wa + (size_t)e * FF * D + cb); Wg1 = Wg0 + 128 * 4; }
}
template <int MODE> __device__ __forceinline__ void moe_prefetch(LAS unsigned char* lds, const float* Wa, const float* Wb, int wave, int lane) {
    constexpr int NU = (MODE == 0) ? NE * 4 : NE * 8, ldw = (MODE == 0) ? FF : D;
    if ((int)blockIdx.x < NU) { const char* w0; const char* w1; moe_wptr<MODE>(Wa, Wb, (int)blockIdx.x, w0, w1); moe_dma_b(lds, w0, w1, ldw, 0, 0, wave, lane); moe_dma_b(lds, w0, w1, ldw, 1, 1, wave, lane); }
}
template <int MODE>
__device__ __forceinline__ void moe_stream_wg(LAS unsigned char* lds, const char* __restrict__ Ab, unsigned lda, int ashift, const float* __restrict__ Wa, const float* __restrict__ Wb,
                                              const int* __restrict__ elist, const int* __restrict__ ecnt, bf16* __restrict__ Out, const float* __restrict__ gate, int G, bool pre, int tid, int wave, int lane) {
    constexpr int NU = (MODE == 0) ? NE * 4 : NE * 8, K = (MODE == 0) ? D : FF, ldw = (MODE == 0) ? FF : D, nt = K / 32;
    const int wr = wave >> 2, wc = wave & 3, r = lane & 31, h = lane >> 5;
    const unsigned a_base = (unsigned)(wr * 2048 + r * 64), a_sw0 = (unsigned)(((h ^ ((r >> 2) & 3)) & 3) << 4), a_sw1 = (unsigned)((((2 + h) ^ ((r >> 2) & 3)) & 3) << 4);
    const unsigned b_base = (unsigned)((h * 8 * 128 + 32 * wc + r) * 4);
    int u = (int)blockIdx.x, base = 0, ne = 0; bool have = false;
    for (; u < NU; u += G) { ne = ecnt[moe_expert<MODE>(u) * 64]; if (ne > 0) { have = true; break; } }
    if (pre && !(have && u == (int)blockIdx.x)) { asm volatile("s_waitcnt vmcnt(0)" ::: "memory"); pre = false; }
    if (!pre) __syncthreads();
    if (!have) return;
    const char* Wg0; const char* Wg1; moe_wptr<MODE>(Wa, Wb, u, Wg0, Wg1);
    if (!pre) { moe_dma_b(lds, Wg0, Wg1, ldw, 0, 0, wave, lane); moe_dma_b(lds, Wg0, Wg1, ldw, 1, 1, wave, lane); }
    int ph = 0;
    unsigned aoff[3], naoff[3];
#define MW_AOFF(dst, lst, bs, nr) do { _Pragma("unroll") for (int i = 0; i < 3; ++i) { const int pc = (i < 2) ? (wave + 8 * i) : (16 + (wave & 3)); const int m = 16 * pc + (lane >> 2), mm = m < (nr) ? m : (nr) - 1; const int id = (lst)[(bs) + mm]; \
            dst[i] = (unsigned)(id >> ashift) * lda + (unsigned)(((lane & 3) ^ ((m >> 2) & 3)) * 16); } } while (0)
#define MW_DMAA(t, ao) do { int tq_ = (t); asm volatile("" : "+s"(tq_)); const unsigned st_ = (unsigned)(tq_ & 1) * 20480u; const char* ap_ = Ab + (size_t)tq_ * 64; \
            __builtin_amdgcn_global_load_lds((const unsigned*)(ap_ + ao[0]), (LAS unsigned*)(lds + st_ + wave * 1024), 16, 0, 0); \
            __builtin_amdgcn_global_load_lds((const unsigned*)(ap_ + ao[1]), (LAS unsigned*)(lds + st_ + (wave + 8) * 1024), 16, 0, 0); \
            __builtin_amdgcn_global_load_lds((const unsigned*)(ap_ + ao[2]), (LAS unsigned*)(lds + st_ + (16 + (wave & 3)) * 1024), 16, 0, 0); } while (0)
    { const int nr0 = ne < 320 ? ne : 320; const int* l0 = elist + (size_t)moe_expert<MODE>(u) * NTOK; MW_AOFF(aoff, l0, 0, nr0); }
    MW_DMAA(0, aoff);
    for (;;) {
        const int* list = elist + (size_t)moe_expert<MODE>(u) * NTOK; const int colbase = moe_colbase<MODE>(u);
        const int nrows = (ne - base) < 320 ? (ne - base) : 320, nblk = (nrows + 31) >> 5;
        int nu = u, nbase = base + 320, nne = ne; bool hn = true;
        if (nbase >= ne) { hn = false; for (nu = u + G; nu < NU; nu += G) { nne = ecnt[moe_expert<MODE>(nu) * 64]; if (nne > 0) { hn = true; nbase = 0; break; } } }
        const char* nW0 = Wg0; const char* nW1 = Wg1;
        if (hn) { moe_wptr<MODE>(Wa, Wb, nu, nW0, nW1); const int nnr = (nne - nbase) < 320 ? (nne - nbase) : 320; const int* nl = elist + (size_t)moe_expert<MODE>(nu) * NTOK; MW_AOFF(naoff, nl, nbase, nnr); }
        f32x16 acc[5][2];
#pragma unroll
        for (int j = 0; j < 5; ++j)
#pragma unroll
            for (int nb = 0; nb < 2; ++nb)
#pragma unroll
                for (int i = 0; i < 16; ++i) acc[j][nb][i] = 0.f;
        int prs[5]; float gts[5];
#pragma unroll
        for (int j = 0; j < 5; ++j) { const int m = 32 * (wr + 2 * j) + r; prs[j] = list[base + (m < nrows ? m : nrows - 1)]; gts[j] = (MODE == 1) ? gate[prs[j]] : 0.f; }
        for (int t = 0; t < nt; ++t) {
            int tq = t; asm volatile("" : "+s"(tq));
            const int sb = (ph + tq) % 3;
            LAS unsigned char* Bs = lds + 40960 + sb * 32768; LAS unsigned char* As = lds + (tq & 1) * 20480;
            if (t > 0 && (t + 1 < nt || hn)) asm volatile("s_waitcnt vmcnt(4)" ::: "memory"); else asm volatile("s_waitcnt vmcnt(0)" ::: "memory");
            __builtin_amdgcn_s_barrier(); asm volatile("" ::: "memory");
            if (t + 1 < nt) MW_DMAA(t + 1, aoff); else if (hn) MW_DMAA(0, naoff);
            if (t + 2 < nt) moe_dma_b(lds, Wg0, Wg1, ldw, t + 2, (ph + t + 2) % 3, wave, lane); else if (hn) moe_dma_b(lds, nW0, nW1, ldw, t + 2 - nt, (ph + t + 2) % 3, wave, lane);
            const LAS unsigned char* Ar = As + a_base; const LAS float* Br = (const LAS float*)(Bs + b_base);
#pragma unroll
            for (int ks = 0; ks < 2; ++ks) {
                bf16x8 Bf[2];
#pragma unroll
                for (int nb = 0; nb < 2; ++nb) { const LAS float* bp = Br + nb * 4096 + ks * 2048;
                    v4u w; w.x = pkbf(bp[0], bp[128]); w.y = pkbf(bp[256], bp[384]); w.z = pkbf(bp[512], bp[640]); w.w = pkbf(bp[768], bp[896]); Bf[nb] = __builtin_bit_cast(bf16x8, w); }
#pragma unroll
                for (int j = 0; j < 5; ++j) { const int mb = wr + 2 * j;
                    if (mb < nblk) { const bf16x8 Af = *(const LAS bf16x8*)(Ar + (ks ? a_sw1 : a_sw0) + j * 4096);
                        acc[j][0] = __builtin_amdgcn_mfma_f32_32x32x16_bf16(Bf[0], Af, acc[j][0], 0, 0, 0); acc[j][1] = __builtin_amdgcn_mfma_f32_32x32x16_bf16(Bf[1], Af, acc[j][1], 0, 0, 0); } }
            }
        }
#pragma unroll
        for (int j = 0; j < 5; ++j) { const int mb = wr + 2 * j, m = 32 * mb + r;
            if (mb < nblk) { const bool live = m < nrows; const int pair = prs[j];
                if (MODE == 0) { unsigned w[4][2];
#pragma unroll
                    for (int g = 0; g < 4; ++g) { float hv[4];
#pragma unroll
                        for (int p2 = 0; p2 < 4; ++p2) { const float gv = acc[j][0][4 * g + p2], uv = acc[j][1][4 * g + p2]; hv[p2] = gv / (1.f + __expf(-gv)) * uv; }
                        w[g][0] = pkbf(hv[0], hv[1]); w[g][1] = pkbf(hv[2], hv[3]); }
                    const v2u s0 = __builtin_amdgcn_permlane32_swap(w[0][0], w[1][0], false, false), s1 = __builtin_amdgcn_permlane32_swap(w[0][1], w[1][1], false, false);
                    const v2u s2 = __builtin_amdgcn_permlane32_swap(w[2][0], w[3][0], false, false), s3 = __builtin_amdgcn_permlane32_swap(w[2][1], w[3][1], false, false);
                    if (live) { bf16* op = Out + (size_t)pair * FF + colbase + 32 * wc + 8 * h; *(v4u*)op = (v4u){s0.x, s1.x, s0.y, s1.y}; *(v4u*)(op + 16) = (v4u){s2.x, s3.x, s2.y, s3.y}; }
                } else { const float gt = gts[j];
#pragma unroll
                    for (int nb = 0; nb < 2; ++nb) { unsigned w[4][2];
#pragma unroll
                        for (int g = 0; g < 4; ++g) { w[g][0] = pkbf(acc[j][nb][4 * g] * gt, acc[j][nb][4 * g + 1] * gt); w[g][1] = pkbf(acc[j][nb][4 * g + 2] * gt, acc[j][nb][4 * g + 3] * gt); }
                        const v2u s0 = __builtin_amdgcn_permlane32_swap(w[0][0], w[1][0], false, false), s1 = __builtin_amdgcn_permlane32_swap(w[0][1], w[1][1], false, false);
                        const v2u s2 = __builtin_amdgcn_permlane32_swap(w[2][0], w[3][0], false, false), s3 = __builtin_amdgcn_permlane32_swap(w[2][1], w[3][1], false, false);
                        if (live) { bf16* op = Out + (size_t)pair * D + colbase + 128 * nb + 32 * wc + 8 * h; *(v4u*)op = (v4u){s0.x, s1.x, s0.y, s1.y}; *(v4u*)(op + 16) = (v4u){s2.x, s3.x, s2.y, s3.y}; } } } } }
        if (!hn) break;
        u = nu; base = nbase; ne = nne; Wg0 = nW0; Wg1 = nW1; ph = (ph + nt) % 3;
#pragma unroll
        for (int i = 0; i < 3; ++i) aoff[i] = naoff[i];
    }
#undef MW_AOFF
#undef MW_DMAA
}

__device__ __forceinline__ float softplus_f(float z) { return fmaxf(z, 0.f) + log1pf(__expf(-fabsf(z))); }
__device__ __forceinline__ void tr_read2(unsigned a0, unsigned a1, s16x4& r0, s16x4& r1) {
    asm volatile("ds_read_b64_tr_b16 %0, %2\n\tds_read_b64_tr_b16 %1, %3\n\ts_waitcnt lgkmcnt(0)" : "=&v"(r0), "=&v"(r1) : "v"(a0), "v"(a1) : "memory");
}
__device__ __forceinline__ void gla_stage_v(LAS unsigned char* vt, const bf16* __restrict__ proj, size_t row0, int hd, int tid) {
#pragma unroll
    for (int i = 0; i < 4; ++i) { const int id = i * 512 + tid, row = id >> 5, ch = id & 31;
        const v4u x = *(const v4u*)(proj + (row0 + row) * PROJP + C_VG + hd * GDV + ch * 8);
        *(LAS v4u*)(vt + (ch >> 4) * 16384 + offb(row, ch & 15)) = x; }
}
__device__ __forceinline__ void gla_pass1_unit(LAS unsigned char* sm, const bf16* __restrict__ proj, const float* __restrict__ alr, const float* __restrict__ wg, const float* __restrict__ bg,
                                               bf16* __restrict__ qdg, bf16* __restrict__ kig, float* __restrict__ elg, bf16* __restrict__ Ug, int unit, int tid, int wave, int lane) {
    LAS unsigned char* vt = sm; LAS unsigned char* kit = sm + 32768; LAS float* ptot = (LAS float*)(sm + 49152);
    const int c = unit & 31, hd = (unit >> 5) & 3, b = unit >> 7;
    const size_t row0 = (size_t)b * SEQ + c * CHUNK;
    const int j = tid & 127, part = tid >> 7;
    __syncthreads();
    gla_stage_v(vt, proj, row0, hd, tid);
    LAS float* alds = ptot + 512;
    if (tid < 256) *(LAS f32x4*)(alds + tid * 4) = *(const f32x4*)(alr + row0 * GRANK + tid * 4);
    float wgr[GRANK];
#pragma unroll
    for (int r = 0; r < GRANK; ++r) wgr[r] = wg[r * 512 + hd * GDK + j];
    const float bj = bg[hd * GDK + j];
    __syncthreads();
    float cl[16]; float run = 0.f;
#pragma unroll
    for (int tt = 0; tt < 16; ++tt) { const LAS f32x4* ap = (const LAS f32x4*)(alds + (part * 16 + tt) * GRANK); const f32x4 a0 = ap[0], a1 = ap[1], a2 = ap[2], a3 = ap[3];
        float sacc = bj + ((a0[0] * wgr[0] + a0[1] * wgr[1]) + (a0[2] * wgr[2] + a0[3] * wgr[3])) + ((a1[0] * wgr[4] + a1[1] * wgr[5]) + (a1[2] * wgr[6] + a1[3] * wgr[7]))
                   + ((a2[0] * wgr[8] + a2[1] * wgr[9]) + (a2[2] * wgr[10] + a2[3] * wgr[11])) + ((a3[0] * wgr[12] + a3[1] * wgr[13]) + (a3[2] * wgr[14] + a3[3] * wgr[15]));
        run -= (fmaxf(-sacc, 0.f) + __logf(1.0f + __expf(-fabsf(sacc)))) * (1.0f / 16.0f); cl[tt] = run; }
    ptot[part * 128 + j] = run;
    __syncthreads();
    const float prefix = (part > 0 ? ptot[j] : 0.f) + (part > 1 ? ptot[128 + j] : 0.f) + (part > 2 ? ptot[256 + j] : 0.f);
    LAS float* cumt = alds + 1024;
#pragma unroll
    for (int tt = 0; tt < 16; ++tt) cumt[(part * 16 + tt) * 128 + j] = prefix + cl[tt];
    if (part == 3) elg[(size_t)unit * 128 + j] = __expf(prefix + run);
    __syncthreads();
#pragma unroll
    for (int i = 0; i < 2; ++i) { const int id = i * 512 + tid, t = id >> 4, cch = id & 15;
        const v4u q8 = *(const v4u*)(proj + (row0 + t) * PROJP + C_QG + hd * GDK + cch * 8), k8 = *(const v4u*)(proj + (row0 + t) * PROJP + C_KG + hd * GDK + cch * 8);
        const f32x4 c0 = *(const LAS f32x4*)(cumt + t * 128 + cch * 8), c1 = *(const LAS f32x4*)(cumt + t * 128 + cch * 8 + 4);
        v4u qo, ko;
#pragma unroll
        for (int e2 = 0; e2 < 4; ++e2) { const float ca = e2 < 2 ? c0[2 * e2] : c1[2 * e2 - 4], cb = e2 < 2 ? c0[2 * e2 + 1] : c1[2 * e2 - 3];
            const float ea = __expf(ca), eb = __expf(cb), ia = __builtin_amdgcn_rcpf(ea), ib = __builtin_amdgcn_rcpf(eb);
            const float qa = __uint_as_float(q8[e2] << 16), qb = __uint_as_float(q8[e2] & 0xffff0000u), ka = __uint_as_float(k8[e2] << 16), kb2 = __uint_as_float(k8[e2] & 0xffff0000u);
            qo[e2] = pkbf(qa * 0.08838834764831845f * ea, qb * 0.08838834764831845f * eb); ko[e2] = pkbf(ka * ia, kb2 * ib); }
        const size_t gi = (row0 + t) * 512 + hd * GDK + cch * 8;
        *(v4u*)(qdg + gi) = qo; *(v4u*)(kig + gi) = ko;
        *(LAS v4u*)(kit + offb(t, cch)) = ko; }
    __syncthreads();
    const unsigned vbase = (unsigned)(size_t)vt + (wave >> 2) * 16384, kbase = (unsigned)(size_t)kit;
    const unsigned h = lane >> 5, blk = (lane >> 4) & 1, q4 = (lane & 15) >> 2, p4 = lane & 3;
    f32x16 U[4];
#pragma unroll
    for (int db = 0; db < 4; ++db)
#pragma unroll
        for (int i = 0; i < 16; ++i) U[db][i] = 0.f;
#pragma unroll
    for (int ks = 0; ks < 4; ++ks) {
        const unsigned r0 = 16 * ks + 8 * h + q4, r1 = r0 + 4, cc = 2 * blk + (p4 >> 1), bo = 8 * (p4 & 1);
        s16x4 a0, a1; tr_read2(vbase + offb(r0, 4 * (wave & 3) + cc) + bo, vbase + offb(r1, 4 * (wave & 3) + cc) + bo, a0, a1);
        const bf16x8 Af = __builtin_shufflevector(a0, a1, 0, 1, 2, 3, 4, 5, 6, 7);
#pragma unroll
        for (int db = 0; db < 4; ++db) { s16x4 b0, b1; tr_read2(kbase + offb(r0, 4 * db + cc) + bo, kbase + offb(r1, 4 * db + cc) + bo, b0, b1);
            U[db] = __builtin_amdgcn_mfma_f32_32x32x16_bf16(Af, __builtin_shufflevector(b0, b1, 0, 1, 2, 3, 4, 5, 6, 7), U[db], 0, 0, 0); }
    }
    bf16* up = Ug + (size_t)unit * 32768;
#pragma unroll
    for (int db = 0; db < 4; ++db)
#pragma unroll
        for (int i = 0; i < 16; ++i) up[(size_t)(32 * wave + (i & 3) + 8 * (i >> 2) + 4 * h) * 128 + 32 * db + (lane & 31)] = f2bf(U[db][i]);
}
__device__ __forceinline__ void gla_pass3_pair(LAS unsigned char* sm, const bf16* __restrict__ proj, const bf16* __restrict__ qdg, const bf16* __restrict__ kig, const bf16* __restrict__ Sg,
                                               const float* __restrict__ gain, const float* __restrict__ br, bf16* __restrict__ cat, int unit0, int unit1, int tid, int wave, int lane) {
    LAS float* nt = (LAS float*)(sm + 65536);
    const int ug = wave >> 2, gwv = wave & 3, unit = ug ? unit1 : unit0;
    const int c = unit & 31, hd = (unit >> 5) & 3, b = unit >> 7;
    const size_t row0 = (size_t)b * SEQ + c * CHUNK;
    __syncthreads();
#pragma unroll
    for (int i = 0; i < 8; ++i) { const int id = i * 512 + tid, tl = id >> 11, rem = id & 2047, row = rem >> 5, ch = rem & 31; const int us = tl ? unit1 : unit0;
        const size_t r0s = (size_t)(us >> 7) * SEQ + (us & 31) * CHUNK; const int hs = (us >> 5) & 3;
        const v4u x = *(const v4u*)(proj + (r0s + row) * PROJP + C_VG + hs * GDV + ch * 8);
        *(LAS v4u*)(sm + tl * 32768 + (ch >> 4) * 16384 + offb(row, ch & 15)) = x; }
    LAS unsigned char* vt = sm + ug * 32768;
    const int tb = gwv & 1, dq2 = gwv >> 1, r = lane & 31, h = lane >> 5, t = 32 * tb + r;
    bf16x8 Bq[8];
#pragma unroll
    for (int ks = 0; ks < 8; ++ks) Bq[ks] = *(const bf16x8*)(qdg + (row0 + t) * 512 + hd * GDK + 16 * ks + 8 * h);
    f32x16 O[4];
#pragma unroll
    for (int dvb = 0; dvb < 4; ++dvb)
#pragma unroll
        for (int i = 0; i < 16; ++i) O[dvb][i] = 0.f;
    const bf16* Sp = Sg + (size_t)unit * 32768;
    bf16x8 Kf0[8];
#pragma unroll
    for (int ks = 0; ks < 8; ++ks) Kf0[ks] = *(const bf16x8*)(kig + (row0 + r) * 512 + hd * GDK + 16 * ks + 8 * h);
#pragma unroll
    for (int dvb = 0; dvb < 4; ++dvb)
#pragma unroll
        for (int ks = 0; ks < 8; ++ks) { const bf16x8 Sf = *(const bf16x8*)(Sp + (size_t)(32 * (4 * dq2 + dvb) + r) * 128 + 16 * ks + 8 * h);
            O[dvb] = __builtin_amdgcn_mfma_f32_32x32x16_bf16(Sf, Bq[ks], O[dvb], 0, 0, 0); }
    __syncthreads();
    const unsigned blk = (lane >> 4) & 1, q4 = (lane & 15) >> 2, p4 = lane & 3;
    v2u rgp[4][4];
#pragma unroll
    for (int dvb = 0; dvb < 4; ++dvb)
#pragma unroll
        for (int g = 0; g < 4; ++g) rgp[dvb][g] = *(const v2u*)(proj + (row0 + t) * PROJP + C_RG + hd * GDV + 32 * (4 * dq2 + dvb) + 8 * g + 4 * h);
    for (int sb = 0; sb <= tb; ++sb) {
        f32x16 ST;
#pragma unroll
        for (int i = 0; i < 16; ++i) ST[i] = 0.f;
#pragma unroll
        for (int ks = 0; ks < 8; ++ks) { const bf16x8 Kf = (sb == 0) ? Kf0[ks] : *(const bf16x8*)(kig + (row0 + 32 * sb + r) * 512 + hd * GDK + 16 * ks + 8 * h);
            ST = __builtin_amdgcn_mfma_f32_32x32x16_bf16(Kf, Bq[ks], ST, 0, 0, 0); }
        const bool diag = (sb == tb);
        float w[16];
#pragma unroll
        for (int i = 0; i < 16; ++i) { const int sl = (i & 3) + 8 * (i >> 2) + 4 * h; w[i] = (!diag || sl <= r) ? ST[i] : 0.f; }
#pragma unroll
        for (int s2 = 0; s2 < 2; ++s2) {
            v4u wp; wp.x = pkbf(w[8 * s2], w[8 * s2 + 1]); wp.y = pkbf(w[8 * s2 + 2], w[8 * s2 + 3]); wp.z = pkbf(w[8 * s2 + 4], w[8 * s2 + 5]); wp.w = pkbf(w[8 * s2 + 6], w[8 * s2 + 7]);
            const bf16x8 Wf = __builtin_bit_cast(bf16x8, wp);
            const unsigned rb0 = 32 * sb + 16 * s2 + 4 * h + q4, rb1 = rb0 + 8, cb = 2 * blk + (p4 >> 1), bo = 8 * (p4 & 1);
            const unsigned base = (unsigned)(size_t)vt + dq2 * 16384 + bo;
            s16x4 v0a, v0b, v1a, v1b, v2a, v2b, v3a, v3b;
            tr_read8(base + offb(rb0, cb), base + offb(rb1, cb), base + offb(rb0, 4 + cb), base + offb(rb1, 4 + cb), base + offb(rb0, 8 + cb), base + offb(rb1, 8 + cb), base + offb(rb0, 12 + cb), base + offb(rb1, 12 + cb),
                     v0a, v0b, v1a, v1b, v2a, v2b, v3a, v3b);
            O[0] = __builtin_amdgcn_mfma_f32_32x32x16_bf16(__builtin_shufflevector(v0a, v0b, 0, 1, 2, 3, 4, 5, 6, 7), Wf, O[0], 0, 0, 0);
            O[1] = __builtin_amdgcn_mfma_f32_32x32x16_bf16(__builtin_shufflevector(v1a, v1b, 0, 1, 2, 3, 4, 5, 6, 7), Wf, O[1], 0, 0, 0);
            O[2] = __builtin_amdgcn_mfma_f32_32x32x16_bf16(__builtin_shufflevector(v2a, v2b, 0, 1, 2, 3, 4, 5, 6, 7), Wf, O[2], 0, 0, 0);
            O[3] = __builtin_amdgcn_mfma_f32_32x32x16_bf16(__builtin_shufflevector(v3a, v3b, 0, 1, 2, 3, 4, 5, 6, 7), Wf, O[3], 0, 0, 0);
        }
    }
    float ss = 0.f;
#pragma unroll
    for (int dvb = 0; dvb < 4; ++dvb)
#pragma unroll
        for (int i = 0; i < 16; ++i) ss += O[dvb][i] * O[dvb][i];
    ss += __shfl_xor(ss, 32);
    if (h == 0) nt[(ug * 64 + t) * 2 + dq2] = ss;
    __syncthreads();
    const float rs = rsqrtf((nt[(ug * 64 + t) * 2] + nt[(ug * 64 + t) * 2 + 1]) * (1.0f / GDV) + EPS);
#pragma unroll
    for (int dvb = 0; dvb < 4; ++dvb) { unsigned w[4][2];
#pragma unroll
        for (int g = 0; g < 4; ++g) { const int cidx = hd * GDV + 32 * (4 * dq2 + dvb) + 8 * g + 4 * h;
            const v2u rg = rgp[dvb][g]; const f32x4 gv = *(const f32x4*)(gain + cidx), bv = *(const f32x4*)(br + cidx);
            const float rr[4] = {__uint_as_float(rg.x << 16) + bv[0], __uint_as_float(rg.x & 0xffff0000u) + bv[1], __uint_as_float(rg.y << 16) + bv[2], __uint_as_float(rg.y & 0xffff0000u) + bv[3]};
            float y[4];
#pragma unroll
            for (int i = 0; i < 4; ++i) y[i] = O[dvb][4 * g + i] * rs * gv[i] * (rr[i] / (1.f + __expf(-rr[i])));
            w[g][0] = pkbf(y[0], y[1]); w[g][1] = pkbf(y[2], y[3]); }
        const v2u s0 = __builtin_amdgcn_permlane32_swap(w[0][0], w[1][0], false, false), s1 = __builtin_amdgcn_permlane32_swap(w[0][1], w[1][1], false, false);
        const v2u s2 = __builtin_amdgcn_permlane32_swap(w[2][0], w[3][0], false, false), s3 = __builtin_amdgcn_permlane32_swap(w[2][1], w[3][1], false, false);
        bf16* op = cat + (row0 + t) * D + 1024 + hd * GDV + 32 * (4 * dq2 + dvb) + 8 * h;
        *(v4u*)op = (v4u){s0.x, s1.x, s0.y, s1.y}; *(v4u*)(op + 16) = (v4u){s2.x, s3.x, s2.y, s3.y}; }
}

__device__ __forceinline__ void proj_tail_item(LAS unsigned char* sm, const bf16* __restrict__ h0, const bf16* __restrict__ WinT, bf16* __restrict__ proj, int item, int tid, int wave, int lane) {
    LAS float* red = (LAS float*)sm;
    const int fr = lane & 15, kg = lane >> 4; const size_t row0 = (size_t)item * 64;
    f32x4 acc[4];
#pragma unroll
    for (int mt = 0; mt < 4; ++mt) acc[mt] = (f32x4){0.f, 0.f, 0.f, 0.f};
    __syncthreads();
#pragma unroll
    for (int ks = 0; ks < 8; ++ks) { const int k0 = 256 * wave + 32 * ks + 8 * kg;
        const bf16x8 Bf = *(const bf16x8*)(WinT + (size_t)(6144 + fr) * D + k0);
#pragma unroll
        for (int mt = 0; mt < 4; ++mt) { const bf16x8 Af = *(const bf16x8*)(h0 + (row0 + 16 * mt + fr) * D + k0); acc[mt] = __builtin_amdgcn_mfma_f32_16x16x32_bf16(Af, Bf, acc[mt], 0, 0, 0); } }
#pragma unroll
    for (int mt = 0; mt < 4; ++mt)
#pragma unroll
        for (int jj = 0; jj < 4; ++jj) red[(wave * 64 + 16 * mt + 4 * kg + jj) * 16 + fr] = acc[mt][jj];
    __syncthreads();
#pragma unroll
    for (int i = 0; i < 2; ++i) { const int o = i * 512 + tid; float a = 0.f;
#pragma unroll
        for (int w8 = 0; w8 < 8; ++w8) a += red[w8 * 1024 + o];
        proj[(row0 + (o >> 4)) * PROJP + 6144 + (o & 15)] = f2bf(a); }
}

struct Args { const float* in[24]; float* out; unsigned char* ws; int ph_lo, ph_hi; };
__global__ void __launch_bounds__(NWAVES * 64, 2) mk_fwd(Args args) {
    extern __shared__ __attribute__((aligned(16))) unsigned char lds[];
    Frame F;
    F.lds = (LAS unsigned char*)lds; F.MISC = (volatile LAS unsigned*)(F.lds + MISC_OFF);
    F.tid = threadIdx.x; F.lane = F.tid & 63; F.wave = __builtin_amdgcn_readfirstlane(F.tid >> 6);
    F.G = gridDim.x; { const int bx = blockIdx.x; F.vcu = (F.G % 8 == 0) ? (bx % 8) * (F.G / 8) + bx / 8 : bx; }
    F.ws = args.ws; F.ctl = (unsigned*)(args.ws + WS_CTL);
    for (int u = F.tid; u < (LDS_BYTES - LDSCTL_OFF) / 4; u += NWAVES * 64) ((LAS unsigned*)(F.lds + LDSCTL_OFF))[u] = 0u;
    __syncthreads();
    const int lo = args.ph_lo, hi = args.ph_hi;
    const bool multi = (hi - lo) > 1;
    XcdBarrier bar; bar.bar = F.ctl + CW_BAR; bar.x = 0; bar.st = nullptr;
    if (multi) bar = xcd_barrier_post(F.ctl + CW_BAR, F.MISC + 8);
#ifndef DUP_PHASE
#define DUP_PHASE -1
#endif
#define IN(k) (lo <= (k) && (k) < hi)
#define REP(k) for (int rep_ = 0; rep_ < ((DUP_PHASE) == (k) ? 2 : 1); ++rep_)
#define SEAM(k) do { if (IN(k) && IN((k) + 1)) xcd_barrier(bar); } while (0)
    const float* const* in = args.in;
    unsigned char* ws = args.ws;
    bf16* WinT = (bf16*)(ws + WS_WIN); bf16* WoutT = (bf16*)(ws + WS_WOUT); bf16* WxqT = (bf16*)(ws + WS_WXQ); bf16* WxkvT = (bf16*)(ws + WS_WXKV); bf16* WxoT = (bf16*)(ws + WS_WXO);
    bf16* h0 = (bf16*)(ws + WS_H0); bf16* hm = (bf16*)(ws + WS_HM); bf16* projb = (bf16*)(ws + WS_PROJ); float* alr = (float*)(ws + WS_ALR);
    bf16* KVb = (bf16*)(ws + WS_KV); bf16* MKT = (bf16*)(ws + WS_MKT); bf16* NVT = (bf16*)(ws + WS_NVT);
    bf16* catb = (bf16*)(ws + WS_CAT); float* x1 = (float*)(ws + WS_X1); bf16* x1b = (bf16*)(ws + WS_X1B); bf16* qx = (bf16*)(ws + WS_QX); bf16* oxb = (bf16*)(ws + WS_OX); bf16* x2b = (bf16*)(ws + WS_X2);
    bf16* Pb = (bf16*)(ws + WS_PB);
    bf16* hf = (bf16*)(ws + WS_HF); bf16* Hb = (bf16*)(ws + WS_HB); bf16* Yb = (bf16*)(ws + WS_YB);
    bf16* WrHi = (bf16*)(ws + WS_WR); bf16* WrLo = (bf16*)(ws + WS_WR + 512 * 1024); int* elist = (int*)(ws + WS_LIST); float* gatev = (float*)(ws + WS_GATE); int* ecnt = (int*)(F.ctl + CW_CNT);
    float* rowsq1 = (float*)(F.ctl + CW_ROWSQ1); float* rowsq2 = (float*)(F.ctl + CW_ROWSQ2);

    if (IN(0)) REP(0) {
        LAS float* scr = (LAS float*)(F.lds + RING_OFF + F.wave * 18432);
        const int gw = F.vcu * NWAVES + F.wave, NGW = F.G * NWAVES;
        constexpr int KB = D / 64;
        constexpr int I_IN = KB * ((PROJ + 63) / 64), I_KV = KB * (2 * D / 64);
        constexpr int NITEMS = I_IN + I_KV;
        for (int it = gw; it < NITEMS; it += NGW) {
            if (it < I_IN) p0_transpose_item(in[3], D, PROJ, PROJ, nullptr, WinT, 0, scr, it, F.lane);
            else p0_transpose_item(in[13], D, 2 * D, 2 * D, nullptr, WxkvT, 0, scr, it - I_IN, F.lane);
        }
        { const size_t z0 = (size_t)(((PROJ + 63) / 64) * 64) * D, z1 = (size_t)PROJP * D; v4u zz = {0u, 0u, 0u, 0u};
          for (size_t i = z0 / 8 + (size_t)blockIdx.x * 512 + F.tid; i < z1 / 8; i += (size_t)F.G * 512) ((v4u*)WinT)[i] = zz; }
        for (int i = blockIdx.x * 512 + F.tid; i < 80 * D; i += F.G * 512) { const int n = i / D, k = i % D; const float v = n < 8 ? in[16][k * 8 + n] : (n < 72 ? in[18][k * 64 + n - 8] : 0.f);
            const int j = ((((k >> 5) * 5 + (n >> 4)) * 64) + ((k & 31) >> 3) * 16 + (n & 15)) * 8 + (k & 7);
            const unsigned short hi = f2bf(v); WrHi[j] = hi; WrLo[j] = f2bf(v - bf2f(hi)); }
        for (int m = gw; m < NTOK; m += NGW) rms_row_to_bf16(in[0] + (size_t)m * D, in[2], h0 + (size_t)m * D, F.lane);
        for (int m = gw; m < NMEM; m += NGW) rms_row_to_bf16(in[1] + (size_t)m * D, in[11], hm + (size_t)m * D, F.lane);
    }
    SEAM(0);
    if (IN(1)) REP(1) {
        pg8::DenseSched S{(const char*)h0, (const char*)WinT, D * 2, D * 2, D, NTOK / 256, 24, F.G, (int)blockIdx.x};
        EpiProj E{projb, alr};
        pg8::gemm_phase<EpiProj, pg8::DenseSched, true>(F.lds + RING_OFF, S, E);
    }
    SEAM(1);
    if (IN(2)) REP(2) {
        { pg8::DenseSched S{(const char*)hm, (const char*)WxkvT, D * 2, D * 2, D, NMEM / 256, 2 * D / 256, F.G, (int)blockIdx.x};
          EpiBf16 E{KVb, 2 * D};
          pg8::gemm_phase<EpiBf16, pg8::DenseSched, true>(F.lds + RING_OFF, S, E); }
        { const int first = (F.G > 64 + 32) ? 64 : 0, nl = F.G - first, li = (int)blockIdx.x - first;
          if (li >= 0) { LAS float* scr = (LAS float*)(F.lds + RING_OFF + F.wave * 18432);
              constexpr int I_SQ = (D / 64) * (D / 64);
              for (int it = li * NWAVES + F.wave; it < 2 * I_SQ; it += nl * NWAVES) {
                  if (it < I_SQ) p0_transpose_item(in[9], D, D, D, nullptr, WoutT, 0, scr, it, F.lane);
                  else p0_transpose_item(in[14], D, D, D, nullptr, WxoT, 0, scr, it - I_SQ, F.lane); }
              for (int i = li * 512 + F.tid; i < D * D / 4; i += nl * 512) { const f32x4 v = ((const f32x4*)in[12])[i]; const float g = in[10][i / (D / 4)]; v2u o; o.x = pkbf(v[0] * g, v[1] * g); o.y = pkbf(v[2] * g, v[3] * g); ((v2u*)WxqT)[i] = o; } } }
        for (;;) {
            if (F.tid == 0) F.MISC[20] = (unsigned)__hip_atomic_fetch_add(F.ctl + CW_Q + 128, 1u, __ATOMIC_RELAXED, __HIP_MEMORY_SCOPE_AGENT);
            __syncthreads();
            const int item = (int)F.MISC[20];
            __syncthreads();
            if (item >= NTOK / 64) break;
            proj_tail_item(F.lds + RING_OFF, h0, WinT, projb, item, F.tid, F.wave, F.lane);
        }
        for (;;) {
            if (F.tid == 0) F.MISC[20] = (unsigned)__hip_atomic_fetch_add(F.ctl + CW_Q, 1u, __ATOMIC_RELAXED, __HIP_MEMORY_SCOPE_AGENT);
            __syncthreads();
            const int item = (int)F.MISC[20];
            __syncthreads();
            if (item >= 512) break;
            gla_pass1_unit(F.lds + RING_OFF, projb, alr, in[4], in[5], (bf16*)(ws + WS_GQD), (bf16*)(ws + WS_GKI), (float*)(ws + WS_GEL), (bf16*)(ws + WS_GU), item, F.tid, F.wave, F.lane);
        }
        for (;;) {
            if (F.tid == 0) F.MISC[20] = (unsigned)__hip_atomic_fetch_add(F.ctl + CW_Q + 64, 1u, __ATOMIC_RELAXED, __HIP_MEMORY_SCOPE_AGENT);
            __syncthreads();
            const int item = (int)F.MISC[20];
            __syncthreads();
            if (item >= BATCH * SBH * (SEQ / 32) / NWAVES) break;
            sb_wg_unit(F.lds + RING_OFF, projb, in[7], catb, item, F.wave, F.lane);
        }
    }
    SEAM(2);
    if (IN(3)) REP(3) {
        { MktSched S{(const char*)KVb, (const char*)WxqT, D * 2, XD, F.G, (int)blockIdx.x}; EpiBf16 E{MKT, D};
          pg8::gemm_phase<EpiBf16, MktSched, true>(F.lds + RING_OFF, S, E); }
        { NvtSched S{(const char*)WxoT, (const char*)KVb, 2 * D * 2, XD, F.G, ((int)blockIdx.x + F.G - 128) % F.G}; EpiBf16 E{NVT, 1024};
          pg8::gemm_phase<EpiBf16, NvtSched, true>(F.lds + RING_OFF, S, E); }
        const bf16* Ug = (const bf16*)(ws + WS_GU); const float* elg = (const float*)(ws + WS_GEL); bf16* Sg = (bf16*)(ws + WS_GS);
        for (int g = blockIdx.x * 512 + F.tid; g < BATCH * GH * 8192; g += F.G * 512) { const int bh = g >> 13, idx = g & 8191, dk = (idx & 31) * 4;
            f32x4 S4 = {0.f, 0.f, 0.f, 0.f};
#pragma unroll 8
            for (int c = 0; c < 32; ++c) { const size_t u = (size_t)bh * 32 + c; const v2u ub = __builtin_nontemporal_load((const v2u*)(Ug + u * 32768 + (size_t)idx * 4)); const f32x4 u4 = {__uint_as_float(ub.x << 16), __uint_as_float(ub.x & 0xffff0000u), __uint_as_float(ub.y << 16), __uint_as_float(ub.y & 0xffff0000u)}, e4 = *(const f32x4*)(elg + u * 128 + dk);
                v2u o; o.x = pkbf(S4[0], S4[1]); o.y = pkbf(S4[2], S4[3]); *(v2u*)(Sg + u * 32768 + (size_t)idx * 4) = o;
                S4 = (S4 + u4) * e4; } }
    }
    SEAM(3);
    if (IN(4)) REP(4) {
        for (int unit = blockIdx.x; unit < 512; unit += 2 * F.G)
            gla_pass3_pair(F.lds + RING_OFF, projb, (const bf16*)(ws + WS_GQD), (const bf16*)(ws + WS_GKI), (const bf16*)(ws + WS_GS), in[8], in[6], catb, unit, (unit + F.G < 512) ? unit + F.G : unit, F.tid, F.wave, F.lane);
    }
    SEAM(4);
    if (IN(5)) REP(5) {
        pg8::DenseSched S{(const char*)catb, (const char*)WoutT, D * 2, D * 2, D, NTOK / 256, D / 256, F.G, (int)blockIdx.x};
        EpiResid E{in[0], nullptr, nullptr, x1b, rowsq1};
        pg8::gemm_phase<EpiResid, pg8::DenseSched, false>(F.lds + RING_OFF, S, E);
    }
    SEAM(5);
    if (IN(6)) REP(6) {
        EpiSoftmax128 E{Pb, (LAS float*)(F.lds + LDSCTL_OFF + 1024), rowsq1};
        for (int c = blockIdx.x; c < 256; c += F.G) { const int hp = 8 * (c & 7) + (c >> 5), h = (c >> 3) & 3, b = hp >> 4;
            pg8::Unit u; u.pm = hp; u.pn = h; u.z = c; u.mv = 128; u.A = (const char*)x1b + (size_t)hp * 128 * D * 2; u.B = (const char*)MKT + (size_t)(b * 1024 + h * 256) * D * 2;
            pg8::gemm128_unit<EpiSoftmax128>(F.lds + RING_OFF, u.A, D * 2, u.B, D * 2, D, E, u); }
    }
    SEAM(6);
    if (IN(7)) REP(7) {
        XOutSched S{(const char*)Pb, (const char*)NVT, 1024 * 2, 1024, F.G, (int)blockIdx.x};
        EpiResid E{nullptr, x1b, nullptr, x2b, rowsq2};
        pg8::gemm_phase<EpiResid, XOutSched, false>(F.lds + RING_OFF, S, E);
    }
    SEAM(7);
    if (IN(8)) REP(8) {
        LAS float* red = (LAS float*)(F.lds + RING_OFF);
        LAS float* lg = (LAS float*)(F.lds + RING_OFF + 81920);
        const int kg = F.lane >> 4, fr = F.lane & 15;
        for (int tile = blockIdx.x; tile < NTOK / 32; tile += F.G) {
            const int row0 = tile * 32;
            f32x4 racc[2][5];
#pragma unroll
            for (int rt = 0; rt < 2; ++rt)
#pragma unroll
                for (int nt = 0; nt < 5; ++nt) racc[rt][nt] = (f32x4){0.f, 0.f, 0.f, 0.f};
            float rs[2];
#pragma unroll
            for (int rt = 0; rt < 2; ++rt) rs[rt] = rsqrtf(rowsq2[row0 + 16 * rt + fr] * (1.0f / D) + EPS);
            for (int kh = 0; kh < 4; ++kh) {
                v4u xa[2][2];
#pragma unroll
                for (int k4 = 0; k4 < 2; ++k4)
#pragma unroll
                    for (int rt = 0; rt < 2; ++rt) { const size_t ro = (size_t)(row0 + 16 * rt + fr) * D + 256 * F.wave + 32 * (2 * kh + k4) + 8 * kg; xa[k4][rt] = __builtin_nontemporal_load((const v4u*)(x2b + ro)); }
#pragma unroll
                for (int k4 = 0; k4 < 2; ++k4) {
                    const int k0 = 256 * F.wave + 32 * (2 * kh + k4) + 8 * kg;
                    const f32x4 g0 = *(const f32x4*)(in[15] + k0), g1 = *(const f32x4*)(in[15] + k0 + 4);
                    bf16x8 Ahi[2], Alo[2];
#pragma unroll
                    for (int rt = 0; rt < 2; ++rt) { const size_t ro = (size_t)(row0 + 16 * rt + fr) * D + k0; const v4u xb = xa[k4][rt]; const f32x4 a0 = {__uint_as_float(xb.x << 16), __uint_as_float(xb.x & 0xffff0000u), __uint_as_float(xb.y << 16), __uint_as_float(xb.y & 0xffff0000u)}, a1 = {__uint_as_float(xb.z << 16), __uint_as_float(xb.z & 0xffff0000u), __uint_as_float(xb.w << 16), __uint_as_float(xb.w & 0xffff0000u)};
                        float v[8]; v[0] = a0[0] * rs[rt] * g0[0]; v[1] = a0[1] * rs[rt] * g0[1]; v[2] = a0[2] * rs[rt] * g0[2]; v[3] = a0[3] * rs[rt] * g0[3];
                        v[4] = a1[0] * rs[rt] * g1[0]; v[5] = a1[1] * rs[rt] * g1[1]; v[6] = a1[2] * rs[rt] * g1[2]; v[7] = a1[3] * rs[rt] * g1[3];
                        v4u hp, lp;
#pragma unroll
                        for (int j = 0; j < 4; ++j) { const unsigned hpk = pkbf(v[2 * j], v[2 * j + 1]); hp[j] = hpk; lp[j] = pkbf(v[2 * j] - __uint_as_float(hpk << 16), v[2 * j + 1] - __uint_as_float(hpk & 0xffff0000u)); }
                        *(v4u*)(hf + ro) = hp; Ahi[rt] = __builtin_bit_cast(bf16x8, hp); Alo[rt] = __builtin_bit_cast(bf16x8, lp); }
#pragma unroll
                    for (int nt = 0; nt < 5; ++nt) { const size_t bo = (size_t)((((8 * F.wave + 2 * kh + k4) * 5 + nt) * 64 + F.lane) * 8); const bf16x8 Bh = *(const bf16x8*)(WrHi + bo), Bl = *(const bf16x8*)(WrLo + bo);
#pragma unroll
                        for (int rt = 0; rt < 2; ++rt) { racc[rt][nt] = __builtin_amdgcn_mfma_f32_16x16x32_bf16(Ahi[rt], Bh, racc[rt][nt], 0, 0, 0);
                            racc[rt][nt] = __builtin_amdgcn_mfma_f32_16x16x32_bf16(Alo[rt], Bh, racc[rt][nt], 0, 0, 0); racc[rt][nt] = __builtin_amdgcn_mfma_f32_16x16x32_bf16(Ahi[rt], Bl, racc[rt][nt], 0, 0, 0); } }
                }
            }
#pragma unroll
            for (int rt = 0; rt < 2; ++rt)
#pragma unroll
                for (int nt = 0; nt < 5; ++nt)
#pragma unroll
                    for (int j = 0; j < 4; ++j) red[(F.wave * 32 + 16 * rt + 4 * kg + j) * 80 + 16 * nt + fr] = racc[rt][nt][j];
            __syncthreads();
            for (int o = F.tid; o < 32 * 80; o += 512) { float a = 0.f;
#pragma unroll
                for (int w8 = 0; w8 < 8; ++w8) a += red[w8 * 2560 + o]; lg[o] = a; }
            __syncthreads();
            if (F.tid < 32) { const int tkn = row0 + F.tid; const LAS float* l = lg + F.tid * 80;
                int g = 0; float mg = l[0] + in[17][0];
                for (int i = 1; i < 8; ++i) { const float v = l[i] + in[17][i]; if (v > mg) { mg = v; g = i; } }
                float sg = 0.f; for (int i = 0; i < 8; ++i) sg += __expf(l[i] + in[17][i] - mg);
                const float ptop = 1.f / sg;
                int i1 = 0; float m1 = l[8 + g * 8] + in[19][g * 8];
                for (int i = 1; i < 8; ++i) { const float v = l[8 + g * 8 + i] + in[19][g * 8 + i]; if (v > m1) { m1 = v; i1 = i; } }
                int i2 = 0; float m2 = -3.4e38f;
                for (int i = 0; i < 8; ++i) { const float v = l[8 + g * 8 + i] + in[19][g * 8 + i]; if (i != i1 && v > m2) { m2 = v; i2 = i; } }
                const float rr = __expf(m2 - m1), w1 = 1.f / (1.f + rr), w2 = rr / (1.f + rr);
                const int e1 = g * 8 + i1, e2 = g * 8 + i2;
                const int s1 = atomicAdd(&ecnt[e1 * 64], 1), s2 = atomicAdd(&ecnt[e2 * 64], 1);
                elist[(size_t)e1 * NTOK + s1] = tkn * 2; gatev[tkn * 2] = ptop * w1;
                elist[(size_t)e2 * NTOK + s2] = tkn * 2 + 1; gatev[tkn * 2 + 1] = ptop * w2; }
            __syncthreads();
        }
    }
    const bool pre9 = IN(8) && IN(9), pre10 = IN(9) && IN(10);
    if (pre9) xcd_barrier_pf(bar, [&]() { moe_prefetch<0>(F.lds + RING_OFF, in[20], in[21], F.wave, F.lane); });
    if (IN(9)) REP(9) {
        moe_stream_wg<0>(F.lds + RING_OFF, (const char*)hf, D * 2, 1, in[20], in[21], elist, ecnt, Hb, nullptr, F.G, pre9 && rep_ == 0, F.tid, F.wave, F.lane);
    }
    if (pre10) xcd_barrier_pf(bar, [&]() { moe_prefetch<1>(F.lds + RING_OFF, in[22], nullptr, F.wave, F.lane); });
    if (IN(10)) REP(10) {
        moe_stream_wg<1>(F.lds + RING_OFF, (const char*)Hb, FF * 2, 0, in[22], nullptr, elist, ecnt, Yb, gatev, F.G, pre10 && rep_ == 0, F.tid, F.wave, F.lane);
    }
    SEAM(10);
    if (IN(11)) REP(11) {
        const int gw = F.vcu * NWAVES + F.wave, NGW = F.G * NWAVES;
        v2u ra[8], rb[8], rx[8];
#define P11_LOAD(m_, A_, B_, X_) do { const v2u* xr_ = (const v2u*)(x2b + (size_t)(m_) * D) + F.lane; const v2u* y0_ = (const v2u*)(Yb + (size_t)(2 * (m_)) * D) + F.lane; const v2u* y1_ = (const v2u*)(Yb + (size_t)(2 * (m_) + 1) * D) + F.lane; \
            _Pragma("unroll") for (int j = 0; j < 8; ++j) { A_[j] = __builtin_nontemporal_load(y0_ + 64 * j); B_[j] = __builtin_nontemporal_load(y1_ + 64 * j); X_[j] = __builtin_nontemporal_load(xr_ + 64 * j); } } while (0)
        if (gw < NTOK) P11_LOAD(gw, ra, rb, rx);
        for (int m = gw; m < NTOK; m += NGW) {
            v2u na[8], nb2[8], nx[8];
            const int mn = (m + NGW < NTOK) ? m + NGW : m;
            P11_LOAD(mn, na, nb2, nx);
            f32x4 v[8]; float ssq = 0.f;
#pragma unroll
            for (int j = 0; j < 8; ++j) { const v2u a = ra[j], b2 = rb[j], xx = rx[j]; f32x4 t4;
                t4[0] = __uint_as_float(xx.x << 16) + __uint_as_float(a.x << 16) + __uint_as_float(b2.x << 16); t4[1] = __uint_as_float(xx.x & 0xffff0000u) + __uint_as_float(a.x & 0xffff0000u) + __uint_as_float(b2.x & 0xffff0000u);
                t4[2] = __uint_as_float(xx.y << 16) + __uint_as_float(a.y << 16) + __uint_as_float(b2.y << 16); t4[3] = __uint_as_float(xx.y & 0xffff0000u) + __uint_as_float(a.y & 0xffff0000u) + __uint_as_float(b2.y & 0xffff0000u);
                v[j] = t4; ssq += (t4[0] * t4[0] + t4[1] * t4[1]) + (t4[2] * t4[2] + t4[3] * t4[3]); }
            const float rstd = rsqrtf(wave_sum(ssq) * (1.f / D) + EPS);
            f32x4* o4 = (f32x4*)(args.out + (size_t)m * D) + F.lane;
#pragma unroll
            for (int j = 0; j < 8; ++j) { const f32x4 g = ((const f32x4*)in[23])[64 * j + F.lane]; __builtin_nontemporal_store(v[j] * rstd * g, o4 + 64 * j); }
#pragma unroll
            for (int j = 0; j < 8; ++j) { ra[j] = na[j]; rb[j] = nb2[j]; rx[j] = nx[j]; }
        }
#undef P11_LOAD
    }
#undef IN
#undef SEAM
}


extern "C" void kernel_launch(void* const* d_in, const int* in_sizes, int n_in, void* d_out, int out_size, void* d_ws, size_t ws_size, hipStream_t stream) {
    static int grid = 0;
    if (!grid) {
        if (WS_NEW_END > ws_size || n_in != 24) { fprintf(stderr, "kernel_launch: workspace too small (%zu < %zu) or n_in %d != 24\n", ws_size, (size_t)WS_NEW_END, n_in); grid = -1; return; }
        (void)hipFuncSetAttribute((const void*)mk_fwd, hipFuncAttributeMaxDynamicSharedMemorySize, LDS_BYTES);
        int dev = 0, cus = 0, per_cu = 0; (void)hipGetDevice(&dev); (void)hipDeviceGetAttribute(&cus, hipDeviceAttributeMultiprocessorCount, dev);
        (void)hipOccupancyMaxActiveBlocksPerMultiprocessor(&per_cu, (const void*)mk_fwd, NWAVES * 64, LDS_BYTES);
        (void)hipGetLastError();
        grid = cus > 0 ? cus : 256;
        if (per_cu < 1) fprintf(stderr, "kernel_launch: occupancy query reports %d workgroups per CU\n", per_cu);
    }
    if (grid < 0) return;
    (void)hipMemsetAsync((char*)d_ws + WS_CTL, 0, CTL_ZERO_BYTES, stream);
    Args a{};
    for (int i = 0; i < 24; ++i) a.in[i] = (const float*)d_in[i];
    a.out = (float*)d_out; a.ws = (unsigned char*)d_ws; a.ph_lo = 0; a.ph_hi = 12;
#if defined(EXP_LO)
    a.ph_hi = EXP_HI + 1;
    hipLaunchKernelGGL(mk_fwd, dim3(grid), dim3(NWAVES * 64), LDS_BYTES, stream, a);
    (void)hipMemsetAsync((char*)d_ws + WS_CTL + CW_BAR * 4, 0, XCD_BAR_WORDS * 4, stream);
    if (EXP_LO <= 2 && 2 <= EXP_HI) (void)hipMemsetAsync((char*)d_ws + WS_CTL + CW_Q * 4, 0, 1024, stream);
    if (EXP_LO <= 5 && 5 <= EXP_HI) (void)hipMemsetAsync((char*)d_ws + WS_CTL + CW_ROWSQ1 * 4, 0, NTOK * 4, stream);
    if (EXP_LO <= 7 && 7 <= EXP_HI) (void)hipMemsetAsync((char*)d_ws + WS_CTL + CW_ROWSQ2 * 4, 0, NTOK * 4, stream);
    if (EXP_LO <= 8 && 8 <= EXP_HI) (void)hipMemsetAsync((char*)d_ws + WS_CTL + CW_CNT * 4, 0, NE * 256, stream);
    a.ph_lo = EXP_LO; a.ph_hi = 12;
#endif
    hipLaunchKernelGGL(mk_fwd, dim3(grid), dim3(NWAVES * 64), LDS_BYTES, stream, a);
}
```

```cpp
#include <hip/hip_runtime.h>
#include <cstdio>
#include <cstdint>

constexpr int D = 2048, BATCH = 4, SEQ = 2048, NTOK = BATCH * SEQ;
constexpr int MEM = 256, NMEM = BATCH * MEM;
constexpr int PROJ = 6160;
constexpr int C_QSB = 0, C_KSB = 1024, C_VSB = 2048, C_QG = 3072, C_KG = 3584, C_VG = 4096, C_ALR = 5120, C_RG = 5136;
constexpr int SBH = 8, SBD = 128, GH = 4, GDK = 128, GDV = 256, GRANK = 16, CHUNK = 64;
constexpr int XH = 4, XD = 512;
constexpr int NG = 8, EPG = 8, NE = 64, FF = 512, NPAIR = NTOK * 2;
constexpr float EPS = 1e-6f;

typedef short bf16x8 __attribute__((ext_vector_type(8)));
typedef float f32x4 __attribute__((ext_vector_type(4)));

__device__ __forceinline__ unsigned short f2bf(float f) { unsigned u = __float_as_uint(f); u += 0x7fffu + ((u >> 16) & 1u); return (unsigned short)(u >> 16); }

namespace pg8 {
#define PG8_LAS __attribute__((address_space(3)))
typedef unsigned short bf16_t;
typedef unsigned u32x4 __attribute__((ext_vector_type(4)));
typedef unsigned u32x2 __attribute__((ext_vector_type(2)));
constexpr int BM = 256, BK = 64, HALF = 128, HTB = HALF * BK * 2, STAGE_BYTES = 8 * HTB, NXCD = 8, WGM = 8;
__host__ __device__ __forceinline__ int lds_byte(int r, int c) { const int st = (r >> 4) * 2 + (c >> 5), rr = r & 15, cc = c & 31, ob = rr * 64 + cc * 2; return st * 1024 + (ob ^ (((ob >> 9) & 1) << 5)); }
__host__ __device__ __forceinline__ void stage_rc(int b, int& R, int& C) { const int st = b / 1024, sb = b % 1024, swz = sb ^ (((sb >> 9) & 1) << 5); R = (st >> 1) * 16 + swz / 64; C = (st & 1) * 32 + (swz % 64) / 2; }
__host__ __device__ __forceinline__ int perm32(int rho) { const int n = rho >> 4, i = rho & 15; return 8 * (i >> 2) + 4 * n + (i & 3); }
__device__ __forceinline__ unsigned cvt_pk_bf16(float lo, float hi) { unsigned r; asm volatile("v_cvt_pk_bf16_f32 %0, %1, %2" : "=v"(r) : "v"(lo), "v"(hi)); return r; }

struct Unit { const char* A; const char* B; int pm, pn, z, mv; };

__device__ __forceinline__ void tile_order(int L, int nM, int nN, int& pm, int& pn) {
    const int nwg = nM * nN; int wgid = L;
    { const int q = nwg / NXCD, r = nwg % NXCD, xcd = wgid % NXCD, off = wgid / NXCD; wgid = (xcd < r ? xcd * (q + 1) : r * (q + 1) + (xcd - r) * q) + off; }
    const int nig = WGM * nN, gid = wgid / nig, fm = gid * WGM, gsz = (nM - fm) < WGM ? (nM - fm) : WGM;
    pm = fm + ((wgid % nig) % gsz); pn = (wgid % nig) / gsz;
}
struct DenseSched {
    const char* A; const char* Bt; unsigned lda, ldb; int K, nM, nN, G, c;
    __device__ __forceinline__ bool next(int i, Unit& u) const { const long L = (long)i * G + c; if (c < 0 || L >= (long)nM * nN) return false; int pm, pn; tile_order((int)L, nM, nN, pm, pn);
        u.pm = pm; u.pn = pn; u.z = 0; u.mv = 256; u.A = A + (size_t)pm * 256 * lda; u.B = Bt + (size_t)pn * 256 * ldb; return true; }
    __device__ __forceinline__ unsigned arow(const Unit&, int r) const { return (unsigned)r * lda; }
    __device__ __forceinline__ void a_ready(const Unit&) const {}
    __device__ __forceinline__ void done(const Unit&) const {}
};

struct ColTileSched {
    const char* A; const char* Bt; unsigned lda, ldb; int K, nM, pn, G, c;
    __device__ __forceinline__ bool next(int i, Unit& u) const { const long L = (long)i * G + c; if (c < 0 || L >= nM) return false;
        u.pm = (int)L; u.pn = pn; u.z = 0; u.mv = 256; u.A = A + (size_t)L * 256 * lda; u.B = Bt + (size_t)pn * 256 * ldb; return true; }
    __device__ __forceinline__ unsigned arow(const Unit&, int r) const { return (unsigned)r * lda; }
    __device__ __forceinline__ void a_ready(const Unit&) const {}
    __device__ __forceinline__ void done(const Unit&) const {}
};

template <class Epi, class Sched, bool ALIGN_EPI>
__device__ __forceinline__ void gemm_phase(PG8_LAS unsigned char* lds, const Sched& S, const Epi& E) {
    const int tid = threadIdx.x, wid = __builtin_amdgcn_readfirstlane(tid >> 6), lane = tid & 63, wr = wid >> 2, wc = wid & 3, fr = lane & 15, fq = lane >> 4;
    const int nt = S.K / BK;
    int R0, C0, R1, C1; stage_rc(tid * 16, R0, C0); stage_rc(tid * 16 + 8192, R1, C1);
    const int Rb0 = Epi::PERM ? ((R0 & ~31) + perm32(R0 & 31)) : R0, Rb1 = Epi::PERM ? ((R1 & ~31) + perm32(R1 & 31)) : R1;
    const unsigned ldb = S.ldb;
    const unsigned vB0 = (unsigned)Rb0 * ldb + (unsigned)C0 * 2u, vB1 = (unsigned)Rb1 * ldb + (unsigned)C1 * 2u;
    const size_t kstep = (size_t)(BK * 2);
    const size_t hstepB = (size_t)HALF * ldb;
    const unsigned ldsw = (unsigned)wid * 1024u;
    const int aoff = lds_byte(wr * 64 + fr, fq * 8), boff = lds_byte(wc * 32 + fr, fq * 8);
#define PG8_SA(b, h) (((b) * 2 + (h)) * HTB)
#define PG8_SB(b, h) ((4 + (b) * 2 + (h)) * HTB)
#define PG8_STG(bufoff, gbase, v0, v1) do { \
        __builtin_amdgcn_global_load_lds((const unsigned*)((const char*)(gbase) + (v0)), (PG8_LAS unsigned*)(lds + (bufoff) + ldsw), 16, 0, 0); \
        __builtin_amdgcn_global_load_lds((const unsigned*)((const char*)(gbase) + (v1)), (PG8_LAS unsigned*)(lds + (bufoff) + ldsw + 8192), 16, 0, 0); } while (0)
#define PG8_STGB(bufoff, gbase) PG8_STG(bufoff, gbase, vB0, vB1)
#define PG8_LDA(dst, b, h) do { _Pragma("unroll") for (int m = 0; m < 4; ++m) _Pragma("unroll") for (int k = 0; k < 2; ++k) dst[m][k] = *(const PG8_LAS bf16x8*)(lds + PG8_SA(b, h) + aoff + m * 2048 + k * 1024); } while (0)
#define PG8_LDB(dst, b, h) do { _Pragma("unroll") for (int n = 0; n < 2; ++n) _Pragma("unroll") for (int k = 0; k < 2; ++k) dst[n][k] = *(const PG8_LAS bf16x8*)(lds + PG8_SB(b, h) + boff + n * 2048 + k * 1024); } while (0)
#define PG8_MMA(ai, bj, At, Bt) do { __builtin_amdgcn_s_setprio(1); _Pragma("unroll") for (int m = 0; m < 4; ++m) _Pragma("unroll") for (int n = 0; n < 2; ++n) _Pragma("unroll") for (int k = 0; k < 2; ++k) \
        acc[ai][bj][m][n] = __builtin_amdgcn_mfma_f32_16x16x32_bf16(Bt[n][k], At[m][k], acc[ai][bj][m][n], 0, 0, 0); __builtin_amdgcn_s_setprio(0); } while (0)
#define PG8_WAIT_V(n) asm volatile("s_waitcnt vmcnt(" #n ")" ::: "memory")
#define PG8_WAIT_L(n) asm volatile("s_waitcnt lgkmcnt(" #n ")" ::: "memory")
#define PG8_BAR __builtin_amdgcn_s_barrier()
#define PG8_SCHED __builtin_amdgcn_sched_barrier(0)
#define PG8_OFFS(u, o00, o01, o10, o11) do { o00 = S.arow(u, R0) + (unsigned)C0 * 2u; o01 = S.arow(u, R1) + (unsigned)C1 * 2u; o10 = S.arow(u, HALF + R0) + (unsigned)C0 * 2u; o11 = S.arow(u, HALF + R1) + (unsigned)C1 * 2u; } while (0)
    Unit cur, nxt; int ui = 0;
    if (!S.next(0, cur)) return;
    f32x4 acc[2][2][4][2];
#pragma unroll
    for (int a = 0; a < 2; ++a)
#pragma unroll
        for (int b = 0; b < 2; ++b)
#pragma unroll
            for (int m = 0; m < 4; ++m)
#pragma unroll
                for (int n = 0; n < 2; ++n) acc[a][b][m][n] = (f32x4){0.f, 0.f, 0.f, 0.f};
    bf16x8 At[4][2], B0[2][2], B1[2][2];
    const char* cA = cur.A; const char* cB = cur.B;
    unsigned c00, c01, c10, c11; PG8_OFFS(cur, c00, c01, c10, c11);
    S.a_ready(cur);
    PG8_STGB(PG8_SB(0, 0), cB); PG8_STGB(PG8_SB(0, 1), cB + hstepB); PG8_STG(PG8_SA(0, 0), cA, c00, c01); PG8_STG(PG8_SA(0, 1), cA, c10, c11);
    if (wr == 1) PG8_BAR;
    PG8_WAIT_V(2); PG8_BAR;
    PG8_STGB(PG8_SB(1, 0), cB + kstep); PG8_STG(PG8_SA(1, 0), cA + kstep, c00, c01); PG8_STGB(PG8_SB(1, 1), cB + hstepB + kstep);
    PG8_WAIT_V(6); PG8_BAR;
    for (;;) {
        const bool has_next = S.next(ui + 1, nxt);
        const char* nA = has_next ? nxt.A : cA; const char* nB = has_next ? nxt.B : cB;
        unsigned n00 = c00, n01 = c01, n10 = c10, n11 = c11;
        if (has_next) PG8_OFFS(nxt, n00, n01, n10, n11);
        for (int t = 0; t < nt; t += 2) {
            const bool last = (t == nt - 2);
            const char* a1 = cA + (size_t)(t + 1) * kstep;
            const char* a2 = last ? nA : cA + (size_t)(t + 2) * kstep; const char* b2 = last ? nB : cB + (size_t)(t + 2) * kstep;
            const char* a3 = a2 + kstep; const char* b3 = b2 + kstep;
            const unsigned x00 = last ? n00 : c00, x01 = last ? n01 : c01, x10 = last ? n10 : c10, x11 = last ? n11 : c11;
            if (last && has_next) S.a_ready(nxt);
            PG8_LDB(B0, 0, 0); PG8_LDB(B1, 0, 1); PG8_SCHED; PG8_LDA(At, 0, 0); PG8_STG(PG8_SA(1, 1), a1, c10, c11);
            PG8_WAIT_V(8); PG8_WAIT_L(0); PG8_BAR; PG8_MMA(0, 0, At, B0); PG8_MMA(0, 1, At, B1); PG8_BAR; PG8_SCHED;
            PG8_LDA(At, 0, 1); PG8_STGB(PG8_SB(0, 0), b2); PG8_STGB(PG8_SB(0, 1), b2 + hstepB); PG8_STG(PG8_SA(0, 0), a2, x00, x01);
            PG8_WAIT_V(8); PG8_WAIT_L(0); PG8_BAR; PG8_MMA(1, 0, At, B0); PG8_MMA(1, 1, At, B1); PG8_BAR; PG8_SCHED;
            PG8_LDB(B0, 1, 0); PG8_LDB(B1, 1, 1); PG8_SCHED; PG8_LDA(At, 1, 0); PG8_STG(PG8_SA(0, 1), a2, x10, x11);
            PG8_WAIT_V(8); PG8_WAIT_L(0); PG8_BAR; PG8_MMA(0, 0, At, B0); PG8_MMA(0, 1, At, B1); PG8_BAR; PG8_SCHED;
            PG8_LDA(At, 1, 1); PG8_STGB(PG8_SB(1, 0), b3); PG8_STGB(PG8_SB(1, 1), b3 + hstepB); PG8_STG(PG8_SA(1, 0), a3, x00, x01);
            PG8_WAIT_V(8); PG8_WAIT_L(0); PG8_BAR; PG8_MMA(1, 0, At, B0); PG8_MMA(1, 1, At, B1); PG8_BAR; PG8_SCHED;
        }
        if constexpr (ALIGN_EPI) { if (wr == 0) PG8_BAR; }
        if constexpr (!Epi::AFTER_DRAIN) { E(acc, cur, wr, wc, fr, fq); S.done(cur); }
        if (!has_next) break;
#pragma unroll
        for (int a = 0; a < 2; ++a)
#pragma unroll
            for (int b = 0; b < 2; ++b)
#pragma unroll
                for (int m = 0; m < 4; ++m)
#pragma unroll
                    for (int n = 0; n < 2; ++n) acc[a][b][m][n] = (f32x4){0.f, 0.f, 0.f, 0.f};
        cur = nxt; cA = nA; cB = nB; c00 = n00; c01 = n01; c10 = n10; c11 = n11; ++ui;
        if constexpr (ALIGN_EPI) { if (wr == 1) PG8_BAR; }
    }
    PG8_WAIT_V(0);
    if constexpr (!ALIGN_EPI) { if (wr == 0) PG8_BAR; }
    PG8_BAR;
    if constexpr (Epi::AFTER_DRAIN) { E.fused(acc, cur, wr, wc, fr, fq, lds, wid, lane); S.done(cur); }
#undef PG8_SA
#undef PG8_SB
#undef PG8_STG
#undef PG8_STGB
#undef PG8_LDA
#undef PG8_LDB
#undef PG8_MMA
#undef PG8_WAIT_V
#undef PG8_WAIT_L
#undef PG8_BAR
#undef PG8_SCHED
#undef PG8_OFFS
}

template <class Epi>
__device__ __forceinline__ void gemm128_unit(PG8_LAS unsigned char* lds, const char* A, unsigned lda, const char* B, unsigned ldb, int K, const Epi& E, const Unit& u) {
    const int tid = threadIdx.x, wid = __builtin_amdgcn_readfirstlane(tid >> 6), lane = tid & 63, wr = wid >> 2, wc = wid & 3, fr = lane & 15, fq = lane >> 4;
    const int nt = K / BK;
    int R0, C0, R1, C1; stage_rc(tid * 16, R0, C0); stage_rc(tid * 16 + 8192, R1, C1);
    const int Rb0 = (R0 & ~31) + perm32(R0 & 31), Rb1 = (R1 & ~31) + perm32(R1 & 31);
    const unsigned vB0 = (unsigned)Rb0 * ldb + (unsigned)C0 * 2u, vB1 = (unsigned)Rb1 * ldb + (unsigned)C1 * 2u, vA0 = (unsigned)R0 * lda + (unsigned)C0 * 2u, vA1 = (unsigned)R1 * lda + (unsigned)C1 * 2u;
    const size_t hstepB = (size_t)HALF * ldb;
    const unsigned ldsw = (unsigned)wid * 1024u;
    const int aoff = lds_byte(wr * 64 + fr, fq * 8), boff = lds_byte(wc * 32 + fr, fq * 8);
    constexpr int STG3 = 3 * HTB;
#define G8_STG(off, gbase, v0, v1) do { \
        __builtin_amdgcn_global_load_lds((const unsigned*)((const char*)(gbase) + (v0)), (PG8_LAS unsigned*)(lds + (off) + ldsw), 16, 0, 0); \
        __builtin_amdgcn_global_load_lds((const unsigned*)((const char*)(gbase) + (v1)), (PG8_LAS unsigned*)(lds + (off) + ldsw + 8192), 16, 0, 0); } while (0)
#define G8_TILE(so, kt) do { const char* bb_ = B + (size_t)(kt) * (BK * 2); const char* aa_ = A + (size_t)(kt) * (BK * 2); \
        G8_STG((so), bb_, vB0, vB1); G8_STG((so) + HTB, bb_ + hstepB, vB0, vB1); G8_STG((so) + 2 * HTB, aa_, vA0, vA1); } while (0)
#define G8_MMA(bj, Bt) do { __builtin_amdgcn_s_setprio(1); _Pragma("unroll") for (int m = 0; m < 4; ++m) _Pragma("unroll") for (int n = 0; n < 2; ++n) _Pragma("unroll") for (int k = 0; k < 2; ++k) \
        acc[bj][m][n] = __builtin_amdgcn_mfma_f32_16x16x32_bf16(Bt[n][k], At[m][k], acc[bj][m][n], 0, 0, 0); __builtin_amdgcn_s_setprio(0); } while (0)
    f32x4 acc[2][4][2];
#pragma unroll
    for (int b = 0; b < 2; ++b)
#pragma unroll
        for (int m = 0; m < 4; ++m)
#pragma unroll
            for (int n = 0; n < 2; ++n) acc[b][m][n] = (f32x4){0.f, 0.f, 0.f, 0.f};
    bf16x8 At[4][2], B0[2][2], B1[2][2];
    typename Epi::Pre pre; E.prefetch(pre, u, wr, wc, fr, fq);
    G8_TILE(0, 0); G8_TILE(STG3, 1);
    asm volatile("s_waitcnt vmcnt(6)" ::: "memory"); __builtin_amdgcn_s_barrier();
    if (wr == 1) __builtin_amdgcn_s_barrier();
    int so = 0;
    for (int t = 0; t < nt; ++t) {
        const int s2 = (so >= STG3) ? so - STG3 : so + 2 * STG3;
        const int kt2 = (t + 2 < nt) ? t + 2 : 0;
        G8_TILE(s2, kt2);
#pragma unroll
        for (int n = 0; n < 2; ++n)
#pragma unroll
            for (int k = 0; k < 2; ++k) { B0[n][k] = *(const PG8_LAS bf16x8*)(lds + so + boff + n * 2048 + k * 1024); B1[n][k] = *(const PG8_LAS bf16x8*)(lds + so + HTB + boff + n * 2048 + k * 1024); }
#pragma unroll
        for (int m = 0; m < 4; ++m)
#pragma unroll
            for (int k = 0; k < 2; ++k) At[m][k] = *(const PG8_LAS bf16x8*)(lds + so + 2 * HTB + aoff + m * 2048 + k * 1024);
        asm volatile("s_waitcnt vmcnt(6)" ::: "memory"); asm volatile("s_waitcnt lgkmcnt(0)" ::: "memory"); __builtin_amdgcn_s_barrier();
        G8_MMA(0, B0); G8_MMA(1, B1);
        __builtin_amdgcn_s_barrier(); __builtin_amdgcn_sched_barrier(0);
        so = (so == 2 * STG3) ? 0 : so + STG3;
    }
    if (wr == 0) __builtin_amdgcn_s_barrier();
    E(acc, u, wr, wc, fr, fq, pre);
    asm volatile("s_waitcnt vmcnt(0)" ::: "memory"); __builtin_amdgcn_s_barrier();
#undef G8_STG
#undef G8_TILE
#undef G8_MMA
}
}

#define LAS __attribute__((address_space(3)))
typedef unsigned short bf16;
typedef unsigned v4u __attribute__((ext_vector_type(4)));
typedef unsigned v2u __attribute__((ext_vector_type(2)));
#define RLX_AGENT __ATOMIC_RELAXED, __HIP_MEMORY_SCOPE_AGENT
#define LDS_WAIT() asm volatile("s_waitcnt lgkmcnt(0)" ::: "memory")
#define VM_WAIT() asm volatile("s_waitcnt vmcnt(0)" ::: "memory")
__device__ __forceinline__ unsigned pk2(float lo, float hi) { return (unsigned)f2bf(lo) | ((unsigned)f2bf(hi) << 16); }
__device__ __forceinline__ float bf2f(unsigned short b) { return __uint_as_float(((unsigned)b) << 16); }

#define XB_TMO      128
#define XB_XCNT(j)  (256  + 64 * (j))
#define XB_XSUB(j)  (1280 + 64 * (j))
#define XB_XGEN(j)  (2304 + 64 * (j))
#define XB_TOP      3328
#define XB_TOPGEN   3392
#define XCD_BAR_WORDS 3456
#define XB_SPIN_CAP (1u << 18)
__device__ __forceinline__ unsigned xb_ld(unsigned* p)              { return __hip_atomic_load(p, __ATOMIC_RELAXED, __HIP_MEMORY_SCOPE_AGENT); }
__device__ __forceinline__ unsigned xb_add(unsigned* p, unsigned v) { return __hip_atomic_fetch_add(p, v, __ATOMIC_RELAXED, __HIP_MEMORY_SCOPE_AGENT); }
__device__ __forceinline__ unsigned xb_xcc_id() { return (unsigned)__builtin_amdgcn_s_getreg((3 << 11) | 20) & 0xFu; }
#define XB_SPIN(cond, bar) do { unsigned _sp = 0; while (cond) { __builtin_amdgcn_s_sleep(1); \
    if ((++_sp & 255u) == 0u) { if (xb_ld(&(bar)[XB_TMO])) break; if (_sp > XB_SPIN_CAP) { atomicAdd(&(bar)[XB_TMO], 1u); break; } } } } while (0)
struct XcdBarrier { unsigned* bar; unsigned x; volatile LAS unsigned* st; };
__device__ __forceinline__ XcdBarrier xcd_barrier_post(unsigned* bar, volatile LAS unsigned* st) {
    XcdBarrier b; b.bar = bar; b.x = xb_xcc_id(); b.st = st;
    if (threadIdx.x == 0) st[2] = xb_add(&bar[XB_XCNT(b.x)], 1u);
    return b;
}
__device__ __forceinline__ void xcd_barrier_complete(unsigned* bar, unsigned x, unsigned& nloc, unsigned& nx, unsigned& uni) {
    const unsigned G = gridDim.x * gridDim.y * gridDim.z;
    unsigned sum, cnt, mine, bad, sp = 0u;
    for (;;) {
        sum = 0u; cnt = 0u; mine = 0u; bad = 0u;
#pragma unroll
        for (unsigned j = 0; j < 16; ++j) { const unsigned c = xb_ld(&bar[XB_XCNT(j)]); sum += c; cnt += (c > 0u) ? 1u : 0u; mine = (j == x) ? c : mine; bad += (c != (j < 8u ? 32u : 0u)) ? 1u : 0u; }
        if (sum == G) break;
        __builtin_amdgcn_s_sleep(1);
        if ((++sp & 255u) == 0u) { if (xb_ld(&bar[XB_TMO])) break; if (sp > XB_SPIN_CAP) { atomicAdd(&bar[XB_TMO], 1u); break; } }
    }
    nloc = mine > 0u ? mine : 1u; nx = cnt > 0u ? cnt : 1u; uni = (bad == 0u && sum == G) ? 1u : 0u;
}
__device__ __forceinline__ void xcd_barrier(const XcdBarrier& b) {
    asm volatile("s_waitcnt vmcnt(0)" ::: "memory");
    __syncthreads();
    if (threadIdx.x == 0) {
        unsigned* bar = b.bar;
        __builtin_amdgcn_s_waitcnt(0);
        unsigned nloc = b.st[0], nx = b.st[1];
        if (nloc == 0u) { unsigned uni = 0u; xcd_barrier_complete(bar, b.x, nloc, nx, uni); b.st[0] = nloc; b.st[1] = nx; b.st[3] = uni; }
        const unsigned old = xb_add(&bar[XB_XSUB(b.x)], 1u);
        const unsigned gen = old / nloc;
        if (old + 1u == (gen + 1u) * nloc) {
            __builtin_amdgcn_fence(__ATOMIC_RELEASE, "agent");
            asm volatile("s_waitcnt vmcnt(0)" ::: "memory");
            const unsigned og = xb_add(&bar[XB_TOP], 1u);
            const unsigned tg = og / nx;
            if (og + 1u == (tg + 1u) * nx) xb_add(&bar[XB_TOPGEN], 1u);
            else XB_SPIN(xb_ld(&bar[XB_TOPGEN]) == tg, bar);
            __builtin_amdgcn_fence(__ATOMIC_ACQUIRE, "agent");
            xb_add(&bar[XB_XGEN(b.x)], 1u);
            asm volatile("s_waitcnt vmcnt(0)" ::: "memory");
        } else {
            XB_SPIN(xb_ld(&bar[XB_XGEN(b.x)]) == gen, bar);
            __builtin_amdgcn_fence(__ATOMIC_ACQUIRE, "agent");
            asm volatile("s_waitcnt vmcnt(0)" ::: "memory");
        }
    }
    __syncthreads();
}

template <class PF>
__device__ __forceinline__ void xcd_barrier_pf(const XcdBarrier& b, const PF& pf) {
    asm volatile("s_waitcnt vmcnt(0)" ::: "memory");
    __syncthreads();
    if (threadIdx.x >= 64) pf();
    if (threadIdx.x == 0) {
        unsigned* bar = b.bar;
        __builtin_amdgcn_s_waitcnt(0);
        unsigned nloc = b.st[0], nx = b.st[1];
        if (nloc == 0u) { unsigned uni = 0u; xcd_barrier_complete(bar, b.x, nloc, nx, uni); b.st[0] = nloc; b.st[1] = nx; b.st[3] = uni; }
        const unsigned old = xb_add(&bar[XB_XSUB(b.x)], 1u);
        const unsigned gen = old / nloc;
        if (old + 1u == (gen + 1u) * nloc) {
            __builtin_amdgcn_fence(__ATOMIC_RELEASE, "agent");
            asm volatile("s_waitcnt vmcnt(0)" ::: "memory");
            const unsigned og = xb_add(&bar[XB_TOP], 1u);
            const unsigned tg = og / nx;
            if (og + 1u == (tg + 1u) * nx) xb_add(&bar[XB_TOPGEN], 1u);
            else XB_SPIN(xb_ld(&bar[XB_TOPGEN]) == tg, bar);
            __builtin_amdgcn_fence(__ATOMIC_ACQUIRE, "agent");
            xb_add(&bar[XB_XGEN(b.x)], 1u);
            asm volatile("s_waitcnt vmcnt(0)" ::: "memory");
        } else {
            XB_SPIN(xb_ld(&bar[XB_XGEN(b.x)]) == gen, bar);
            __builtin_amdgcn_fence(__ATOMIC_ACQUIRE, "agent");
            asm volatile("s_waitcnt vmcnt(0)" ::: "memory");
        }
    }
    if (threadIdx.x < 64) pf();
    __syncthreads();
}

__device__ __forceinline__ void xcd_local_barrier(unsigned* cnt, unsigned target) {
    asm volatile("s_waitcnt vmcnt(0)" ::: "memory");
    __syncthreads();
    if (threadIdx.x == 0) { (void)xb_add(cnt, 1u); unsigned sp = 0; while (xb_ld(cnt) < target) { __builtin_amdgcn_s_sleep(1); if (++sp > (1u << 24)) break; } }
    __syncthreads();
    asm volatile("buffer_inv sc0" ::: "memory");
}
template <class PF>
__device__ __forceinline__ void xcd_local_barrier_pf(unsigned* cnt, unsigned target, const PF& pf) {
    asm volatile("s_waitcnt vmcnt(0)" ::: "memory");
    __syncthreads();
    if (threadIdx.x >= 64) pf();
    if (threadIdx.x == 0) { (void)xb_add(cnt, 1u); unsigned sp = 0; while (xb_ld(cnt) < target) { __builtin_amdgcn_s_sleep(1); if (++sp > (1u << 24)) break; } }
    if (threadIdx.x < 64) pf();
    __syncthreads();
    asm volatile("buffer_inv sc0" ::: "memory");
}
constexpr size_t MiB = 1u << 20;
constexpr int PROJP = 6400;
constexpr size_t WS_CTL = 0, CTL_ZERO_BYTES = 1 * MiB;
constexpr int CW_BAR = 4096;
constexpr int CW_CNT = 16384;
constexpr int CW_Q = 24576;
constexpr int CW_LB = 49152;
constexpr int CW_ROWSQ1 = 32768, CW_ROWSQ2 = 32768 + 8192;
constexpr size_t WS_WIN = 2 * MiB;
constexpr size_t WS_WOUT = 28 * MiB;
constexpr size_t WS_WXQ = 36 * MiB;
constexpr size_t WS_WXKV = 44 * MiB;
constexpr size_t WS_WXO = 60 * MiB;
constexpr size_t WS_H0 = 68 * MiB;
constexpr size_t WS_HM = 100 * MiB;
constexpr size_t WS_PROJ = 104 * MiB;
constexpr size_t WS_ALR = 204 * MiB;
constexpr size_t WS_KV = 205 * MiB;
constexpr size_t WS_CAT = 214 * MiB;
constexpr size_t WS_X1 = 246 * MiB;
constexpr size_t WS_X1B = 310 * MiB;
constexpr size_t WS_QX = 342 * MiB;
constexpr size_t WS_OX = 374 * MiB;
constexpr size_t WS_X2 = 406 * MiB;
constexpr size_t WS_GU = WS_X1;
constexpr size_t WS_GS = WS_X1B;
constexpr size_t WS_GQD = WS_QX;
constexpr size_t WS_GKI = WS_QX + 8 * MiB;
constexpr size_t WS_GEL = WS_QX + 16 * MiB;
constexpr size_t WS_PB = WS_H0;
constexpr size_t WS_HF = 854 * MiB;
constexpr size_t WS_HB = 886 * MiB;
constexpr size_t WS_YB = 902 * MiB;
constexpr size_t WS_WR = 966 * MiB;
constexpr size_t WS_LIST = 967 * MiB;
constexpr size_t WS_GATE = 969 * MiB;
constexpr size_t WS_MKT = WS_OX;
constexpr size_t WS_NVT = WS_OX + 16 * MiB;
constexpr size_t WS_NEW_END = 970 * MiB;

constexpr int RING_OFF = 0, RING_BYTES = 147456;
constexpr int LDSCTL_OFF = RING_BYTES, MISC_OFF = LDSCTL_OFF + 320;
constexpr int LDS_BYTES = 163840;
constexpr int NWAVES = 8;

struct Frame {
    LAS unsigned char* lds; volatile LAS unsigned* MISC; unsigned* ctl;
    int tid, lane, wave, G, vcu;
    unsigned char* ws;
};

__device__ __forceinline__ void p0_transpose_item(const float* W, int K, int ldw, int ncols, const float* gain, bf16* WT, int row_off, LAS float* scr, int item, int lane) {
    const int nblk = (ncols + 63) / 64, kb = item / nblk, nb = item % nblk, k0 = 64 * kb, n0 = 64 * nb;
    const int lk = lane >> 4, ln = (lane & 15) * 4; const bool ok = (n0 + ln) < ncols;
    f32x4 v[16];
#pragma unroll
    for (int i = 0; i < 16; ++i) v[i] = ok ? __builtin_nontemporal_load((const f32x4*)(W + (size_t)(k0 + 4 * i + lk) * ldw + n0 + ln)) : (f32x4){0.f, 0.f, 0.f, 0.f};
#pragma unroll
    for (int i = 0; i < 16; ++i) { const int kk = 4 * i + lk; const float g = gain ? gain[k0 + kk] : 1.0f; LAS float* d = scr + kk * 65 + ln; d[0] = v[i][0] * g; d[1] = v[i][1] * g; d[2] = v[i][2] * g; d[3] = v[i][3] * g; }
    LDS_WAIT(); asm volatile("" ::: "memory");
    const int c = lane & 7;
#pragma unroll
    for (int j = 0; j < 8; ++j) { const int n = (lane >> 3) + 8 * j; const LAS float* sp = scr + (8 * c) * 65 + n;
        v4u o; o.x = pk2(sp[0 * 65], sp[1 * 65]); o.y = pk2(sp[2 * 65], sp[3 * 65]); o.z = pk2(sp[4 * 65], sp[5 * 65]); o.w = pk2(sp[6 * 65], sp[7 * 65]);
        *(v4u*)(WT + (size_t)(row_off + n0 + n) * K + k0 + 8 * c) = o; }
    LDS_WAIT(); asm volatile("" ::: "memory");
}
__device__ __forceinline__ float wave_sum(float v) {
#pragma unroll
    for (int o = 1; o < 64; o <<= 1) v += __shfl_xor(v, o);
    return v;
}
__device__ __forceinline__ void rms_row_to_bf16(const float* xrow, const float* gain, bf16* orow, int lane) {
    const f32x4* xr = (const f32x4*)xrow + lane; const f32x4* gr = (const f32x4*)gain + lane;
    f32x4 v[8]; float s = 0.f;
#pragma unroll
    for (int j = 0; j < 8; ++j) { v[j] = __builtin_nontemporal_load(xr + 64 * j); s += (v[j].x * v[j].x + v[j].y * v[j].y) + (v[j].z * v[j].z + v[j].w * v[j].w); }
    const float rstd = rsqrtf(wave_sum(s) * (1.f / D) + EPS);
    unsigned long long* o8 = (unsigned long long*)orow + lane;
#pragma unroll
    for (int j = 0; j < 8; ++j) { const f32x4 g = gr[64 * j]; o8[64 * j] = (unsigned long long)pk2(v[j].x * rstd * g.x, v[j].y * rstd * g.y) | ((unsigned long long)pk2(v[j].z * rstd * g.z, v[j].w * rstd * g.w) << 32); }
}

struct EpiBf16 {
    static constexpr bool PERM = true, AFTER_DRAIN = false;
    bf16* O; int ldc;
    __device__ __forceinline__ void operator()(const f32x4 (&acc)[2][2][4][2], const pg8::Unit& u, int wr, int wc, int fr, int fq) const {
        const int row0 = u.pm * 256 + wr * 64 + fr, col0 = u.pn * 256 + wc * 32 + 8 * fq;
#pragma unroll
        for (int ai = 0; ai < 2; ++ai)
#pragma unroll
            for (int m = 0; m < 4; ++m) { bf16* rowp = O + (size_t)(row0 + ai * 128 + m * 16) * ldc + col0;
#pragma unroll
                for (int bj = 0; bj < 2; ++bj) { const f32x4 v0 = acc[ai][bj][m][0], v1 = acc[ai][bj][m][1];
                    v4u w; w.x = pg8::cvt_pk_bf16(v0[0], v0[1]); w.y = pg8::cvt_pk_bf16(v0[2], v0[3]); w.z = pg8::cvt_pk_bf16(v1[0], v1[1]); w.w = pg8::cvt_pk_bf16(v1[2], v1[3]);
                    *(v4u*)(rowp + bj * 128) = w; } }
    }
};
struct EpiProj {
    static constexpr bool PERM = true, AFTER_DRAIN = false;
    bf16* O; float* alr;
    __device__ __forceinline__ void operator()(const f32x4 (&acc)[2][2][4][2], const pg8::Unit& u, int wr, int wc, int fr, int fq) const {
        const int row0 = u.pm * 256 + wr * 64 + fr, col0 = u.pn * 256 + wc * 32 + 8 * fq;
#pragma unroll
        for (int ai = 0; ai < 2; ++ai)
#pragma unroll
            for (int m = 0; m < 4; ++m) { const int row = row0 + ai * 128 + m * 16; bf16* rowp = O + (size_t)row * PROJP + col0;
#pragma unroll
                for (int bj = 0; bj < 2; ++bj) { const f32x4 v0 = acc[ai][bj][m][0], v1 = acc[ai][bj][m][1];
                    v4u w; w.x = pg8::cvt_pk_bf16(v0[0], v0[1]); w.y = pg8::cvt_pk_bf16(v0[2], v0[3]); w.z = pg8::cvt_pk_bf16(v1[0], v1[1]); w.w = pg8::cvt_pk_bf16(v1[2], v1[3]);
                    *(v4u*)(rowp + bj * 128) = w; }
                if (u.pn == C_ALR / 256 && wc == 0 && fq < 2) { float* ap = alr + (size_t)row * GRANK + 8 * fq; *(f32x4*)ap = acc[ai][0][m][0]; *(f32x4*)(ap + 4) = acc[ai][0][m][1]; } }
    }
};

struct EpiResid {
    static constexpr bool PERM = true, AFTER_DRAIN = false;
    const float* R; const bf16* Rb; float* O; bf16* Ob; float* rowsq;
    __device__ __forceinline__ void operator()(const f32x4 (&acc)[2][2][4][2], const pg8::Unit& u, int wr, int wc, int fr, int fq) const {
        const int row0 = u.pm * 256 + wr * 64 + fr, col0 = u.pn * 256 + wc * 32 + 8 * fq;
#pragma unroll
        for (int ai = 0; ai < 2; ++ai) {
            f32x4 rr[4][2][2];
#pragma unroll
            for (int m = 0; m < 4; ++m) { const size_t off = (size_t)(row0 + ai * 128 + m * 16) * D + col0;
#pragma unroll
                for (int bj = 0; bj < 2; ++bj) {
                    if (R) { rr[m][bj][0] = __builtin_nontemporal_load((const f32x4*)(R + off + bj * 128)); rr[m][bj][1] = __builtin_nontemporal_load((const f32x4*)(R + off + bj * 128 + 4)); }
                    else { const v4u rb = *(const v4u*)(Rb + off + bj * 128); rr[m][bj][0] = (f32x4){__uint_as_float(rb.x << 16), __uint_as_float(rb.x & 0xffff0000u), __uint_as_float(rb.y << 16), __uint_as_float(rb.y & 0xffff0000u)};
                        rr[m][bj][1] = (f32x4){__uint_as_float(rb.z << 16), __uint_as_float(rb.z & 0xffff0000u), __uint_as_float(rb.w << 16), __uint_as_float(rb.w & 0xffff0000u)}; } } }
#pragma unroll
            for (int m = 0; m < 4; ++m) { const int row = row0 + ai * 128 + m * 16; const size_t off = (size_t)row * D + col0; float ss = 0.f;
#pragma unroll
                for (int bj = 0; bj < 2; ++bj) { const f32x4 v0 = acc[ai][bj][m][0] + rr[m][bj][0], v1 = acc[ai][bj][m][1] + rr[m][bj][1];
                    if (O) { *(f32x4*)(O + off + bj * 128) = v0; *(f32x4*)(O + off + bj * 128 + 4) = v1; }
                    ss += (v0[0] * v0[0] + v0[1] * v0[1]) + (v0[2] * v0[2] + v0[3] * v0[3]) + (v1[0] * v1[0] + v1[1] * v1[1]) + (v1[2] * v1[2] + v1[3] * v1[3]);
                    if (Ob) { v4u w; w.x = pg8::cvt_pk_bf16(v0[0], v0[1]); w.y = pg8::cvt_pk_bf16(v0[2], v0[3]); w.z = pg8::cvt_pk_bf16(v1[0], v1[1]); w.w = pg8::cvt_pk_bf16(v1[2], v1[3]);
                        *(v4u*)(Ob + off + bj * 128) = w; } }
                ss += __shfl_xor(ss, 16); ss += __shfl_xor(ss, 32);
                if (fq == 0) atomicAdd(rowsq + row, ss); }
            asm volatile("" ::: "memory"); }
    }
};
struct EpiRowScaleBf16 {
    static constexpr bool PERM = true, AFTER_DRAIN = false;
    bf16* O; const float* rowsq;
    __device__ __forceinline__ void operator()(const f32x4 (&acc)[2][2][4][2], const pg8::Unit& u, int wr, int wc, int fr, int fq) const {
        const int row0 = u.pm * 256 + wr * 64 + fr, col0 = u.pn * 256 + wc * 32 + 8 * fq;
#pragma unroll
        for (int ai = 0; ai < 2; ++ai)
#pragma unroll
            for (int m = 0; m < 4; ++m) { const int row = row0 + ai * 128 + m * 16; const float rs = rsqrtf(rowsq[row] * (1.0f / D) + EPS); bf16* rowp = O + (size_t)row * D + col0;
#pragma unroll
                for (int bj = 0; bj < 2; ++bj) { const f32x4 v0 = acc[ai][bj][m][0] * rs, v1 = acc[ai][bj][m][1] * rs;
                    v4u w; w.x = pg8::cvt_pk_bf16(v0[0], v0[1]); w.y = pg8::cvt_pk_bf16(v0[2], v0[3]); w.z = pg8::cvt_pk_bf16(v1[0], v1[1]); w.w = pg8::cvt_pk_bf16(v1[2], v1[3]);
                    *(v4u*)(rowp + bj * 128) = w; } }
    }
};

typedef __bf16 bf16x2_t __attribute__((ext_vector_type(2)));
typedef float f32x2_t __attribute__((ext_vector_type(2)));
typedef float f32x16 __attribute__((ext_vector_type(16)));
typedef short s16x4 __attribute__((ext_vector_type(4)));
__device__ __forceinline__ unsigned pkbf(float a, float b) { f32x2_t f = {a, b}; bf16x2_t h = __builtin_convertvector(f, bf16x2_t); return __builtin_bit_cast(unsigned, h); }
__device__ __forceinline__ unsigned offb(unsigned row, unsigned ch) { return 256u * row + 16u * (ch ^ (((row & 3u) << 2) | ((row >> 2) & 3u))); }
__device__ __forceinline__ void tr_read8(unsigned a0, unsigned a1, unsigned a2, unsigned a3, unsigned a4, unsigned a5, unsigned a6, unsigned a7,
                                         s16x4& r0, s16x4& r1, s16x4& r2, s16x4& r3, s16x4& r4, s16x4& r5, s16x4& r6, s16x4& r7) {
    asm volatile("ds_read_b64_tr_b16 %0, %8\n\tds_read_b64_tr_b16 %1, %9\n\tds_read_b64_tr_b16 %2, %10\n\tds_read_b64_tr_b16 %3, %11\n\t"
                 "ds_read_b64_tr_b16 %4, %12\n\tds_read_b64_tr_b16 %5, %13\n\tds_read_b64_tr_b16 %6, %14\n\tds_read_b64_tr_b16 %7, %15\n\ts_waitcnt lgkmcnt(0)"
                 : "=&v"(r0), "=&v"(r1), "=&v"(r2), "=&v"(r3), "=&v"(r4), "=&v"(r5), "=&v"(r6), "=&v"(r7)
                 : "v"(a0), "v"(a1), "v"(a2), "v"(a3), "v"(a4), "v"(a5), "v"(a6), "v"(a7) : "memory");
}
__device__ __forceinline__ void sb_wave_unit(LAS unsigned char* wl, const bf16* __restrict__ proj, const float* __restrict__ gain, bf16* __restrict__ cat, int b, int hd, int qi, int lane) {
    const int r = lane & 31, h = lane >> 5, t = 32 * qi + r;
    const size_t rowq = (size_t)(b * SEQ + t) * PROJP;
    bf16x8 Bq[8];
#pragma unroll
    for (int ks = 0; ks < 8; ++ks) Bq[ks] = *(const bf16x8*)(proj + rowq + C_QSB + hd * SBD + 16 * ks + 8 * h);
    f32x16 O[4];
#pragma unroll
    for (int db = 0; db < 4; ++db)
#pragma unroll
        for (int i = 0; i < 16; ++i) O[db][i] = 0.f;
    float R = 1.0f;
    const unsigned lbase = (unsigned)(size_t)wl;
    const int srow = lane >> 4, sch = lane & 15;
    v4u sreg[8];
    { const bf16* src = proj + (size_t)(b * SEQ + 32 * qi + srow) * PROJP + hd * SBD + sch * 8 + C_KSB;
#pragma unroll
      for (int i = 0; i < 8; ++i) sreg[i] = *(const v4u*)(src + (size_t)(4 * i) * PROJP); }
    const unsigned blk = (lane >> 4) & 1, q4 = (lane & 15) >> 2, p4 = lane & 3;
    const float cexp = 0.08838834764831845f * 1.4426950408889634f;
    for (int kt = qi; kt >= 0; --kt) {
#pragma unroll
        for (int i = 0; i < 8; ++i) *(LAS v4u*)(wl + offb(4 * i + srow, sch)) = sreg[i];
        { const bf16* src = proj + (size_t)(b * SEQ + 32 * kt + srow) * PROJP + hd * SBD + sch * 8 + C_VSB;
#pragma unroll
          for (int i = 0; i < 8; ++i) sreg[i] = *(const v4u*)(src + (size_t)(4 * i) * PROJP); }
        asm volatile("s_waitcnt lgkmcnt(0)" ::: "memory");
        f32x16 S;
#pragma unroll
        for (int i = 0; i < 16; ++i) S[i] = 0.f;
#pragma unroll
        for (int ks = 0; ks < 8; ++ks) { const bf16x8 Kf = *(const LAS bf16x8*)(wl + offb(r, 2 * ks + h)); S = __builtin_amdgcn_mfma_f32_32x32x16_bf16(Kf, Bq[ks], S, 0, 0, 0); }
        float w[16], keep[16];
        const bool diag = (kt == qi);
#pragma unroll
        for (int i = 0; i < 16; ++i) { const int key = (i & 3) + 8 * (i >> 2) + 4 * h;
            const float e = __builtin_amdgcn_exp2f(fminf(S[i] * cexp, 115.f)); const float kp = __builtin_amdgcn_rcpf(1.f + e);
            const bool ok = !diag || key < r;
            keep[i] = ok ? kp : 1.f; w[i] = ok ? e * kp : 0.f; }
        float tot[4], oth[4], sf[16];
#pragma unroll
        for (int g = 0; g < 4; ++g) { sf[4 * g + 3] = 1.f; sf[4 * g + 2] = keep[4 * g + 3]; sf[4 * g + 1] = sf[4 * g + 2] * keep[4 * g + 2]; sf[4 * g] = sf[4 * g + 1] * keep[4 * g + 1]; tot[g] = sf[4 * g] * keep[4 * g]; }
#pragma unroll
        for (int g = 0; g < 4; ++g) oth[g] = __shfl_xor(tot[g], 32);
        float Cg[4]; Cg[3] = R; Cg[2] = Cg[3] * (tot[3] * oth[3]); Cg[1] = Cg[2] * (tot[2] * oth[2]); Cg[0] = Cg[1] * (tot[1] * oth[1]);
        R = Cg[0] * (tot[0] * oth[0]);
#pragma unroll
        for (int g = 0; g < 4; ++g) { const float E = h ? Cg[g] : Cg[g] * oth[g];
#pragma unroll
            for (int p = 0; p < 4; ++p) w[4 * g + p] = w[4 * g + p] * (sf[4 * g + p] * E); }
#pragma unroll
        for (int i = 0; i < 8; ++i) *(LAS v4u*)(wl + 8192 + offb(4 * i + srow, sch)) = sreg[i];
        if (kt > 0) { const bf16* src = proj + (size_t)(b * SEQ + 32 * (kt - 1) + srow) * PROJP + hd * SBD + sch * 8 + C_KSB;
#pragma unroll
            for (int i = 0; i < 8; ++i) sreg[i] = *(const v4u*)(src + (size_t)(4 * i) * PROJP); }
        asm volatile("s_waitcnt lgkmcnt(0)" ::: "memory");
#pragma unroll
        for (int s2 = 0; s2 < 2; ++s2) {
            v4u wp; wp.x = pkbf(w[8 * s2], w[8 * s2 + 1]); wp.y = pkbf(w[8 * s2 + 2], w[8 * s2 + 3]); wp.z = pkbf(w[8 * s2 + 4], w[8 * s2 + 5]); wp.w = pkbf(w[8 * s2 + 6], w[8 * s2 + 7]);
            const bf16x8 Wf = __builtin_bit_cast(bf16x8, wp);
            s16x4 v0a, v0b, v1a, v1b, v2a, v2b, v3a, v3b;
            const unsigned rb0 = 16 * s2 + 4 * h + q4, rb1 = rb0 + 8, cb = 2 * blk + (p4 >> 1), bo = lbase + 8192 + 8 * (p4 & 1);
            tr_read8(bo + offb(rb0, cb), bo + offb(rb1, cb), bo + offb(rb0, 4 + cb), bo + offb(rb1, 4 + cb), bo + offb(rb0, 8 + cb), bo + offb(rb1, 8 + cb), bo + offb(rb0, 12 + cb), bo + offb(rb1, 12 + cb),
                     v0a, v0b, v1a, v1b, v2a, v2b, v3a, v3b);
            O[0] = __builtin_amdgcn_mfma_f32_32x32x16_bf16(__builtin_shufflevector(v0a, v0b, 0, 1, 2, 3, 4, 5, 6, 7), Wf, O[0], 0, 0, 0);
            O[1] = __builtin_amdgcn_mfma_f32_32x32x16_bf16(__builtin_shufflevector(v1a, v1b, 0, 1, 2, 3, 4, 5, 6, 7), Wf, O[1], 0, 0, 0);
            O[2] = __builtin_amdgcn_mfma_f32_32x32x16_bf16(__builtin_shufflevector(v2a, v2b, 0, 1, 2, 3, 4, 5, 6, 7), Wf, O[2], 0, 0, 0);
            O[3] = __builtin_amdgcn_mfma_f32_32x32x16_bf16(__builtin_shufflevector(v3a, v3b, 0, 1, 2, 3, 4, 5, 6, 7), Wf, O[3], 0, 0, 0);
        }
        if (__all(R == 0.f)) break;
    }
    float ss = 0.f;
#pragma unroll
    for (int db = 0; db < 4; ++db)
#pragma unroll
        for (int i = 0; i < 16; ++i) ss += O[db][i] * O[db][i];
    ss += __shfl_xor(ss, 32);
    const float rs = rsqrtf(ss * (1.0f / SBD) + EPS);
    bf16* orow = cat + (size_t)(b * SEQ + t) * D + hd * SBD;
#pragma unroll
    for (int db = 0; db < 4; ++db)
#pragma unroll
        for (int g = 0; g < 4; ++g) { const int d = 32 * db + 8 * g + 4 * h; const f32x4 gv = *(const f32x4*)(gain + hd * SBD + d);
            v2u o; o.x = pkbf(O[db][4 * g] * rs * gv[0], O[db][4 * g + 1] * rs * gv[1]); o.y = pkbf(O[db][4 * g + 2] * rs * gv[2], O[db][4 * g + 3] * rs * gv[3]);
            *(v2u*)(orow + d) = o; }
}

__device__ __forceinline__ void sb_wg_unit(LAS unsigned char* sm0, const bf16* __restrict__ proj, const float* __restrict__ gain, bf16* __restrict__ cat, int item, int wave, int lane) {
    asm volatile("" : "+v"(lane));
    const int qg = (SEQ / 256 - 1) - item / (BATCH * SBH), bh = item % (BATCH * SBH), b = bh / SBH, hd = bh % SBH;
    LAS unsigned char* sm = sm0;
    LAS int* doneAt = (LAS int*)(sm0 + RING_BYTES + 8192);
    const int qi = 8 * qg + wave, r = lane & 31, h = lane >> 5, t = 32 * qi + r;
    const size_t rowq = (size_t)(b * SEQ + t) * PROJP;
    bf16x8 Bq[8];
#pragma unroll
    for (int ks = 0; ks < 8; ++ks) Bq[ks] = *(const bf16x8*)(proj + rowq + C_QSB + hd * SBD + 16 * ks + 8 * h);
    f32x16 O[4];
#pragma unroll
    for (int db = 0; db < 4; ++db)
#pragma unroll
        for (int i = 0; i < 16; ++i) O[db][i] = 0.f;
    float R = 1.0f; bool done = false;
    const int prow0 = 4 * wave + (lane >> 4); const unsigned sw0 = (unsigned)((((lane >> 4) & 3) << 2) | (wave & 3));
    const unsigned pch0 = (unsigned)(lane & 15) ^ sw0;
    const bf16* kv0 = proj + (size_t)(b * SEQ + prow0) * PROJP + hd * SBD;
    __syncthreads();
    if (lane == 0) doneAt[wave] = -1;
#define SBW_DMA(kt_) do { int kq_ = (kt_); asm volatile("" : "+s"(kq_)); const unsigned st_ = (unsigned)(kq_ % 9) * 16384u + (unsigned)wave * 1024u; const size_t ro_ = (size_t)(32 * kq_) * PROJP; \
        __builtin_amdgcn_global_load_lds((const unsigned*)(kv0 + ro_ + C_KSB + pch0 * 8), (LAS unsigned*)(sm + st_), 16, 0, 0); \
        __builtin_amdgcn_global_load_lds((const unsigned*)(kv0 + ro_ + C_VSB + pch0 * 8), (LAS unsigned*)(sm + st_ + 8192), 16, 0, 0); } while (0)
    const int ktop = 8 * qg + 7;
#pragma unroll
    for (int i = 0; i < 8; ++i) SBW_DMA(ktop - i);
    const unsigned blk = (lane >> 4) & 1, q4 = (lane & 15) >> 2, p4 = lane & 3;
    const float cexp = 0.08838834764831845f * 1.4426950408889634f;
    for (int s = 0; ; ++s) {
        asm volatile("s_waitcnt vmcnt(0) lgkmcnt(0)" ::: "memory");
        __builtin_amdgcn_s_barrier(); asm volatile("" ::: "memory");
        { int nd = 0;
#pragma unroll
          for (int w8 = 0; w8 < 8; ++w8) { const int da = doneAt[w8]; nd += (da >= 0 && da < s) ? 1 : 0; }
          if (nd == 8) break; }
        { const int knew = ktop - 8 - s; if (knew >= 0) SBW_DMA(knew); }
        const int kt = qi - s;
        if (!done) {
            int kq = kt; asm volatile("" : "+s"(kq));
            LAS unsigned char* Kt = sm + (kq % 9) * 16384; const unsigned vb = (unsigned)(size_t)Kt + 8192u;
            f32x16 S;
#pragma unroll
            for (int i = 0; i < 16; ++i) S[i] = 0.f;
#pragma unroll
            for (int ks = 0; ks < 8; ++ks) { const bf16x8 Kf = *(const LAS bf16x8*)(Kt + offb(r, 2 * ks + h)); S = __builtin_amdgcn_mfma_f32_32x32x16_bf16(Kf, Bq[ks], S, 0, 0, 0); }
            float w[16], keep[16];
            const bool diag = (s == 0);
#pragma unroll
            for (int i = 0; i < 16; ++i) { const int key = (i & 3) + 8 * (i >> 2) + 4 * h;
                const float e = __builtin_amdgcn_exp2f(fminf(S[i] * cexp, 115.f)); const float kp = __builtin_amdgcn_rcpf(1.f + e);
                const bool ok = !diag || key < r;
                keep[i] = ok ? kp : 1.f; w[i] = ok ? e * kp : 0.f; }
            float tot[4], oth[4], sf[16];
#pragma unroll
            for (int g = 0; g < 4; ++g) { sf[4 * g + 3] = 1.f; sf[4 * g + 2] = keep[4 * g + 3]; sf[4 * g + 1] = sf[4 * g + 2] * keep[4 * g + 2]; sf[4 * g] = sf[4 * g + 1] * keep[4 * g + 1]; tot[g] = sf[4 * g] * keep[4 * g]; }
#pragma unroll
            for (int g = 0; g < 4; ++g) oth[g] = __shfl_xor(tot[g], 32);
            float Cg[4]; Cg[3] = R; Cg[2] = Cg[3] * (tot[3] * oth[3]); Cg[1] = Cg[2] * (tot[2] * oth[2]); Cg[0] = Cg[1] * (tot[1] * oth[1]);
            R = Cg[0] * (tot[0] * oth[0]);
#pragma unroll
            for (int g = 0; g < 4; ++g) { const float E = h ? Cg[g] : Cg[g] * oth[g];
#pragma unroll
                for (int p = 0; p < 4; ++p) w[4 * g + p] = w[4 * g + p] * (sf[4 * g + p] * E); }
#pragma unroll
            for (int s2 = 0; s2 < 2; ++s2) {
                v4u wp; wp.x = pkbf(w[8 * s2], w[8 * s2 + 1]); wp.y = pkbf(w[8 * s2 + 2], w[8 * s2 + 3]); wp.z = pkbf(w[8 * s2 + 4], w[8 * s2 + 5]); wp.w = pkbf(w[8 * s2 + 6], w[8 * s2 + 7]);
                const bf16x8 Wf = __builtin_bit_cast(bf16x8, wp);
                s16x4 v0a, v0b, v1a, v1b, v2a, v2b, v3a, v3b;
                const unsigned rb0 = 16 * s2 + 4 * h + q4, rb1 = rb0 + 8, cb = 2 * blk + (p4 >> 1), bo = vb + 8 * (p4 & 1);
                tr_read8(bo + offb(rb0, cb), bo + offb(rb1, cb), bo + offb(rb0, 4 + cb), bo + offb(rb1, 4 + cb), bo + offb(rb0, 8 + cb), bo + offb(rb1, 8 + cb), bo + offb(rb0, 12 + cb), bo + offb(rb1, 12 + cb),
                         v0a, v0b, v1a, v1b, v2a, v2b, v3a, v3b);
                O[0] = __builtin_amdgcn_mfma_f32_32x32x16_bf16(__builtin_shufflevector(v0a, v0b, 0, 1, 2, 3, 4, 5, 6, 7), Wf, O[0], 0, 0, 0);
                O[1] = __builtin_amdgcn_mfma_f32_32x32x16_bf16(__builtin_shufflevector(v1a, v1b, 0, 1, 2, 3, 4, 5, 6, 7), Wf, O[1], 0, 0, 0);
                O[2] = __builtin_amdgcn_mfma_f32_32x32x16_bf16(__builtin_shufflevector(v2a, v2b, 0, 1, 2, 3, 4, 5, 6, 7), Wf, O[2], 0, 0, 0);
                O[3] = __builtin_amdgcn_mfma_f32_32x32x16_bf16(__builtin_shufflevector(v3a, v3b, 0, 1, 2, 3, 4, 5, 6, 7), Wf, O[3], 0, 0, 0);
            }
            if (__all(R < 5.0e-20f) || kt == 0) { done = true; if (lane == 0) doneAt[wave] = s; }
        }
    }
#undef SBW_DMA
    asm volatile("s_waitcnt vmcnt(0)" ::: "memory");
    float ss = 0.f;
#pragma unroll
    for (int db = 0; db < 4; ++db)
#pragma unroll
        for (int i = 0; i < 16; ++i) ss += O[db][i] * O[db][i];
    ss += __shfl_xor(ss, 32);
    const float rs = rsqrtf(ss * (1.0f / SBD) + EPS);
    bf16* orow = cat + (size_t)(b * SEQ + t) * D + hd * SBD;
#pragma unroll
    for (int db = 0; db < 4; ++db) { unsigned w[4][2];
#pragma unroll
        for (int g = 0; g < 4; ++g) { const int d = 32 * db + 8 * g + 4 * h; const f32x4 gv = *(const f32x4*)(gain + hd * SBD + d);
            w[g][0] = pkbf(O[db][4 * g] * rs * gv[0], O[db][4 * g + 1] * rs * gv[1]); w[g][1] = pkbf(O[db][4 * g + 2] * rs * gv[2], O[db][4 * g + 3] * rs * gv[3]); }
        const v2u s0 = __builtin_amdgcn_permlane32_swap(w[0][0], w[1][0], false, false), s1 = __builtin_amdgcn_permlane32_swap(w[0][1], w[1][1], false, false);
        const v2u s2 = __builtin_amdgcn_permlane32_swap(w[2][0], w[3][0], false, false), s3 = __builtin_amdgcn_permlane32_swap(w[2][1], w[3][1], false, false);
        *(v4u*)(orow + 32 * db + 8 * h) = (v4u){s0.x, s1.x, s0.y, s1.y}; *(v4u*)(orow + 32 * db + 16 + 8 * h) = (v4u){s2.x, s3.x, s2.y, s3.y}; }
}

struct MktSched { const char* KV; const char* WqN; unsigned ldb; int K, G, c;
    __device__ __forceinline__ bool next(int i, pg8::Unit& u) const { const int L = i * G + c; if (L >= 128) return false; const int b = L >> 5, h = (L >> 3) & 3, kt = L & 7;
        u.pm = b * 4 + h; u.pn = kt; u.z = L; u.mv = 256; u.A = KV + ((size_t)(b * MEM) * 2 * D + h * XD) * 2; u.B = WqN + ((size_t)(kt * 256) * D + h * XD) * 2; return true; }
    __device__ __forceinline__ unsigned arow(const pg8::Unit&, int r) const { return (unsigned)r * (2 * D * 2); }
    __device__ __forceinline__ void a_ready(const pg8::Unit&) const {}
    __device__ __forceinline__ void done(const pg8::Unit&) const {} };
struct NvtSched { const char* WoT; const char* KV; unsigned ldb; int K, G, c;
    __device__ __forceinline__ bool next(int i, pg8::Unit& u) const { const int L = i * G + c; if (L >= 128) return false; const int b = L >> 5, h = (L >> 3) & 3, nt = L & 7;
        u.pm = b * 8 + nt; u.pn = h; u.z = L; u.mv = 256; u.A = WoT + ((size_t)(nt * 256) * D + h * XD) * 2; u.B = KV + ((size_t)(b * MEM) * 2 * D + D + h * XD) * 2; return true; }
    __device__ __forceinline__ unsigned arow(const pg8::Unit&, int r) const { return (unsigned)r * (D * 2); }
    __device__ __forceinline__ void a_ready(const pg8::Unit&) const {}
    __device__ __forceinline__ void done(const pg8::Unit&) const {} };
struct XLogitSched { const char* X1; const char* MKT; unsigned ldb; int K, G, c;
    __device__ __forceinline__ bool next(int i, pg8::Unit& u) const { const int Lr = i * G + c; if (Lr >= 128) return false; const int rp = 4 * (Lr & 7) + (Lr >> 5), h = (Lr >> 3) & 3, L = rp * 4 + h, b = rp >> 3, qt = rp & 7;
        u.pm = b * 8 + qt; u.pn = h; u.z = L; u.mv = 256; u.A = X1 + (size_t)(b * SEQ + qt * 256) * D * 2; u.B = MKT + (size_t)(b * 1024 + h * 256) * D * 2; return true; }
    __device__ __forceinline__ unsigned arow(const pg8::Unit&, int r) const { return (unsigned)r * (D * 2); }
    __device__ __forceinline__ void a_ready(const pg8::Unit&) const {}
    __device__ __forceinline__ void done(const pg8::Unit&) const {} };
struct EpiSoftmaxP {
    static constexpr bool PERM = true, AFTER_DRAIN = false;
    bf16* P; LAS float* tab; const float* rowsq;
    __device__ __forceinline__ void operator()(const f32x4 (&acc)[2][2][4][2], const pg8::Unit& u, int wr, int wc, int fr, int fq) const {
        const float sc = 0.044194173824159216f * 1.4426950408889634f;
        LAS float* Tm = tab; LAS float* Ts = tab + 1024;
        float rsc[2][4];
#pragma unroll
        for (int ai = 0; ai < 2; ++ai)
#pragma unroll
            for (int m = 0; m < 4; ++m) { rsc[ai][m] = sc * rsqrtf(rowsq[u.pm * 256 + ai * 128 + wr * 64 + m * 16 + fr] * (1.0f / D) + EPS); float v = -3.0e38f;
#pragma unroll
                for (int bj = 0; bj < 2; ++bj)
#pragma unroll
                    for (int n = 0; n < 2; ++n) { const f32x4 a = acc[ai][bj][m][n]; v = fmaxf(v, fmaxf(fmaxf(a[0], a[1]), fmaxf(a[2], a[3]))); }
                v = fmaxf(v, __shfl_xor(v, 16)); v = fmaxf(v, __shfl_xor(v, 32));
                if (fq == 0) Tm[(ai * 128 + wr * 64 + m * 16 + fr) * 4 + wc] = v; }
        asm volatile("s_waitcnt lgkmcnt(0)" ::: "memory"); __builtin_amdgcn_s_barrier(); asm volatile("" ::: "memory");
        float e[2][2][4][2][4];
#pragma unroll
        for (int ai = 0; ai < 2; ++ai)
#pragma unroll
            for (int m = 0; m < 4; ++m) { const f32x4 t4 = *(const LAS f32x4*)(Tm + (ai * 128 + wr * 64 + m * 16 + fr) * 4); const float k2 = rsc[ai][m], mr = fmaxf(fmaxf(t4[0], t4[1]), fmaxf(t4[2], t4[3])) * k2; float sacc = 0.f;
#pragma unroll
                for (int bj = 0; bj < 2; ++bj)
#pragma unroll
                    for (int n = 0; n < 2; ++n)
#pragma unroll
                        for (int j = 0; j < 4; ++j) { const float x = __builtin_amdgcn_exp2f(acc[ai][bj][m][n][j] * k2 - mr); e[ai][bj][m][n][j] = x; sacc += x; }
                sacc += __shfl_xor(sacc, 16); sacc += __shfl_xor(sacc, 32);
                if (fq == 0) Ts[(ai * 128 + wr * 64 + m * 16 + fr) * 4 + wc] = sacc; }
        asm volatile("s_waitcnt lgkmcnt(0)" ::: "memory"); __builtin_amdgcn_s_barrier(); asm volatile("" ::: "memory");
        const int col0 = u.pn * 256 + wc * 32 + 8 * fq;
#pragma unroll
        for (int ai = 0; ai < 2; ++ai)
#pragma unroll
            for (int m = 0; m < 4; ++m) { const int rl = ai * 128 + wr * 64 + m * 16 + fr; const f32x4 t4 = *(const LAS f32x4*)(Ts + rl * 4); const float inv = 1.0f / ((t4[0] + t4[1]) + (t4[2] + t4[3]));
                bf16* rowp = P + (size_t)(u.pm * 256 + rl) * 1024 + col0;
#pragma unroll
                for (int bj = 0; bj < 2; ++bj) { v4u w; w.x = pkbf(e[ai][bj][m][0][0] * inv, e[ai][bj][m][0][1] * inv); w.y = pkbf(e[ai][bj][m][0][2] * inv, e[ai][bj][m][0][3] * inv);
                    w.z = pkbf(e[ai][bj][m][1][0] * inv, e[ai][bj][m][1][1] * inv); w.w = pkbf(e[ai][bj][m][1][2] * inv, e[ai][bj][m][1][3] * inv); *(v4u*)(rowp + bj * 128) = w; } }
    }
};
struct EpiSoftmax128 {
    bf16* P; LAS float* tab; const float* rowsq;
    struct Pre { float rq[4]; };
    __device__ __forceinline__ void prefetch(Pre& p, const pg8::Unit& u, int wr, int wc, int fr, int fq) const {
#pragma unroll
        for (int m = 0; m < 4; ++m) p.rq[m] = rowsq[u.pm * 128 + wr * 64 + m * 16 + fr]; }
    __device__ __forceinline__ void operator()(const f32x4 (&acc)[2][4][2], const pg8::Unit& u, int wr, int wc, int fr, int fq, const Pre& pre) const {
        const float sc = 0.044194173824159216f * 1.4426950408889634f;
        LAS float* Tm = tab; LAS float* Ts = tab + 512;
        float rsc[4];
#pragma unroll
        for (int m = 0; m < 4; ++m) { rsc[m] = sc * rsqrtf(pre.rq[m] * (1.0f / D) + EPS); float v = -3.0e38f;
#pragma unroll
            for (int bj = 0; bj < 2; ++bj)
#pragma unroll
                for (int n = 0; n < 2; ++n) { const f32x4 a = acc[bj][m][n]; v = fmaxf(v, fmaxf(fmaxf(a[0], a[1]), fmaxf(a[2], a[3]))); }
            v = fmaxf(v, __shfl_xor(v, 16)); v = fmaxf(v, __shfl_xor(v, 32));
            if (fq == 0) Tm[(wr * 64 + m * 16 + fr) * 4 + wc] = v; }
        asm volatile("s_waitcnt lgkmcnt(0)" ::: "memory"); __builtin_amdgcn_s_barrier(); asm volatile("" ::: "memory");
        float e[2][4][2][4];
#pragma unroll
        for (int m = 0; m < 4; ++m) { const f32x4 t4 = *(const LAS f32x4*)(Tm + (wr * 64 + m * 16 + fr) * 4); const float k2 = rsc[m], mr = fmaxf(fmaxf(t4[0], t4[1]), fmaxf(t4[2], t4[3])) * k2; float sacc = 0.f;
#pragma unroll
            for (int bj = 0; bj < 2; ++bj)
#pragma unroll
                for (int n = 0; n < 2; ++n)
#pragma unroll
                    for (int j = 0; j < 4; ++j) { const float x = __builtin_amdgcn_exp2f(acc[bj][m][n][j] * k2 - mr); e[bj][m][n][j] = x; sacc += x; }
            sacc += __shfl_xor(sacc, 16); sacc += __shfl_xor(sacc, 32);
            if (fq == 0) Ts[(wr * 64 + m * 16 + fr) * 4 + wc] = sacc; }
        asm volatile("s_waitcnt lgkmcnt(0)" ::: "memory"); __builtin_amdgcn_s_barrier(); asm volatile("" ::: "memory");
        const int col0 = u.pn * 256 + wc * 32 + 8 * fq;
#pragma unroll
        for (int m = 0; m < 4; ++m) { const int rl = wr * 64 + m * 16 + fr; const f32x4 t4 = *(const LAS f32x4*)(Ts + rl * 4); const float inv = 1.0f / ((t4[0] + t4[1]) + (t4[2] + t4[3]));
            bf16* rowp = P + (size_t)(u.pm * 128 + rl) * 1024 + col0;
#pragma unroll
            for (int bj = 0; bj < 2; ++bj) { v4u w; w.x = pkbf(e[bj][m][0][0] * inv, e[bj][m][0][1] * inv); w.y = pkbf(e[bj][m][0][2] * inv, e[bj][m][0][3] * inv);
                w.z = pkbf(e[bj][m][1][0] * inv, e[bj][m][1][1] * inv); w.w = pkbf(e[bj][m][1][2] * inv, e[bj][m][1][3] * inv); *(v4u*)(rowp + bj * 128) = w; } }
    }
};
struct WoutSched { const char* A; const char* Bt; unsigned ldb; int K, G, c;
    __device__ __forceinline__ bool next(int i, pg8::Unit& u) const { const int Lr = i * G + c; if (Lr >= 256) return false; const int rp = 4 * (Lr & 7) + (Lr >> 6), nt = (Lr >> 3) & 7;
        u.pm = rp; u.pn = nt; u.z = Lr; u.mv = 256; u.A = A + (size_t)rp * 256 * D * 2; u.B = Bt + (size_t)nt * 256 * D * 2; return true; }
    __device__ __forceinline__ unsigned arow(const pg8::Unit&, int r) const { return (unsigned)r * (D * 2); }
    __device__ __forceinline__ void a_ready(const pg8::Unit&) const {}
    __device__ __forceinline__ void done(const pg8::Unit&) const {} };
struct XOutSched { const char* P; const char* NVT; unsigned ldb; int K, G, c;
    __device__ __forceinline__ bool next(int i, pg8::Unit& u) const { const int Lr = i * G + c; if (Lr >= 256) return false; const int rp = 4 * (Lr & 7) + (Lr >> 6), nt = (Lr >> 3) & 7, L = rp * 8 + nt, b = rp >> 3, qt = rp & 7;
        u.pm = b * 8 + qt; u.pn = nt; u.z = L; u.mv = 256; u.A = P + (size_t)(b * SEQ + qt * 256) * 1024 * 2; u.B = NVT + (size_t)(b * D + nt * 256) * 1024 * 2; return true; }
    __device__ __forceinline__ unsigned arow(const pg8::Unit&, int r) const { return (unsigned)r * (1024 * 2); }
    __device__ __forceinline__ void a_ready(const pg8::Unit&) const {}
    __device__ __forceinline__ void done(const pg8::Unit&) const {} };

template <int MODE>
__device__ __forceinline__ void moe_stream_unit(LAS unsigned char* lds, const char* __restrict__ Ab, unsigned lda, int ashift, const float* __restrict__ W0, const float* __restrict__ W1, int ldw, int K, int colbase,
                                                const int* __restrict__ list, int n_e, bf16* __restrict__ Out, const float* __restrict__ gate, int tid, int wave, int lane) {
    const int wr = wave >> 2, wc = wave & 3, r = lane & 31, h = lane >> 5;
    const int nt = K / 32;
    const unsigned blane = (unsigned)(((lane >> 5) * ldw + 4 * (lane & 31)) * 4);
    const char* Wg0 = (const char*)(W0 + colbase); const char* Wg1 = (MODE == 0) ? (const char*)(W1 + colbase) : (const char*)(W0 + colbase + 128);
    const unsigned a_base = (unsigned)(wr * 2048 + r * 64), a_sw0 = (unsigned)(((h ^ ((r >> 2) & 3)) & 3) << 4), a_sw1 = (unsigned)((((2 + h) ^ ((r >> 2) & 3)) & 3) << 4);
    const unsigned b_base = (unsigned)((h * 8 * 128 + 32 * wc + r) * 4);
    for (int base = 0; base < n_e; base += 320) {
        const int nrows = (n_e - base) < 320 ? (n_e - base) : 320, nblk = (nrows + 31) >> 5;
        __syncthreads();
        unsigned aoff[3];
#pragma unroll
        for (int i = 0; i < 3; ++i) { const int pc = (i < 2) ? (wave + 8 * i) : (16 + (wave & 3)); const int m = 16 * pc + (lane >> 2), mm = m < nrows ? m : nrows - 1; const int id = list[base + mm];
            aoff[i] = (unsigned)(id >> ashift) * lda + (unsigned)(((lane & 3) ^ ((m >> 2) & 3)) * 16); }
        f32x16 acc[5][2];
#pragma unroll
        for (int j = 0; j < 5; ++j)
#pragma unroll
            for (int nb = 0; nb < 2; ++nb)
#pragma unroll
                for (int i = 0; i < 16; ++i) acc[j][nb][i] = 0.f;
#define MS_DMAB(t) do { int tq_ = (t); asm volatile("" : "+s"(tq_)); const unsigned st_ = 40960u + (unsigned)(tq_ % 3) * 32768u + (unsigned)wave * 1024u; const size_t kro_ = ((size_t)tq_ * 32 + 2 * wave) * (size_t)ldw * 4; \
            __builtin_amdgcn_global_load_lds((const unsigned*)(Wg0 + kro_ + blane), (LAS unsigned*)(lds + st_), 16, 0, 2); \
            __builtin_amdgcn_global_load_lds((const unsigned*)(Wg0 + kro_ + (size_t)ldw * 64 + blane), (LAS unsigned*)(lds + st_ + 8192), 16, 0, 2); \
            __builtin_amdgcn_global_load_lds((const unsigned*)(Wg1 + kro_ + blane), (LAS unsigned*)(lds + st_ + 16384), 16, 0, 2); \
            __builtin_amdgcn_global_load_lds((const unsigned*)(Wg1 + kro_ + (size_t)ldw * 64 + blane), (LAS unsigned*)(lds + st_ + 24576), 16, 0, 2); } while (0)
#define MS_DMAA(t) do { int tq_ = (t); asm volatile("" : "+s"(tq_)); const unsigned st_ = (unsigned)(tq_ & 1) * 20480u; const char* ap_ = Ab + (size_t)tq_ * 64; \
            __builtin_amdgcn_global_load_lds((const unsigned*)(ap_ + aoff[0]), (LAS unsigned*)(lds + st_ + wave * 1024), 16, 0, 0); \
            __builtin_amdgcn_global_load_lds((const unsigned*)(ap_ + aoff[1]), (LAS unsigned*)(lds + st_ + (wave + 8) * 1024), 16, 0, 0); \
            __builtin_amdgcn_global_load_lds((const unsigned*)(ap_ + aoff[2]), (LAS unsigned*)(lds + st_ + (16 + (wave & 3)) * 1024), 16, 0, 0); } while (0)
        MS_DMAB(0); MS_DMAA(0); if (nt > 1) MS_DMAB(1);
        for (int t = 0; t < nt; ++t) {
            int tq = t; asm volatile("" : "+s"(tq));
            LAS unsigned char* Bs = lds + 40960 + (tq % 3) * 32768; LAS unsigned char* As = lds + (tq & 1) * 20480;
            if (t + 1 < nt) asm volatile("s_waitcnt vmcnt(4)" ::: "memory"); else asm volatile("s_waitcnt vmcnt(0)" ::: "memory");
            __builtin_amdgcn_s_barrier(); asm volatile("" ::: "memory");
            if (t + 1 < nt) MS_DMAA(t + 1);
            if (t + 2 < nt) MS_DMAB(t + 2);
            const LAS unsigned char* Ar = As + a_base; const LAS float* Br = (const LAS float*)(Bs + b_base);
#pragma unroll
            for (int ks = 0; ks < 2; ++ks) {
                bf16x8 Bf[2];
#pragma unroll
                for (int nb = 0; nb < 2; ++nb) { const LAS float* bp = Br + nb * 4096 + ks * 2048;
                    v4u w; w.x = pkbf(bp[0], bp[128]); w.y = pkbf(bp[256], bp[384]); w.z = pkbf(bp[512], bp[640]); w.w = pkbf(bp[768], bp[896]); Bf[nb] = __builtin_bit_cast(bf16x8, w); }
#pragma unroll
                for (int j = 0; j < 5; ++j) { const int mb = wr + 2 * j;
                    if (mb < nblk) { const bf16x8 Af = *(const LAS bf16x8*)(Ar + (ks ? a_sw1 : a_sw0) + j * 4096);
                        acc[j][0] = __builtin_amdgcn_mfma_f32_32x32x16_bf16(Bf[0], Af, acc[j][0], 0, 0, 0); acc[j][1] = __builtin_amdgcn_mfma_f32_32x32x16_bf16(Bf[1], Af, acc[j][1], 0, 0, 0); } }
            }
        }
#undef MS_DMAB
#undef MS_DMAA
#pragma unroll
        for (int j = 0; j < 5; ++j) { const int mb = wr + 2 * j, m = 32 * mb + r;
            if (mb < nblk && m < nrows) { const int pair = list[base + m];
                if (MODE == 0) {
#pragma unroll
                    for (int g = 0; g < 4; ++g) { float hv[4];
#pragma unroll
                        for (int p2 = 0; p2 < 4; ++p2) { const float gv = acc[j][0][4 * g + p2], uv = acc[j][1][4 * g + p2]; hv[p2] = gv / (1.f + __expf(-gv)) * uv; }
                        v2u w; w.x = pkbf(hv[0], hv[1]); w.y = pkbf(hv[2], hv[3]); *(v2u*)(Out + (size_t)pair * FF + colbase + 32 * wc + 8 * g + 4 * h) = w; }
                } else { const float gt = gate[pair];
#pragma unroll
                    for (int nb = 0; nb < 2; ++nb)
#pragma unroll
                        for (int g = 0; g < 4; ++g) { v2u w; w.x = pkbf(acc[j][nb][4 * g] * gt, acc[j][nb][4 * g + 1] * gt); w.y = pkbf(acc[j][nb][4 * g + 2] * gt, acc[j][nb][4 * g + 3] * gt);
                            *(v2u*)(Out + (size_t)pair * D + colbase + 128 * nb + 32 * wc + 8 * g + 4 * h) = w; } } } }
    }
}

template <int MODE> __device__ __forceinline__ int moe_expert(int u) { const int x8 = u & 7, y = u >> 3; return x8 * 8 + (MODE == 0 ? (y >> 2) : (y >> 3)); }
template <int MODE> __device__ __forceinline__ int moe_colbase(int u) { const int y = u >> 3; return MODE == 0 ? 128 * (y & 3) : 256 * (y & 7); }
__device__ __forceinline__ void moe_dma_b(LAS unsigned char* lds, const char* Wg0, const char* Wg1, int ldw, int tile, int stage, int wave, int lane) {
    int tq = tile; asm volatile("" : "+s"(tq));
    const unsigned blane = (unsigned)(((lane >> 5) * ldw + 4 * (lane & 31)) * 4);
    const unsigned st = 40960u + (unsigned)stage * 32768u + (unsigned)wave * 1024u; const size_t kro = ((size_t)tq * 32 + 2 * wave) * (size_t)ldw * 4;
    __builtin_amdgcn_global_load_lds((const unsigned*)(Wg0 + kro + blane), (LAS unsigned*)(lds + st), 16, 0, 2);
    __builtin_amdgcn_global_load_lds((const unsigned*)(Wg0 + kro + (size_t)ldw * 64 + blane), (LAS unsigned*)(lds + st + 8192), 16, 0, 2);
    __builtin_amdgcn_global_load_lds((const unsigned*)(Wg1 + kro + blane), (LAS unsigned*)(lds + st + 16384), 16, 0, 2);
    __builtin_amdgcn_global_load_lds((const unsigned*)(Wg1 + kro + (size_t)ldw * 64 + blane), (LAS unsigned*)(lds + st + 24576), 16, 0, 2);
}
template <int MODE> __device__ __forceinline__ void moe_wptr(const float* Wa, const float* Wb, int u, const char*& Wg0, const char*& Wg1) {
    const int e = moe_expert<MODE>(u), cb = moe_colbase<MODE>(u);
    if (MODE == 0) { Wg0 = (const char*)(Wa + (size_t)e * D * FF + cb); Wg1 = (const char*)(Wb + (size_t)e * D * FF + cb); }
    else { Wg0 = (const char*)(Wa + (size_t)e * FF * D + cb); Wg1 = Wg0 + 128 * 4; }
}
template <int MODE> __device__ __forceinline__ void moe_prefetch(LAS unsigned char* lds, const float* Wa, const float* Wb, int u0, int wave, int lane) {
    constexpr int NU = (MODE == 0) ? NE * 4 : NE * 8, ldw = (MODE == 0) ? FF : D;
    if (u0 < NU) { const char* w0; const char* w1; moe_wptr<MODE>(Wa, Wb, u0, w0, w1); moe_dma_b(lds, w0, w1, ldw, 0, 0, wave, lane); moe_dma_b(lds, w0, w1, ldw, 1, 1, wave, lane); }
}
template <int MODE>
__device__ __forceinline__ void moe_stream_wg(LAS unsigned char* lds, const char* __restrict__ Ab, unsigned lda, int ashift, const float* __restrict__ Wa, const float* __restrict__ Wb,
                                              const int* __restrict__ elist, const int* __restrict__ ecnt, bf16* __restrict__ Out, const float* __restrict__ gate, int u0, int G, bool pre, int tid, int wave, int lane) {
    constexpr int NU = (MODE == 0) ? NE * 4 : NE * 8, K = (MODE == 0) ? D : FF, ldw = (MODE == 0) ? FF : D, nt = K / 32;
    const int wr = wave >> 2, wc = wave & 3, r = lane & 31, h = lane >> 5;
    const unsigned a_base = (unsigned)(wr * 2048 + r * 64), a_sw0 = (unsigned)(((h ^ ((r >> 2) & 3)) & 3) << 4), a_sw1 = (unsigned)((((2 + h) ^ ((r >> 2) & 3)) & 3) << 4);
    const unsigned b_base = (unsigned)((h * 8 * 128 + 32 * wc + r) * 4);
    int u = u0, base = 0, ne = 0; bool have = false;
    for (; u < NU; u += G) { ne = ecnt[moe_expert<MODE>(u) * 64]; if (ne > 0) { have = true; break; } }
    if (pre && !(have && u == u0)) { asm volatile("s_waitcnt vmcnt(0)" ::: "memory"); pre = false; }
    if (!pre) __syncthreads();
    if (!have) return;
    const char* Wg0; const char* Wg1; moe_wptr<MODE>(Wa, Wb, u, Wg0, Wg1);
    if (!pre) { moe_dma_b(lds, Wg0, Wg1, ldw, 0, 0, wave, lane); moe_dma_b(lds, Wg0, Wg1, ldw, 1, 1, wave, lane); }
    int ph = 0;
    unsigned aoff[3], naoff[3];
#define MW_AOFF(dst, lst, bs, nr) do { _Pragma("unroll") for (int i = 0; i < 3; ++i) { const int pc = (i < 2) ? (wave + 8 * i) : (16 + (wave & 3)); const int m = 16 * pc + (lane >> 2), mm = m < (nr) ? m : (nr) - 1; const int id = (lst)[(bs) + mm]; \
            dst[i] = (unsigned)(id >> ashift) * lda + (unsigned)(((lane & 3) ^ ((m >> 2) & 3)) * 16); } } while (0)
#define MW_DMAA(t, ao) do { int tq_ = (t); asm volatile("" : "+s"(tq_)); const unsigned st_ = (unsigned)(tq_ & 1) * 20480u; const char* ap_ = Ab + (size_t)tq_ * 64; \
            __builtin_amdgcn_global_load_lds((const unsigned*)(ap_ + ao[0]), (LAS unsigned*)(lds + st_ + wave * 1024), 16, 0, 0); \
            __builtin_amdgcn_global_load_lds((const unsigned*)(ap_ + ao[1]), (LAS unsigned*)(lds + st_ + (wave + 8) * 1024), 16, 0, 0); \
            __builtin_amdgcn_global_load_lds((const unsigned*)(ap_ + ao[2]), (LAS unsigned*)(lds + st_ + (16 + (wave & 3)) * 1024), 16, 0, 0); } while (0)
    { const int nr0 = ne < 320 ? ne : 320; const int* l0 = elist + (size_t)moe_expert<MODE>(u) * NTOK; MW_AOFF(aoff, l0, 0, nr0); }
    MW_DMAA(0, aoff);
    for (;;) {
        const int* list = elist + (size_t)moe_expert<MODE>(u) * NTOK; const int colbase = moe_colbase<MODE>(u);
        const int nrows = (ne - base) < 320 ? (ne - base) : 320, nblk = (nrows + 31) >> 5;
        int nu = u, nbase = base + 320, nne = ne; bool hn = true;
        if (nbase >= ne) { hn = false; for (nu = u + G; nu < NU; nu += G) { nne = ecnt[moe_expert<MODE>(nu) * 64]; if (nne > 0) { hn = true; nbase = 0; break; } } }
        const char* nW0 = Wg0; const char* nW1 = Wg1;
        if (hn) { moe_wptr<MODE>(Wa, Wb, nu, nW0, nW1); const int nnr = (nne - nbase) < 320 ? (nne - nbase) : 320; const int* nl = elist + (size_t)moe_expert<MODE>(nu) * NTOK; MW_AOFF(naoff, nl, nbase, nnr); }
        f32x16 acc[5][2];
#pragma unroll
        for (int j = 0; j < 5; ++j)
#pragma unroll
            for (int nb = 0; nb < 2; ++nb)
#pragma unroll
                for (int i = 0; i < 16; ++i) acc[j][nb][i] = 0.f;
        int prs[5]; float gts[5];
#pragma unroll
        for (int j = 0; j < 5; ++j) { const int m = 32 * (wr + 2 * j) + r; prs[j] = list[base + (m < nrows ? m : nrows - 1)]; gts[j] = (MODE == 1) ? gate[prs[j]] : 0.f; }
        for (int t = 0; t < nt; ++t) {
            int tq = t; asm volatile("" : "+s"(tq));
            const int sb = (ph + tq) % 3;
            LAS unsigned char* Bs = lds + 40960 + sb * 32768; LAS unsigned char* As = lds + (tq & 1) * 20480;
            if (t > 0 && (t + 1 < nt || hn)) asm volatile("s_waitcnt vmcnt(4)" ::: "memory"); else asm volatile("s_waitcnt vmcnt(0)" ::: "memory");
            __builtin_amdgcn_s_barrier(); asm volatile("" ::: "memory");
            if (t + 1 < nt) MW_DMAA(t + 1, aoff); else if (hn) MW_DMAA(0, naoff);
            if (t + 2 < nt) moe_dma_b(lds, Wg0, Wg1, ldw, t + 2, (ph + t + 2) % 3, wave, lane); else if (hn) moe_dma_b(lds, nW0, nW1, ldw, t + 2 - nt, (ph + t + 2) % 3, wave, lane);
            const LAS unsigned char* Ar = As + a_base; const LAS float* Br = (const LAS float*)(Bs + b_base);
#pragma unroll
            for (int ks = 0; ks < 2; ++ks) {
                bf16x8 Bf[2];
#pragma unroll
                for (int nb = 0; nb < 2; ++nb) { const LAS float* bp = Br + nb * 4096 + ks * 2048;
                    v4u w; w.x = pkbf(bp[0], bp[128]); w.y = pkbf(bp[256], bp[384]); w.z = pkbf(bp[512], bp[640]); w.w = pkbf(bp[768], bp[896]); Bf[nb] = __builtin_bit_cast(bf16x8, w); }
#pragma unroll
                for (int j = 0; j < 5; ++j) { const int mb = wr + 2 * j;
                    if (mb < nblk) { const bf16x8 Af = *(const LAS bf16x8*)(Ar + (ks ? a_sw1 : a_sw0) + j * 4096);
                        acc[j][0] = __builtin_amdgcn_mfma_f32_32x32x16_bf16(Bf[0], Af, acc[j][0], 0, 0, 0); acc[j][1] = __builtin_amdgcn_mfma_f32_32x32x16_bf16(Bf[1], Af, acc[j][1], 0, 0, 0); } }
            }
        }
#pragma unroll
        for (int j = 0; j < 5; ++j) { const int mb = wr + 2 * j, m = 32 * mb + r;
            if (mb < nblk) { const bool live = m < nrows; const int pair = prs[j];
                if (MODE == 0) { unsigned w[4][2];
#pragma unroll
                    for (int g = 0; g < 4; ++g) { float hv[4];
#pragma unroll
                        for (int p2 = 0; p2 < 4; ++p2) { const float gv = acc[j][0][4 * g + p2], uv = acc[j][1][4 * g + p2]; hv[p2] = gv / (1.f + __expf(-gv)) * uv; }
                        w[g][0] = pkbf(hv[0], hv[1]); w[g][1] = pkbf(hv[2], hv[3]); }
                    const v2u s0 = __builtin_amdgcn_permlane32_swap(w[0][0], w[1][0], false, false), s1 = __builtin_amdgcn_permlane32_swap(w[0][1], w[1][1], false, false);
                    const v2u s2 = __builtin_amdgcn_permlane32_swap(w[2][0], w[3][0], false, false), s3 = __builtin_amdgcn_permlane32_swap(w[2][1], w[3][1], false, false);
                    if (live) { bf16* op = Out + (size_t)pair * FF + colbase + 32 * wc + 8 * h; *(v4u*)op = (v4u){s0.x, s1.x, s0.y, s1.y}; *(v4u*)(op + 16) = (v4u){s2.x, s3.x, s2.y, s3.y}; }
                } else { const float gt = gts[j];
#pragma unroll
                    for (int nb = 0; nb < 2; ++nb) { unsigned w[4][2];
#pragma unroll
                        for (int g = 0; g < 4; ++g) { w[g][0] = pkbf(acc[j][nb][4 * g] * gt, acc[j][nb][4 * g + 1] * gt); w[g][1] = pkbf(acc[j][nb][4 * g + 2] * gt, acc[j][nb][4 * g + 3] * gt); }
                        const v2u s0 = __builtin_amdgcn_permlane32_swap(w[0][0], w[1][0], false, false), s1 = __builtin_amdgcn_permlane32_swap(w[0][1], w[1][1], false, false);
                        const v2u s2 = __builtin_amdgcn_permlane32_swap(w[2][0], w[3][0], false, false), s3 = __builtin_amdgcn_permlane32_swap(w[2][1], w[3][1], false, false);
                        if (live) { bf16* op = Out + (size_t)pair * D + colbase + 128 * nb + 32 * wc + 8 * h; *(v4u*)op = (v4u){s0.x, s1.x, s0.y, s1.y}; *(v4u*)(op + 16) = (v4u){s2.x, s3.x, s2.y, s3.y}; } } } } }
        if (!hn) break;
        u = nu; base = nbase; ne = nne; Wg0 = nW0; Wg1 = nW1; ph = (ph + nt) % 3;
#pragma unroll
        for (int i = 0; i < 3; ++i) aoff[i] = naoff[i];
    }
#undef MW_AOFF
#undef MW_DMAA
}

__device__ __forceinline__ float softplus_f(float z) { return fmaxf(z, 0.f) + log1pf(__expf(-fabsf(z))); }
__device__ __forceinline__ void tr_read2(unsigned a0, unsigned a1, s16x4& r0, s16x4& r1) {
    asm volatile("ds_read_b64_tr_b16 %0, %2\n\tds_read_b64_tr_b16 %1, %3\n\ts_waitcnt lgkmcnt(0)" : "=&v"(r0), "=&v"(r1) : "v"(a0), "v"(a1) : "memory");
}
__device__ __forceinline__ void gla_stage_v(LAS unsigned char* vt, const bf16* __restrict__ proj, size_t row0, int hd, int tid) {
#pragma unroll
    for (int i = 0; i < 4; ++i) { const int id = i * 512 + tid, row = id >> 5, ch = id & 31;
        const v4u x = *(const v4u*)(proj + (row0 + row) * PROJP + C_VG + hd * GDV + ch * 8);
        *(LAS v4u*)(vt + (ch >> 4) * 16384 + offb(row, ch & 15)) = x; }
}
__device__ __forceinline__ void gla_pass1_unit(LAS unsigned char* sm, const bf16* __restrict__ proj, const float* __restrict__ alr, const float* __restrict__ wg, const float* __restrict__ bg,
                                               bf16* __restrict__ qdg, bf16* __restrict__ kig, float* __restrict__ elg, bf16* __restrict__ Ug, int unit, int tid, int wave, int lane) {
    LAS unsigned char* vt = sm; LAS unsigned char* kit = sm + 32768; LAS float* ptot = (LAS float*)(sm + 49152);
    const int c = unit & 31, hd = (unit >> 5) & 3, b = unit >> 7;
    const size_t row0 = (size_t)b * SEQ + c * CHUNK;
    const int j = tid & 127, part = tid >> 7;
    __syncthreads();
    gla_stage_v(vt, proj, row0, hd, tid);
    LAS float* alds = ptot + 512;
    if (tid < 256) *(LAS f32x4*)(alds + tid * 4) = *(const f32x4*)(alr + row0 * GRANK + tid * 4);
    float wgr[GRANK];
#pragma unroll
    for (int r = 0; r < GRANK; ++r) wgr[r] = wg[r * 512 + hd * GDK + j];
    const float bj = bg[hd * GDK + j];
    __syncthreads();
    float cl[16]; float run = 0.f;
#pragma unroll
    for (int tt = 0; tt < 16; ++tt) { const LAS f32x4* ap = (const LAS f32x4*)(alds + (part * 16 + tt) * GRANK); const f32x4 a0 = ap[0], a1 = ap[1], a2 = ap[2], a3 = ap[3];
        float sacc = bj + ((a0[0] * wgr[0] + a0[1] * wgr[1]) + (a0[2] * wgr[2] + a0[3] * wgr[3])) + ((a1[0] * wgr[4] + a1[1] * wgr[5]) + (a1[2] * wgr[6] + a1[3] * wgr[7]))
                   + ((a2[0] * wgr[8] + a2[1] * wgr[9]) + (a2[2] * wgr[10] + a2[3] * wgr[11])) + ((a3[0] * wgr[12] + a3[1] * wgr[13]) + (a3[2] * wgr[14] + a3[3] * wgr[15]));
        run -= (fmaxf(-sacc, 0.f) + __logf(1.0f + __expf(-fabsf(sacc)))) * (1.0f / 16.0f); cl[tt] = run; }
    ptot[part * 128 + j] = run;
    __syncthreads();
    const float prefix = (part > 0 ? ptot[j] : 0.f) + (part > 1 ? ptot[128 + j] : 0.f) + (part > 2 ? ptot[256 + j] : 0.f);
    LAS float* cumt = alds + 1024;
#pragma unroll
    for (int tt = 0; tt < 16; ++tt) cumt[(part * 16 + tt) * 128 + j] = prefix + cl[tt];
    if (part == 3) elg[(size_t)unit * 128 + j] = __expf(prefix + run);
    __syncthreads();
#pragma unroll
    for (int i = 0; i < 2; ++i) { const int id = i * 512 + tid, t = id >> 4, cch = id & 15;
        const v4u q8 = *(const v4u*)(proj + (row0 + t) * PROJP + C_QG + hd * GDK + cch * 8), k8 = *(const v4u*)(proj + (row0 + t) * PROJP + C_KG + hd * GDK + cch * 8);
        const f32x4 c0 = *(const LAS f32x4*)(cumt + t * 128 + cch * 8), c1 = *(const LAS f32x4*)(cumt + t * 128 + cch * 8 + 4);
        v4u qo, ko;
#pragma unroll
        for (int e2 = 0; e2 < 4; ++e2) { const float ca = e2 < 2 ? c0[2 * e2] : c1[2 * e2 - 4], cb = e2 < 2 ? c0[2 * e2 + 1] : c1[2 * e2 - 3];
            const float ea = __expf(ca), eb = __expf(cb), ia = __builtin_amdgcn_rcpf(ea), ib = __builtin_amdgcn_rcpf(eb);
            const float qa = __uint_as_float(q8[e2] << 16), qb = __uint_as_float(q8[e2] & 0xffff0000u), ka = __uint_as_float(k8[e2] << 16), kb2 = __uint_as_float(k8[e2] & 0xffff0000u);
            qo[e2] = pkbf(qa * 0.08838834764831845f * ea, qb * 0.08838834764831845f * eb); ko[e2] = pkbf(ka * ia, kb2 * ib); }
        const size_t gi = (row0 + t) * 512 + hd * GDK + cch * 8;
        *(v4u*)(qdg + gi) = qo; *(v4u*)(kig + gi) = ko;
        *(LAS v4u*)(kit + offb(t, cch)) = ko; }
    __syncthreads();
    const unsigned vbase = (unsigned)(size_t)vt + (wave >> 2) * 16384, kbase = (unsigned)(size_t)kit;
    const unsigned h = lane >> 5, blk = (lane >> 4) & 1, q4 = (lane & 15) >> 2, p4 = lane & 3;
    f32x16 U[4];
#pragma unroll
    for (int db = 0; db < 4; ++db)
#pragma unroll
        for (int i = 0; i < 16; ++i) U[db][i] = 0.f;
#pragma unroll
    for (int ks = 0; ks < 4; ++ks) {
        const unsigned r0 = 16 * ks + 8 * h + q4, r1 = r0 + 4, cc = 2 * blk + (p4 >> 1), bo = 8 * (p4 & 1);
        s16x4 a0, a1; tr_read2(vbase + offb(r0, 4 * (wave & 3) + cc) + bo, vbase + offb(r1, 4 * (wave & 3) + cc) + bo, a0, a1);
        const bf16x8 Af = __builtin_shufflevector(a0, a1, 0, 1, 2, 3, 4, 5, 6, 7);
#pragma unroll
        for (int db = 0; db < 4; ++db) { s16x4 b0, b1; tr_read2(kbase + offb(r0, 4 * db + cc) + bo, kbase + offb(r1, 4 * db + cc) + bo, b0, b1);
            U[db] = __builtin_amdgcn_mfma_f32_32x32x16_bf16(Af, __builtin_shufflevector(b0, b1, 0, 1, 2, 3, 4, 5, 6, 7), U[db], 0, 0, 0); }
    }
    bf16* up = Ug + (size_t)unit * 32768;
#pragma unroll
    for (int db = 0; db < 4; ++db)
#pragma unroll
        for (int i = 0; i < 16; ++i) up[(size_t)(32 * wave + (i & 3) + 8 * (i >> 2) + 4 * h) * 128 + 32 * db + (lane & 31)] = f2bf(U[db][i]);
}
__device__ __forceinline__ void gla_pass3_pair(LAS unsigned char* sm, const bf16* __restrict__ proj, const bf16* __restrict__ qdg, const bf16* __restrict__ kig, const bf16* __restrict__ Sg,
                                               const float* __restrict__ gain, const float* __restrict__ br, bf16* __restrict__ cat, int unit0, int unit1, int tid, int wave, int lane) {
    LAS float* nt = (LAS float*)(sm + 65536);
    const int ug = wave >> 2, gwv = wave & 3, unit = ug ? unit1 : unit0;
    const int c = unit & 31, hd = (unit >> 5) & 3, b = unit >> 7;
    const size_t row0 = (size_t)b * SEQ + c * CHUNK;
    __syncthreads();
    v4u vx[8];
#pragma unroll
    for (int i = 0; i < 8; ++i) { const int id = i * 512 + tid, tl = id >> 11, rem = id & 2047, row = rem >> 5, ch = rem & 31; const int us = tl ? unit1 : unit0;
        const size_t r0s = (size_t)(us >> 7) * SEQ + (us & 31) * CHUNK; const int hs = (us >> 5) & 3;
        vx[i] = *(const v4u*)(proj + (r0s + row) * PROJP + C_VG + hs * GDV + ch * 8); }
    LAS unsigned char* vt = sm + ug * 32768;
    const int tb = gwv & 1, dq2 = gwv >> 1, r = lane & 31, h = lane >> 5, t = 32 * tb + r;
    bf16x8 Bq[8];
#pragma unroll
    for (int ks = 0; ks < 8; ++ks) Bq[ks] = *(const bf16x8*)(qdg + (row0 + t) * 512 + hd * GDK + 16 * ks + 8 * h);
    f32x16 O[4];
#pragma unroll
    for (int dvb = 0; dvb < 4; ++dvb)
#pragma unroll
        for (int i = 0; i < 16; ++i) O[dvb][i] = 0.f;
    const bf16* Sp = Sg + (size_t)unit * 32768;
    bf16x8 Kf0[8];
#pragma unroll
    for (int ks = 0; ks < 8; ++ks) Kf0[ks] = *(const bf16x8*)(kig + (row0 + r) * 512 + hd * GDK + 16 * ks + 8 * h);
    bf16x8 Sf0[8];
#pragma unroll
    for (int ks = 0; ks < 8; ++ks) Sf0[ks] = *(const bf16x8*)(Sp + (size_t)(32 * (4 * dq2) + r) * 128 + 16 * ks + 8 * h);
#pragma unroll
    for (int i = 0; i < 8; ++i) { const int id = i * 512 + tid, tl = id >> 11, rem = id & 2047, row = rem >> 5, ch = rem & 31; *(LAS v4u*)(sm + tl * 32768 + (ch >> 4) * 16384 + offb(row, ch & 15)) = vx[i]; }
#pragma unroll
    for (int dvb = 0; dvb < 4; ++dvb)
#pragma unroll
        for (int ks = 0; ks < 8; ++ks) { const bf16x8 Sf = (dvb == 0) ? Sf0[ks] : *(const bf16x8*)(Sp + (size_t)(32 * (4 * dq2 + dvb) + r) * 128 + 16 * ks + 8 * h);
            O[dvb] = __builtin_amdgcn_mfma_f32_32x32x16_bf16(Sf, Bq[ks], O[dvb], 0, 0, 0); }
    __syncthreads();
    const unsigned blk = (lane >> 4) & 1, q4 = (lane & 15) >> 2, p4 = lane & 3;
    v2u rgp[4][4];
#pragma unroll
    for (int dvb = 0; dvb < 4; ++dvb)
#pragma unroll
        for (int g = 0; g < 4; ++g) rgp[dvb][g] = *(const v2u*)(proj + (row0 + t) * PROJP + C_RG + hd * GDV + 32 * (4 * dq2 + dvb) + 8 * g + 4 * h);
    for (int sb = 0; sb <= tb; ++sb) {
        f32x16 ST;
#pragma unroll
        for (int i = 0; i < 16; ++i) ST[i] = 0.f;
#pragma unroll
        for (int ks = 0; ks < 8; ++ks) { const bf16x8 Kf = (sb == 0) ? Kf0[ks] : *(const bf16x8*)(kig + (row0 + 32 * sb + r) * 512 + hd * GDK + 16 * ks + 8 * h);
            ST = __builtin_amdgcn_mfma_f32_32x32x16_bf16(Kf, Bq[ks], ST, 0, 0, 0); }
        const bool diag = (sb == tb);
        float w[16];
#pragma unroll
        for (int i = 0; i < 16; ++i) { const int sl = (i & 3) + 8 * (i >> 2) + 4 * h; w[i] = (!diag || sl <= r) ? ST[i] : 0.f; }
#pragma unroll
        for (int s2 = 0; s2 < 2; ++s2) {
            v4u wp; wp.x = pkbf(w[8 * s2], w[8 * s2 + 1]); wp.y = pkbf(w[8 * s2 + 2], w[8 * s2 + 3]); wp.z = pkbf(w[8 * s2 + 4], w[8 * s2 + 5]); wp.w = pkbf(w[8 * s2 + 6], w[8 * s2 + 7]);
            const bf16x8 Wf = __builtin_bit_cast(bf16x8, wp);
            const unsigned rb0 = 32 * sb + 16 * s2 + 4 * h + q4, rb1 = rb0 + 8, cb = 2 * blk + (p4 >> 1), bo = 8 * (p4 & 1);
            const unsigned base = (unsigned)(size_t)vt + dq2 * 16384 + bo;
            s16x4 v0a, v0b, v1a, v1b, v2a, v2b, v3a, v3b;
            tr_read8(base + offb(rb0, cb), base + offb(rb1, cb), base + offb(rb0, 4 + cb), base + offb(rb1, 4 + cb), base + offb(rb0, 8 + cb), base + offb(rb1, 8 + cb), base + offb(rb0, 12 + cb), base + offb(rb1, 12 + cb),
                     v0a, v0b, v1a, v1b, v2a, v2b, v3a, v3b);
            O[0] = __builtin_amdgcn_mfma_f32_32x32x16_bf16(__builtin_shufflevector(v0a, v0b, 0, 1, 2, 3, 4, 5, 6, 7), Wf, O[0], 0, 0, 0);
            O[1] = __builtin_amdgcn_mfma_f32_32x32x16_bf16(__builtin_shufflevector(v1a, v1b, 0, 1, 2, 3, 4, 5, 6, 7), Wf, O[1], 0, 0, 0);
            O[2] = __builtin_amdgcn_mfma_f32_32x32x16_bf16(__builtin_shufflevector(v2a, v2b, 0, 1, 2, 3, 4, 5, 6, 7), Wf, O[2], 0, 0, 0);
            O[3] = __builtin_amdgcn_mfma_f32_32x32x16_bf16(__builtin_shufflevector(v3a, v3b, 0, 1, 2, 3, 4, 5, 6, 7), Wf, O[3], 0, 0, 0);
        }
    }
    float ss = 0.f;
#pragma unroll
    for (int dvb = 0; dvb < 4; ++dvb)
#pragma unroll
        for (int i = 0; i < 16; ++i) ss += O[dvb][i] * O[dvb][i];
    ss += __shfl_xor(ss, 32);
    if (h == 0) nt[(ug * 64 + t) * 2 + dq2] = ss;
    __syncthreads();
    const float rs = rsqrtf((nt[(ug * 64 + t) * 2] + nt[(ug * 64 + t) * 2 + 1]) * (1.0f / GDV) + EPS);
#pragma unroll
    for (int dvb = 0; dvb < 4; ++dvb) { unsigned w[4][2];
#pragma unroll
        for (int g = 0; g < 4; ++g) { const int cidx = hd * GDV + 32 * (4 * dq2 + dvb) + 8 * g + 4 * h;
            const v2u rg = rgp[dvb][g]; const f32x4 gv = *(const f32x4*)(gain + cidx), bv = *(const f32x4*)(br + cidx);
            const float rr[4] = {__uint_as_float(rg.x << 16) + bv[0], __uint_as_float(rg.x & 0xffff0000u) + bv[1], __uint_as_float(rg.y << 16) + bv[2], __uint_as_float(rg.y & 0xffff0000u) + bv[3]};
            float y[4];
#pragma unroll
            for (int i = 0; i < 4; ++i) y[i] = O[dvb][4 * g + i] * rs * gv[i] * (rr[i] / (1.f + __expf(-rr[i])));
            w[g][0] = pkbf(y[0], y[1]); w[g][1] = pkbf(y[2], y[3]); }
        const v2u s0 = __builtin_amdgcn_permlane32_swap(w[0][0], w[1][0], false, false), s1 = __builtin_amdgcn_permlane32_swap(w[0][1], w[1][1], false, false);
        const v2u s2 = __builtin_amdgcn_permlane32_swap(w[2][0], w[3][0], false, false), s3 = __builtin_amdgcn_permlane32_swap(w[2][1], w[3][1], false, false);
        bf16* op = cat + (row0 + t) * D + 1024 + hd * GDV + 32 * (4 * dq2 + dvb) + 8 * h;
        *(v4u*)op = (v4u){s0.x, s1.x, s0.y, s1.y}; *(v4u*)(op + 16) = (v4u){s2.x, s3.x, s2.y, s3.y}; }
}

__device__ __forceinline__ void proj_tail_item(LAS unsigned char* sm, const bf16* __restrict__ h0, const bf16* __restrict__ WinT, bf16* __restrict__ proj, int item, int tid, int wave, int lane) {
    LAS float* red = (LAS float*)sm;
    const int fr = lane & 15, kg = lane >> 4; const size_t row0 = (size_t)item * 64;
    f32x4 acc[4];
#pragma unroll
    for (int mt = 0; mt < 4; ++mt) acc[mt] = (f32x4){0.f, 0.f, 0.f, 0.f};
    __syncthreads();
#pragma unroll
    for (int ks = 0; ks < 8; ++ks) { const int k0 = 256 * wave + 32 * ks + 8 * kg;
        const bf16x8 Bf = *(const bf16x8*)(WinT + (size_t)(6144 + fr) * D + k0);
#pragma unroll
        for (int mt = 0; mt < 4; ++mt) { const bf16x8 Af = *(const bf16x8*)(h0 + (row0 + 16 * mt + fr) * D + k0); acc[mt] = __builtin_amdgcn_mfma_f32_16x16x32_bf16(Af, Bf, acc[mt], 0, 0, 0); } }
#pragma unroll
    for (int mt = 0; mt < 4; ++mt)
#pragma unroll
        for (int jj = 0; jj < 4; ++jj) red[(wave * 64 + 16 * mt + 4 * kg + jj) * 16 + fr] = acc[mt][jj];
    __syncthreads();
#pragma unroll
    for (int i = 0; i < 2; ++i) { const int o = i * 512 + tid; float a = 0.f;
#pragma unroll
        for (int w8 = 0; w8 < 8; ++w8) a += red[w8 * 1024 + o];
        proj[(row0 + (o >> 4)) * PROJP + 6144 + (o & 15)] = f2bf(a); }
}

struct Args { const float* in[24]; float* out; unsigned char* ws; int ph_lo, ph_hi; };
__global__ void __launch_bounds__(NWAVES * 64, 2) mk_fwd(Args args) {
    extern __shared__ __attribute__((aligned(16))) unsigned char lds[];
    Frame F;
    F.lds = (LAS unsigned char*)lds; F.MISC = (volatile LAS unsigned*)(F.lds + MISC_OFF);
    F.tid = threadIdx.x; F.lane = F.tid & 63; F.wave = __builtin_amdgcn_readfirstlane(F.tid >> 6);
    F.G = gridDim.x; { const int bx = blockIdx.x; F.vcu = (F.G % 8 == 0) ? (bx % 8) * (F.G / 8) + bx / 8 : bx; }
    F.ws = args.ws; F.ctl = (unsigned*)(args.ws + WS_CTL);
    for (int u = F.tid; u < (LDS_BYTES - LDSCTL_OFF) / 4; u += NWAVES * 64) ((LAS unsigned*)(F.lds + LDSCTL_OFF))[u] = 0u;
    __syncthreads();
    const int lo = args.ph_lo, hi = args.ph_hi;
    const bool multi = (hi - lo) > 1;
    XcdBarrier bar; bar.bar = F.ctl + CW_BAR; bar.x = 0; bar.st = nullptr;
    if (multi) bar = xcd_barrier_post(F.ctl + CW_BAR, F.MISC + 8);
#ifndef DUP_PHASE
#define DUP_PHASE -1
#endif
#define IN(k) (lo <= (k) && (k) < hi)
#define REP(k) for (int rep_ = 0; rep_ < ((DUP_PHASE) == (k) ? 2 : 1); ++rep_)
#define SEAM(k) do { if (IN(k) && IN((k) + 1)) xcd_barrier(bar); } while (0)
#define LSEAM(k) do { if (IN(k) && IN((k) + 1)) { if (localok) xcd_local_barrier(F.ctl + CW_LB + bar.x * 64, 32u * ((k) - 3)); else xcd_barrier(bar); } } while (0)
    const float* const* in = args.in;
    unsigned char* ws = args.ws;
    bf16* WinT = (bf16*)(ws + WS_WIN); bf16* WoutT = (bf16*)(ws + WS_WOUT); bf16* WxqT = (bf16*)(ws + WS_WXQ); bf16* WxkvT = (bf16*)(ws + WS_WXKV); bf16* WxoT = (bf16*)(ws + WS_WXO);
    bf16* h0 = (bf16*)(ws + WS_H0); bf16* hm = (bf16*)(ws + WS_HM); bf16* projb = (bf16*)(ws + WS_PROJ); float* alr = (float*)(ws + WS_ALR);
    bf16* KVb = (bf16*)(ws + WS_KV); bf16* MKT = (bf16*)(ws + WS_MKT); bf16* NVT = (bf16*)(ws + WS_NVT);
    bf16* catb = (bf16*)(ws + WS_CAT); float* x1 = (float*)(ws + WS_X1); bf16* x1b = (bf16*)(ws + WS_X1);   bf16* qx = (bf16*)(ws + WS_QX); bf16* oxb = (bf16*)(ws + WS_OX); bf16* x2b = (bf16*)(ws + WS_X2);
    bf16* Pb = (bf16*)(ws + WS_PB);
    bf16* hf = (bf16*)(ws + WS_HF); bf16* Hb = (bf16*)(ws + WS_HB); bf16* Yb = (bf16*)(ws + WS_YB);
    bf16* WrHi = (bf16*)(ws + WS_WR); bf16* WrLo = (bf16*)(ws + WS_WR + 512 * 1024); int* elist = (int*)(ws + WS_LIST); float* gatev = (float*)(ws + WS_GATE); int* ecnt = (int*)(F.ctl + CW_CNT);
    float* rowsq1 = (float*)(F.ctl + CW_ROWSQ1); float* rowsq2 = (float*)(F.ctl + CW_ROWSQ2);

    if (IN(0)) REP(0) {
        LAS float* scr = (LAS float*)(F.lds + RING_OFF + F.wave * 18432);
        const int gw = F.vcu * NWAVES + F.wave, NGW = F.G * NWAVES;
        constexpr int KB = D / 64;
        constexpr int I_IN = KB * ((PROJ + 63) / 64), I_KV = KB * (2 * D / 64);
        constexpr int NITEMS = I_IN + I_KV;
        for (int it = gw; it < NITEMS; it += NGW) {
            if (it < I_IN) p0_transpose_item(in[3], D, PROJ, PROJ, nullptr, WinT, 0, scr, it, F.lane);
            else p0_transpose_item(in[13], D, 2 * D, 2 * D, nullptr, WxkvT, 0, scr, it - I_IN, F.lane);
        }
        { const size_t z0 = (size_t)(((PROJ + 63) / 64) * 64) * D, z1 = (size_t)PROJP * D; v4u zz = {0u, 0u, 0u, 0u};
          for (size_t i = z0 / 8 + (size_t)blockIdx.x * 512 + F.tid; i < z1 / 8; i += (size_t)F.G * 512) ((v4u*)WinT)[i] = zz; }
        for (int i = blockIdx.x * 512 + F.tid; i < 80 * D; i += F.G * 512) { const int n = i / D, k = i % D; const float v = n < 8 ? in[16][k * 8 + n] : (n < 72 ? in[18][k * 64 + n - 8] : 0.f);
            const int j = ((((k >> 5) * 5 + (n >> 4)) * 64) + ((k & 31) >> 3) * 16 + (n & 15)) * 8 + (k & 7);
            const unsigned short hi = f2bf(v); WrHi[j] = hi; WrLo[j] = f2bf(v - bf2f(hi)); }
        for (int m = gw; m < NTOK; m += NGW) rms_row_to_bf16(in[0] + (size_t)m * D, in[2], h0 + (size_t)m * D, F.lane);
        for (int m = gw; m < NMEM; m += NGW) rms_row_to_bf16(in[1] + (size_t)m * D, in[11], hm + (size_t)m * D, F.lane);
    }
    SEAM(0);
    if (IN(1)) REP(1) {
        pg8::DenseSched S{(const char*)h0, (const char*)WinT, D * 2, D * 2, D, NTOK / 256, 24, F.G, (int)blockIdx.x};
        EpiProj E{projb, alr};
        pg8::gemm_phase<EpiProj, pg8::DenseSched, true>(F.lds + RING_OFF, S, E);
    }
    SEAM(1);
    if (IN(2)) REP(2) {
        { pg8::DenseSched S{(const char*)hm, (const char*)WxkvT, D * 2, D * 2, D, NMEM / 256, 2 * D / 256, F.G, (int)blockIdx.x};
          EpiBf16 E{KVb, 2 * D};
          pg8::gemm_phase<EpiBf16, pg8::DenseSched, true>(F.lds + RING_OFF, S, E); }
        { const int first = (F.G > 64 + 32) ? 64 : 0, nl = F.G - first, li = (int)blockIdx.x - first;
          if (li >= 0) { LAS float* scr = (LAS float*)(F.lds + RING_OFF + F.wave * 18432);
              constexpr int I_SQ = (D / 64) * (D / 64);
              for (int it = li * NWAVES + F.wave; it < 2 * I_SQ; it += nl * NWAVES) {
                  if (it < I_SQ) p0_transpose_item(in[9], D, D, D, nullptr, WoutT, 0, scr, it, F.lane);
                  else p0_transpose_item(in[14], D, D, D, nullptr, WxoT, 0, scr, it - I_SQ, F.lane); }
              for (int i = li * 512 + F.tid; i < D * D / 4; i += nl * 512) { const f32x4 v = ((const f32x4*)in[12])[i]; const float g = in[10][i / (D / 4)]; v2u o; o.x = pkbf(v[0] * g, v[1] * g); o.y = pkbf(v[2] * g, v[3] * g); ((v2u*)WxqT)[i] = o; } } }
        for (;;) {
            if (F.tid == 0) F.MISC[20] = (unsigned)__hip_atomic_fetch_add(F.ctl + CW_Q + 128, 1u, __ATOMIC_RELAXED, __HIP_MEMORY_SCOPE_AGENT);
            __syncthreads();
            const int item = (int)F.MISC[20];
            __syncthreads();
            if (item >= NTOK / 64) break;
            proj_tail_item(F.lds + RING_OFF, h0, WinT, projb, item, F.tid, F.wave, F.lane);
        }
        for (;;) {
            if (F.tid == 0) F.MISC[20] = (unsigned)__hip_atomic_fetch_add(F.ctl + CW_Q, 1u, __ATOMIC_RELAXED, __HIP_MEMORY_SCOPE_AGENT);
            __syncthreads();
            const int item = (int)F.MISC[20];
            __syncthreads();
            if (item >= 512) break;
            gla_pass1_unit(F.lds + RING_OFF, projb, alr, in[4], in[5], (bf16*)(ws + WS_GQD), (bf16*)(ws + WS_GKI), (float*)(ws + WS_GEL), (bf16*)(ws + WS_GU), item, F.tid, F.wave, F.lane);
        }
        for (;;) {
            if (F.tid == 0) F.MISC[20] = (unsigned)__hip_atomic_fetch_add(F.ctl + CW_Q + 64, 1u, __ATOMIC_RELAXED, __HIP_MEMORY_SCOPE_AGENT);
            __syncthreads();
            const int item = (int)F.MISC[20];
            __syncthreads();
            if (item >= BATCH * SBH * (SEQ / 32) / NWAVES) break;
            sb_wg_unit(F.lds + RING_OFF, projb, in[7], catb, item, F.wave, F.lane);
        }
    }
    SEAM(2);
    if (IN(3)) REP(3) {
        { MktSched S{(const char*)KVb, (const char*)WxqT, D * 2, XD, F.G, (int)blockIdx.x}; EpiBf16 E{MKT, D};
          pg8::gemm_phase<EpiBf16, MktSched, true>(F.lds + RING_OFF, S, E); }
        { NvtSched S{(const char*)WxoT, (const char*)KVb, 2 * D * 2, XD, F.G, ((int)blockIdx.x + F.G - 128) % F.G}; EpiBf16 E{NVT, 1024};
          pg8::gemm_phase<EpiBf16, NvtSched, true>(F.lds + RING_OFF, S, E); }
        const bf16* Ug = (const bf16*)(ws + WS_GU); const float* elg = (const float*)(ws + WS_GEL); bf16* Sg = (bf16*)(ws + WS_GS);
        for (int g = blockIdx.x * 512 + F.tid; g < BATCH * GH * 8192; g += F.G * 512) { const int bh = g >> 13, idx = g & 8191, dk = (idx & 31) * 4;
            f32x4 S4 = {0.f, 0.f, 0.f, 0.f};
#pragma unroll 8
            for (int c = 0; c < 32; ++c) { const size_t u = (size_t)bh * 32 + c; const v2u ub = __builtin_nontemporal_load((const v2u*)(Ug + u * 32768 + (size_t)idx * 4)); const f32x4 u4 = {__uint_as_float(ub.x << 16), __uint_as_float(ub.x & 0xffff0000u), __uint_as_float(ub.y << 16), __uint_as_float(ub.y & 0xffff0000u)}, e4 = *(const f32x4*)(elg + u * 128 + dk);
                v2u o; o.x = pkbf(S4[0], S4[1]); o.y = pkbf(S4[2], S4[3]); *(v2u*)(Sg + u * 32768 + (size_t)idx * 4) = o;
                S4 = (S4 + u4) * e4; } }
    }
    SEAM(3);
    const unsigned lk_uni = (unsigned)__builtin_amdgcn_readfirstlane((int)F.MISC[8 + 3]), lk_rank = (unsigned)__builtin_amdgcn_readfirstlane((int)F.MISC[8 + 2]);
    const bool localok = multi && lo == 0 && F.G == 256 && lk_uni == 1u && lk_rank < 32u && bar.x < 8u;
    const int vb = localok ? (int)(lk_rank * 8u + bar.x) : (int)blockIdx.x;
    if (IN(4)) REP(4) {
        for (int it = vb; it < 256; it += F.G) {
            const int x = it & 7, k = it >> 3; const int u0 = (F.G == 256) ? ((x >> 1) * 4 + (k >> 3)) * 32 + 16 * (x & 1) + (k & 7) : it, u1 = (F.G == 256) ? u0 + 8 : it + 256;
            gla_pass3_pair(F.lds + RING_OFF, projb, (const bf16*)(ws + WS_GQD), (const bf16*)(ws + WS_GKI), (const bf16*)(ws + WS_GS), in[8], in[6], catb, u0, u1, F.tid, F.wave, F.lane); }
    }
    LSEAM(4);
    if (IN(5)) REP(5) {
        WoutSched S{(const char*)catb, (const char*)WoutT, D * 2, D, F.G, vb};
        EpiResid E{in[0], nullptr, nullptr, x1b, rowsq1};
        pg8::gemm_phase<EpiResid, WoutSched, false>(F.lds + RING_OFF, S, E);
    }
    LSEAM(5);
    if (IN(6)) REP(6) {
        EpiSoftmax128 E{Pb, (LAS float*)(F.lds + LDSCTL_OFF + 1024), rowsq1};
        for (int c = vb; c < 256; c += F.G) { const int hp = 8 * (c & 7) + (c >> 5), h = (c >> 3) & 3, b = hp >> 4;
            pg8::Unit u; u.pm = hp; u.pn = h; u.z = c; u.mv = 128; u.A = (const char*)x1b + (size_t)hp * 128 * D * 2; u.B = (const char*)MKT + (size_t)(b * 1024 + h * 256) * D * 2;
            pg8::gemm128_unit<EpiSoftmax128>(F.lds + RING_OFF, u.A, D * 2, u.B, D * 2, D, E, u); }
    }
    LSEAM(6);
    if (IN(7)) REP(7) {
        XOutSched S{(const char*)Pb, (const char*)NVT, 1024 * 2, 1024, F.G, vb};
        EpiResid E{nullptr, x1b, nullptr, x2b, rowsq2};
        pg8::gemm_phase<EpiResid, XOutSched, false>(F.lds + RING_OFF, S, E);
    }
    LSEAM(7);
    if (IN(8)) REP(8) {
        LAS float* red = (LAS float*)(F.lds + RING_OFF);
        LAS float* lg = (LAS float*)(F.lds + RING_OFF + 81920);
        const int kg = F.lane >> 4, fr = F.lane & 15;
        for (int tile0 = vb; tile0 < NTOK / 32; tile0 += F.G) { const int tile = (F.G == 256) ? 32 * (tile0 & 7) + (tile0 >> 3) : tile0;
            const int row0 = tile * 32;
            f32x4 racc[2][5];
#pragma unroll
            for (int rt = 0; rt < 2; ++rt)
#pragma unroll
                for (int nt = 0; nt < 5; ++nt) racc[rt][nt] = (f32x4){0.f, 0.f, 0.f, 0.f};
            float rs[2];
#pragma unroll
            for (int rt = 0; rt < 2; ++rt) rs[rt] = rsqrtf(rowsq2[row0 + 16 * rt + fr] * (1.0f / D) + EPS);
            for (int kh = 0; kh < 4; ++kh) {
                v4u xa[2][2];
#pragma unroll
                for (int k4 = 0; k4 < 2; ++k4)
#pragma unroll
                    for (int rt = 0; rt < 2; ++rt) { const size_t ro = (size_t)(row0 + 16 * rt + fr) * D + 256 * F.wave + 32 * (2 * kh + k4) + 8 * kg; xa[k4][rt] = __builtin_nontemporal_load((const v4u*)(x2b + ro)); }
#pragma unroll
                for (int k4 = 0; k4 < 2; ++k4) {
                    const int k0 = 256 * F.wave + 32 * (2 * kh + k4) + 8 * kg;
                    const f32x4 g0 = *(const f32x4*)(in[15] + k0), g1 = *(const f32x4*)(in[15] + k0 + 4);
                    bf16x8 Ahi[2], Alo[2];
#pragma unroll
                    for (int rt = 0; rt < 2; ++rt) { const size_t ro = (size_t)(row0 + 16 * rt + fr) * D + k0; const v4u xb = xa[k4][rt]; const f32x4 a0 = {__uint_as_float(xb.x << 16), __uint_as_float(xb.x & 0xffff0000u), __uint_as_float(xb.y << 16), __uint_as_float(xb.y & 0xffff0000u)}, a1 = {__uint_as_float(xb.z << 16), __uint_as_float(xb.z & 0xffff0000u), __uint_as_float(xb.w << 16), __uint_as_float(xb.w & 0xffff0000u)};
                        float v[8]; v[0] = a0[0] * rs[rt] * g0[0]; v[1] = a0[1] * rs[rt] * g0[1]; v[2] = a0[2] * rs[rt] * g0[2]; v[3] = a0[3] * rs[rt] * g0[3];
                        v[4] = a1[0] * rs[rt] * g1[0]; v[5] = a1[1] * rs[rt] * g1[1]; v[6] = a1[2] * rs[rt] * g1[2]; v[7] = a1[3] * rs[rt] * g1[3];
                        v4u hp, lp;
#pragma unroll
                        for (int j = 0; j < 4; ++j) { const unsigned hpk = pkbf(v[2 * j], v[2 * j + 1]); hp[j] = hpk; lp[j] = pkbf(v[2 * j] - __uint_as_float(hpk << 16), v[2 * j + 1] - __uint_as_float(hpk & 0xffff0000u)); }
                        *(v4u*)(hf + ro) = hp; Ahi[rt] = __builtin_bit_cast(bf16x8, hp); Alo[rt] = __builtin_bit_cast(bf16x8, lp); }
#pragma unroll
                    for (int nt = 0; nt < 5; ++nt) { const size_t bo = (size_t)((((8 * F.wave + 2 * kh + k4) * 5 + nt) * 64 + F.lane) * 8); const bf16x8 Bh = *(const bf16x8*)(WrHi + bo), Bl = *(const bf16x8*)(WrLo + bo);
#pragma unroll
                        for (int rt = 0; rt < 2; ++rt) { racc[rt][nt] = __builtin_amdgcn_mfma_f32_16x16x32_bf16(Ahi[rt], Bh, racc[rt][nt], 0, 0, 0);
                            racc[rt][nt] = __builtin_amdgcn_mfma_f32_16x16x32_bf16(Alo[rt], Bh, racc[rt][nt], 0, 0, 0); racc[rt][nt] = __builtin_amdgcn_mfma_f32_16x16x32_bf16(Ahi[rt], Bl, racc[rt][nt], 0, 0, 0); } }
                }
            }
#pragma unroll
            for (int rt = 0; rt < 2; ++rt)
#pragma unroll
                for (int nt = 0; nt < 5; ++nt)
#pragma unroll
                    for (int j = 0; j < 4; ++j) red[(F.wave * 32 + 16 * rt + 4 * kg + j) * 80 + 16 * nt + fr] = racc[rt][nt][j];
            __syncthreads();
            for (int o = F.tid; o < 32 * 80; o += 512) { float a = 0.f;
#pragma unroll
                for (int w8 = 0; w8 < 8; ++w8) a += red[w8 * 2560 + o]; lg[o] = a; }
            __syncthreads();
            if (F.tid < 32) { const int tkn = row0 + F.tid; const LAS float* l = lg + F.tid * 80;
                int g = 0; float mg = l[0] + in[17][0];
                for (int i = 1; i < 8; ++i) { const float v = l[i] + in[17][i]; if (v > mg) { mg = v; g = i; } }
                float sg = 0.f; for (int i = 0; i < 8; ++i) sg += __expf(l[i] + in[17][i] - mg);
                const float ptop = 1.f / sg;
                int i1 = 0; float m1 = l[8 + g * 8] + in[19][g * 8];
                for (int i = 1; i < 8; ++i) { const float v = l[8 + g * 8 + i] + in[19][g * 8 + i]; if (v > m1) { m1 = v; i1 = i; } }
                int i2 = 0; float m2 = -3.4e38f;
                for (int i = 0; i < 8; ++i) { const float v = l[8 + g * 8 + i] + in[19][g * 8 + i]; if (i != i1 && v > m2) { m2 = v; i2 = i; } }
                const float rr = __expf(m2 - m1), w1 = 1.f / (1.f + rr), w2 = rr / (1.f + rr);
                const int e1 = g * 8 + i1, e2 = g * 8 + i2;
                const int s1 = atomicAdd(&ecnt[e1 * 64], 1), s2 = atomicAdd(&ecnt[e2 * 64], 1);
                elist[(size_t)e1 * NTOK + s1] = tkn * 2; gatev[tkn * 2] = ptop * w1;
                elist[(size_t)e2 * NTOK + s2] = tkn * 2 + 1; gatev[tkn * 2 + 1] = ptop * w2; }
            __syncthreads();
        }
    }
    const bool pre9 = IN(8) && IN(9), pre10 = IN(9) && IN(10);
    if (pre9) xcd_barrier_pf(bar, [&]() { moe_prefetch<0>(F.lds + RING_OFF, in[20], in[21], vb, F.wave, F.lane); });
    if (IN(9)) REP(9) {
        moe_stream_wg<0>(F.lds + RING_OFF, (const char*)hf, D * 2, 1, in[20], in[21], elist, ecnt, Hb, nullptr, vb, F.G, pre9 && rep_ == 0, F.tid, F.wave, F.lane);
    }
    if (pre10) { if (localok) xcd_local_barrier_pf(F.ctl + CW_LB + bar.x * 64, 32u * 5u, [&]() { moe_prefetch<1>(F.lds + RING_OFF, in[22], nullptr, vb, F.wave, F.lane); });
                 else xcd_barrier_pf(bar, [&]() { moe_prefetch<1>(F.lds + RING_OFF, in[22], nullptr, vb, F.wave, F.lane); }); }
    if (IN(10)) REP(10) {
        moe_stream_wg<1>(F.lds + RING_OFF, (const char*)Hb, FF * 2, 0, in[22], nullptr, elist, ecnt, Yb, gatev, vb, F.G, pre10 && rep_ == 0, F.tid, F.wave, F.lane);
    }
    SEAM(10);
    if (IN(11)) REP(11) {
        const int gw = F.vcu * NWAVES + F.wave, NGW = F.G * NWAVES;
        v2u ra[8], rb[8], rx[8];
#define P11_LOAD(m_, A_, B_, X_) do { const v2u* xr_ = (const v2u*)(x2b + (size_t)(m_) * D) + F.lane; const v2u* y0_ = (const v2u*)(Yb + (size_t)(2 * (m_)) * D) + F.lane; const v2u* y1_ = (const v2u*)(Yb + (size_t)(2 * (m_) + 1) * D) + F.lane; \
            _Pragma("unroll") for (int j = 0; j < 8; ++j) { A_[j] = __builtin_nontemporal_load(y0_ + 64 * j); B_[j] = __builtin_nontemporal_load(y1_ + 64 * j); X_[j] = __builtin_nontemporal_load(xr_ + 64 * j); } } while (0)
        f32x4 gfin[8];
#pragma unroll
        for (int j = 0; j < 8; ++j) gfin[j] = ((const f32x4*)in[23])[64 * j + F.lane];
        if (gw < NTOK) P11_LOAD(gw, ra, rb, rx);
        for (int m = gw; m < NTOK; m += NGW) {
            v2u na[8], nb2[8], nx[8];
            const int mn = (m + NGW < NTOK) ? m + NGW : m;
            P11_LOAD(mn, na, nb2, nx);
            f32x4 v[8]; float ssq = 0.f;
#pragma unroll
            for (int j = 0; j < 8; ++j) { const v2u a = ra[j], b2 = rb[j], xx = rx[j]; f32x4 t4;
                t4[0] = __uint_as_float(xx.x << 16) + __uint_as_float(a.x << 16) + __uint_as_float(b2.x << 16); t4[1] = __uint_as_float(xx.x & 0xffff0000u) + __uint_as_float(a.x & 0xffff0000u) + __uint_as_float(b2.x & 0xffff0000u);
                t4[2] = __uint_as_float(xx.y << 16) + __uint_as_float(a.y << 16) + __uint_as_float(b2.y << 16); t4[3] = __uint_as_float(xx.y & 0xffff0000u) + __uint_as_float(a.y & 0xffff0000u) + __uint_as_float(b2.y & 0xffff0000u);
                v[j] = t4; ssq += (t4[0] * t4[0] + t4[1] * t4[1]) + (t4[2] * t4[2] + t4[3] * t4[3]); }
            const float rstd = rsqrtf(wave_sum(ssq) * (1.f / D) + EPS);
            f32x4* o4 = (f32x4*)(args.out + (size_t)m * D) + F.lane;
#pragma unroll
            for (int j = 0; j < 8; ++j) __builtin_nontemporal_store(v[j] * rstd * gfin[j], o4 + 64 * j);
#pragma unroll
            for (int j = 0; j < 8; ++j) { ra[j] = na[j]; rb[j] = nb2[j]; rx[j] = nx[j]; }
        }
#undef P11_LOAD
    }
#undef IN
#undef SEAM
}


extern "C" void kernel_launch(void* const* d_in, const int* in_sizes, int n_in, void* d_out, int out_size, void* d_ws, size_t ws_size, hipStream_t stream) {
    static int grid = 0;
    if (!grid) {
        if (WS_NEW_END > ws_size || n_in != 24) { fprintf(stderr, "kernel_launch: workspace too small (%zu < %zu) or n_in %d != 24\n", ws_size, (size_t)WS_NEW_END, n_in); grid = -1; return; }
        (void)hipFuncSetAttribute((const void*)mk_fwd, hipFuncAttributeMaxDynamicSharedMemorySize, LDS_BYTES);
        int dev = 0, cus = 0, per_cu = 0; (void)hipGetDevice(&dev); (void)hipDeviceGetAttribute(&cus, hipDeviceAttributeMultiprocessorCount, dev);
        (void)hipOccupancyMaxActiveBlocksPerMultiprocessor(&per_cu, (const void*)mk_fwd, NWAVES * 64, LDS_BYTES);
        (void)hipGetLastError();
        grid = cus > 0 ? cus : 256;
        if (per_cu < 1) fprintf(stderr, "kernel_launch: occupancy query reports %d workgroups per CU\n", per_cu);
    }
    if (grid < 0) return;
    (void)hipMemsetAsync((char*)d_ws + WS_CTL, 0, CTL_ZERO_BYTES, stream);
    Args a{};
    for (int i = 0; i < 24; ++i) a.in[i] = (const float*)d_in[i];
    a.out = (float*)d_out; a.ws = (unsigned char*)d_ws; a.ph_lo = 0; a.ph_hi = 12;
#if defined(EXP_LO)
    a.ph_hi = EXP_HI + 1;
    hipLaunchKernelGGL(mk_fwd, dim3(grid), dim3(NWAVES * 64), LDS_BYTES, stream, a);
    (void)hipMemsetAsync((char*)d_ws + WS_CTL + CW_BAR * 4, 0, XCD_BAR_WORDS * 4, stream);
    if (EXP_LO <= 2 && 2 <= EXP_HI) (void)hipMemsetAsync((char*)d_ws + WS_CTL + CW_Q * 4, 0, 1024, stream);
    if (EXP_LO <= 5 && 5 <= EXP_HI) (void)hipMemsetAsync((char*)d_ws + WS_CTL + CW_ROWSQ1 * 4, 0, NTOK * 4, stream);
    if (EXP_LO <= 7 && 7 <= EXP_HI) (void)hipMemsetAsync((char*)d_ws + WS_CTL + CW_ROWSQ2 * 4, 0, NTOK * 4, stream);
    if (EXP_LO <= 8 && 8 <= EXP_HI) (void)hipMemsetAsync((char*)d_ws + WS_CTL + CW_CNT * 4, 0, NE * 256, stream);
    a.ph_lo = EXP_LO; a.ph_hi = 12;
#endif
    hipLaunchKernelGGL(mk_fwd, dim3(grid), dim3(NWAVES * 64), LDS_BYTES, stream, a);
}
```
